# Optimizing an MI355X kernel written in HIP

```python
import math
import jax, jax.numpy as jnp
from jax import lax
import numpy as np

D_MODEL = 2048
BATCH = 2
SEQ = 16384
DEPTH = 1

HEAD_DIM = 128
DN_HEADS = D_MODEL // (2 * HEAD_DIM)
NSA_HEADS = D_MODEL // (2 * HEAD_DIM)
NSA_KV_GROUPS = 2
NSA_HPG = NSA_HEADS // NSA_KV_GROUPS
DN_KEY = DN_HEADS * HEAD_DIM
NSA_Q = NSA_HEADS * HEAD_DIM
KVW = NSA_KV_GROUPS * HEAD_DIM
MIX_WIDTH = DN_KEY + NSA_Q
CONV_WIDTH = 4
DN_CHUNK = 64
CMP_LEN = 32
CMP_STRIDE = 16
CMP_HIDDEN = HEAD_DIM
SEL_LEN = 64
SEL_COUNT = 16
WINDOW = 512
Q_BLOCK = 128
N_GROUPS = 8
EXPERTS_PER_GROUP = 8
N_EXPERTS = N_GROUPS * EXPERTS_PER_GROUP
TOP_K = 2
D_EXPERT = 512
MOE_BLOCK = 128
NORM_EPS = 1e-6
NEG_INF = -1e30
SEL_FORCE = 1e9
IN_SPLITS = (3 * DN_KEY, DN_KEY, DN_HEADS, DN_HEADS, NSA_Q, KVW, KVW, KVW, KVW, KVW, KVW, 3 * NSA_HEADS)
D_IN_PROJ = 4 * DN_KEY + 2 * DN_HEADS + NSA_Q + 6 * KVW + 3 * NSA_HEADS

kernel_name = "hymba_deltanet_nsa_hiermoe"


def rms_norm(x, g):
    xf = x.astype(jnp.float32)
    y = xf * lax.rsqrt(jnp.mean(xf * xf, axis=-1, keepdims=True) + NORM_EPS)
    return (y * g.astype(jnp.float32)).astype(x.dtype)


def l2_normalize(x):
    xf = x.astype(jnp.float32)
    return xf * lax.rsqrt(jnp.sum(xf * xf, axis=-1, keepdims=True) + NORM_EPS)


def causal_conv(x, w):
    S = x.shape[1]
    xp = jnp.pad(x, ((0, 0), (CONV_WIDTH - 1, 0), (0, 0)))
    out = xp[:, 0:S] * w[0]
    for i in range(1, CONV_WIDTH):
        out = out + xp[:, i:i + S] * w[i]
    return out


def masked_softmax(s, mask):
    s = jnp.where(mask, s.astype(jnp.float32), NEG_INF)
    e = jnp.where(mask, jnp.exp(s - jnp.max(s, axis=-1, keepdims=True)), 0.0)
    return e / jnp.maximum(jnp.sum(e, axis=-1, keepdims=True), 1e-30)


def alibi_slopes(n_heads):
    return (2.0 ** (-8.0 * (np.arange(n_heads) + 1) / n_heads)).astype(np.float32)


def gated_delta_rule(q, k, v, log_decay, beta):
    B, S, H, Dk = q.shape
    Dv = v.shape[-1]
    C = DN_CHUNK
    n = S // C

    def chunks(t):
        return jnp.moveaxis(t.reshape((B, n, C, H) + t.shape[3:]), 3, 1)

    q = chunks(q) * (Dk ** -0.5)
    k = chunks(k)
    v = chunks(v)
    beta = chunks(beta)
    gcum = jnp.cumsum(chunks(log_decay), axis=-1)
    idx = jnp.arange(C)
    causal = idx[:, None] >= idx[None, :]
    strict = idx[:, None] > idx[None, :]
    decay = jnp.exp(jnp.where(causal, gcum[..., :, None] - gcum[..., None, :], -jnp.inf))
    k_beta = k * beta[..., None]
    v_beta = v * beta[..., None]
    kk = jnp.einsum('bhnid,bhnjd->bhnij', k_beta, k) * decay
    tri = jnp.where(strict, kk, 0.0) + jnp.eye(C, dtype=kk.dtype)
    rhs = jnp.concatenate([v_beta, k_beta * jnp.exp(gcum)[..., None]], axis=-1)
    sol = lax.linalg.triangular_solve(tri, rhs, left_side=True, lower=True, unit_diagonal=True)
    u, w = sol[..., :Dv], sol[..., Dv:]
    qk = jnp.einsum('bhnid,bhnjd->bhnij', q, k) * decay
    q_dec = q * jnp.exp(gcum)[..., None]
    g_last = gcum[..., -1]
    k_dec = k * jnp.exp(g_last[..., None] - gcum)[..., None]

    def step(state, xs):
        u_i, w_i, qd_i, qk_i, kd_i, gl_i = xs
        v_new = u_i - jnp.einsum('bhcd,bhde->bhce', w_i, state)
        o_i = jnp.einsum('bhcd,bhde->bhce', qd_i, state) + jnp.einsum('bhij,bhje->bhie', qk_i, v_new)
        state = state * jnp.exp(gl_i)[..., None, None] + jnp.einsum('bhcd,bhce->bhde', kd_i, v_new)
        return state, o_i

    xs = tuple(jnp.moveaxis(t, 2, 0) for t in (u, w, q_dec, qk, k_dec, g_last))
    state0 = jnp.zeros((B, H, Dk, Dv), jnp.float32)
    _, o = lax.scan(step, state0, xs)
    return jnp.transpose(o, (1, 0, 3, 2, 4)).reshape(B, S, H, Dv)


def deltanet_heads(dn_qkv, dn_z, dn_b, dn_a, conv_w, dt_bias, a_log, norm_g):
    B, S, _ = dn_qkv.shape
    qkv = jax.nn.silu(causal_conv(dn_qkv, conv_w))
    q, k, v = jnp.split(qkv, 3, axis=-1)
    q = l2_normalize(q.reshape(B, S, DN_HEADS, HEAD_DIM))
    k = l2_normalize(k.reshape(B, S, DN_HEADS, HEAD_DIM))
    v = v.reshape(B, S, DN_HEADS, HEAD_DIM).astype(jnp.float32)
    beta = jax.nn.sigmoid(dn_b.astype(jnp.float32))
    log_decay = -jnp.exp(a_log.astype(jnp.float32)) * jax.nn.softplus(
        dn_a.astype(jnp.float32) + dt_bias.astype(jnp.float32))
    o = gated_delta_rule(q, k, v, log_decay, beta)
    z = dn_z.reshape(B, S, DN_HEADS, HEAD_DIM).astype(jnp.float32)
    o = rms_norm(o, norm_g) * jax.nn.silu(z)
    return o.reshape(B, S, DN_KEY).astype(dn_qkv.dtype)


def compress_tokens(kv, pos_emb, w1, w2):
    S = kv.shape[1]
    n_cmp = (S - CMP_LEN) // CMP_STRIDE + 1
    idx = np.arange(n_cmp)[:, None] * CMP_STRIDE + np.arange(CMP_LEN)[None, :]
    blocks = kv[:, idx] + pos_emb[:, None, :]
    hid = jax.nn.gelu(jnp.einsum('bnlgd,ldh->bngh', blocks, w1))
    return jnp.einsum('bngh,he->bnge', hid, w2)


def cmp_to_sel_matrix(n_cmp, n_sel):
    r = SEL_LEN // CMP_STRIDE
    c = CMP_LEN // CMP_STRIDE
    off = np.arange(n_cmp)[:, None] - r * np.arange(n_sel)[None, :] + (c - 1)
    cnt = np.minimum(c - 1, off) - np.maximum(0, off - r + 1) + 1
    return np.clip(cnt, 0, None).astype(np.float32)


def nsa_heads(nsa_q, k_cmp, v_cmp, k_sel, v_sel, k_win, v_win, nsa_gate,
              cmp_pos_k, cmp_w1_k, cmp_w2_k, cmp_pos_v, cmp_w1_v, cmp_w2_v, norm_g):
    B, S, _ = nsa_q.shape
    G, HPG, D = NSA_KV_GROUPS, NSA_HPG, HEAD_DIM
    scale = D ** -0.5
    kv_shape = (B, S, G, D)
    kc = compress_tokens(k_cmp.reshape(kv_shape), cmp_pos_k, cmp_w1_k, cmp_w2_k)
    vc = compress_tokens(v_cmp.reshape(kv_shape), cmp_pos_v, cmp_w1_v, cmp_w2_v)
    n_cmp = kc.shape[1]
    cmp_pos = jnp.asarray(np.arange(n_cmp) * CMP_STRIDE + CMP_LEN - 1, jnp.int32)
    n_sel = S // SEL_LEN
    n_pick = min(SEL_COUNT, n_sel)
    agg = jnp.asarray(cmp_to_sel_matrix(n_cmp, n_sel))
    ks_blocks = jnp.transpose(k_sel.reshape(B, n_sel, SEL_LEN, G, D), (0, 3, 1, 2, 4))
    vs_blocks = jnp.transpose(v_sel.reshape(B, n_sel, SEL_LEN, G, D), (0, 3, 1, 2, 4))
    kw_pad = jnp.pad(k_win.reshape(kv_shape), ((0, 0), (WINDOW, 0), (0, 0), (0, 0)))
    vw_pad = jnp.pad(v_win.reshape(kv_shape), ((0, 0), (WINDOW, 0), (0, 0), (0, 0)))
    slopes = jnp.asarray(alibi_slopes(NSA_HEADS).reshape(G, HPG))[None, :, :, None, None]
    gates = jax.nn.sigmoid(nsa_gate.astype(jnp.float32))
    nq = S // Q_BLOCK
    q_blocks = jnp.moveaxis(nsa_q.reshape(B, nq, Q_BLOCK, G, HPG, D), 1, 0)
    g_blocks = jnp.moveaxis(gates.reshape(B, nq, Q_BLOCK, G, HPG, 3), 1, 0)
    bi = jnp.arange(B)[:, None, None]
    gi = jnp.arange(G)[None, :, None]
    sel_id = jnp.arange(n_sel)

    def alibi_attn(scores, dist, mask):
        return masked_softmax(scores * scale - slopes * dist.astype(jnp.float32), mask)

    def block_fn(args):
        qb, gb, blk = args
        t = blk * Q_BLOCK + jnp.arange(Q_BLOCK)
        s_c = jnp.einsum('bqghd,bngd->bghqn', qb, kc)
        dist_c = t[:, None] - cmp_pos[None, :]
        p_c = alibi_attn(s_c, dist_c, dist_c >= 0)
        o_c = jnp.einsum('bghqn,bngd->bqghd', p_c.astype(vc.dtype), vc)
        imp = jnp.einsum('bghqn,ns->bgqs', p_c, agg)
        cur = t // SEL_LEN
        forced = (sel_id == 0) | (sel_id == cur[:, None]) | (sel_id == cur[:, None] - 1)
        valid = sel_id * SEL_LEN <= t[:, None]
        imp = jnp.where(forced, SEL_FORCE, jnp.where(valid, imp, NEG_INF))
        _, pick = lax.top_k(imp, n_pick)
        flat = pick.reshape(B, G, Q_BLOCK * n_pick)
        k_s = ks_blocks[bi, gi, flat].reshape(B, G, Q_BLOCK, n_pick * SEL_LEN, D)
        v_s = vs_blocks[bi, gi, flat].reshape(B, G, Q_BLOCK, n_pick * SEL_LEN, D)
        pos_s = (pick[..., None] * SEL_LEN + jnp.arange(SEL_LEN)).reshape(B, G, Q_BLOCK, n_pick * SEL_LEN)
        dist_s = (t[:, None] - pos_s)[:, :, None]
        s_s = jnp.einsum('bqghd,bgqkd->bghqk', qb, k_s)
        p_s = alibi_attn(s_s, dist_s, dist_s >= 0)
        o_s = jnp.einsum('bghqk,bgqkd->bqghd', p_s.astype(v_s.dtype), v_s)
        start = blk * Q_BLOCK
        k_w = lax.dynamic_slice_in_dim(kw_pad, start, WINDOW + Q_BLOCK, axis=1)
        v_w = lax.dynamic_slice_in_dim(vw_pad, start, WINDOW + Q_BLOCK, axis=1)
        pos_w = start - WINDOW + jnp.arange(WINDOW + Q_BLOCK)
        dist_w = t[:, None] - pos_w[None, :]
        mask_w = (dist_w >= 0) & (dist_w < WINDOW) & (pos_w[None, :] >= 0)
        s_w = jnp.einsum('bqghd,bkgd->bghqk', qb, k_w)
        p_w = alibi_attn(s_w, dist_w, mask_w)
        o_w = jnp.einsum('bghqk,bkgd->bqghd', p_w.astype(v_w.dtype), v_w)
        return gb[..., 0:1] * o_c + gb[..., 1:2] * o_s + gb[..., 2:3] * o_w

    o = lax.map(block_fn, (q_blocks, g_blocks, jnp.arange(nq)))
    o = jnp.moveaxis(o, 0, 1).reshape(B, S, NSA_HEADS, D)
    return rms_norm(o, norm_g).reshape(B, S, NSA_Q).astype(nsa_q.dtype)


def hierarchical_moe(h, w_group, b_group, w_router, b_router, w_gate, w_up, w_down):
    B, S, D = h.shape
    T = B * S
    ht = h.reshape(T, D)
    tok_ids = jnp.arange(T)
    group_logits = jnp.einsum('td,dg->tg', ht, w_group).astype(jnp.float32)
    p_group = jax.nn.softmax(group_logits, axis=-1)
    g_sel = jnp.argmax(group_logits + b_group.astype(jnp.float32), axis=-1)
    exp_logits = jnp.einsum('td,de->te', ht, w_router).astype(jnp.float32).reshape(T, N_GROUPS, EXPERTS_PER_GROUP)
    el = exp_logits[tok_ids, g_sel]
    bias = b_router.astype(jnp.float32).reshape(N_GROUPS, EXPERTS_PER_GROUP)[g_sel]
    _, top_idx = lax.top_k(el + bias, TOP_K)
    w_top = jax.nn.softmax(jnp.take_along_axis(el, top_idx, axis=-1), axis=-1)
    gate = p_group[tok_ids, g_sel][:, None] * w_top
    expert = g_sel[:, None] * EXPERTS_PER_GROUP + top_idx
    A = T * TOP_K
    e_flat = expert.reshape(A)
    tok_flat = jnp.repeat(tok_ids, TOP_K)
    w_flat = gate.reshape(A)
    order = jnp.argsort(e_flat)
    e_s, tok_s, w_s = e_flat[order], tok_flat[order], w_flat[order]
    counts = jnp.zeros((N_EXPERTS,), jnp.int32).at[e_flat].add(1)
    starts = jnp.cumsum(counts) - counts
    padded = (counts + MOE_BLOCK - 1) // MOE_BLOCK * MOE_BLOCK
    pends = jnp.cumsum(padded)
    pstarts = pends - padded
    dest = pstarts[e_s] + (jnp.arange(A) - starts[e_s])
    n_blocks = (A + MOE_BLOCK - 1) // MOE_BLOCK + N_EXPERTS
    P = n_blocks * MOE_BLOCK
    row_tok = jnp.full((P,), T, jnp.int32).at[dest].set(tok_s)
    row_w = jnp.zeros((P,), jnp.float32).at[dest].set(w_s)
    block_start = jnp.arange(n_blocks) * MOE_BLOCK
    block_expert = jnp.minimum(jnp.sum(block_start[:, None] >= pends[None, :], axis=1), N_EXPERTS - 1)
    ht_pad = jnp.concatenate([ht, jnp.zeros((1, D), ht.dtype)], axis=0)

    def run_block(args):
        toks, ws, e = args
        xb = ht_pad[toks]
        hid = jax.nn.silu(xb @ w_gate[e]) * (xb @ w_up[e])
        return ((hid @ w_down[e]) * ws[:, None]).astype(ht.dtype)

    y = lax.map(run_block, (row_tok.reshape(n_blocks, MOE_BLOCK), row_w.reshape(n_blocks, MOE_BLOCK), block_expert))
    out = jnp.zeros((T + 1, D), ht.dtype).at[row_tok].add(y.reshape(P, D))
    return out[:T].reshape(B, S, D)


def setup_inputs(seed: int = 0) -> dict:
    key = jax.random.key(seed)
    ks = jax.random.split(key, 26)
    f32 = jnp.float32
    L = DEPTH

    def nrm(k, shape, fan_in):
        return jax.random.normal(k, shape, f32) * (fan_in ** -0.5)

    def gain(k, shape):
        return 1.0 + 0.02 * jax.random.normal(k, shape, f32)

    dt = jnp.exp(jax.random.uniform(ks[4], (L, DN_HEADS), f32, math.log(1e-3), math.log(1e-1)))
    return {
        "x": jax.random.normal(ks[0], (BATCH, SEQ, D_MODEL), f32),
        "norm_mix_g": gain(ks[1], (L, D_MODEL)),
        "w_in": nrm(ks[2], (L, D_MODEL, D_IN_PROJ), D_MODEL),
        "conv_w": nrm(ks[3], (L, CONV_WIDTH, 3 * DN_KEY), CONV_WIDTH),
        "dt_bias": dt + jnp.log(-jnp.expm1(-dt)),
        "a_log": jnp.log(jax.random.uniform(ks[5], (L, DN_HEADS), f32, 1.0, 16.0)),
        "dn_norm_g": gain(ks[6], (L, HEAD_DIM)),
        "cmp_pos_k": 0.02 * jax.random.normal(ks[7], (L, CMP_LEN, HEAD_DIM), f32),
        "cmp_w1_k": nrm(ks[8], (L, CMP_LEN, HEAD_DIM, CMP_HIDDEN), CMP_LEN * HEAD_DIM),
        "cmp_w2_k": nrm(ks[9], (L, CMP_HIDDEN, HEAD_DIM), CMP_HIDDEN),
        "cmp_pos_v": 0.02 * jax.random.normal(ks[10], (L, CMP_LEN, HEAD_DIM), f32),
        "cmp_w1_v": nrm(ks[11], (L, CMP_LEN, HEAD_DIM, CMP_HIDDEN), CMP_LEN * HEAD_DIM),
        "cmp_w2_v": nrm(ks[12], (L, CMP_HIDDEN, HEAD_DIM), CMP_HIDDEN),
        "nsa_norm_g": gain(ks[13], (L, HEAD_DIM)),
        "w_out": nrm(ks[14], (L, MIX_WIDTH, D_MODEL), MIX_WIDTH),
        "norm_ffn_g": gain(ks[15], (L, D_MODEL)),
        "w_group": nrm(ks[16], (L, D_MODEL, N_GROUPS), D_MODEL),
        "b_group": 0.01 * jax.random.normal(ks[17], (L, N_GROUPS), f32),
        "w_router": nrm(ks[18], (L, D_MODEL, N_EXPERTS), D_MODEL),
        "b_router": 0.01 * jax.random.normal(ks[19], (L, N_EXPERTS), f32),
        "w_gate": nrm(ks[20], (L, N_EXPERTS, D_MODEL, D_EXPERT), D_MODEL),
        "w_up": nrm(ks[21], (L, N_EXPERTS, D_MODEL, D_EXPERT), D_MODEL),
        "w_down": nrm(ks[22], (L, N_EXPERTS, D_EXPERT, D_MODEL), D_EXPERT),
        "norm_final_g": gain(ks[23], (D_MODEL,)),
    }


def reference(x, norm_mix_g, w_in, conv_w, dt_bias, a_log, dn_norm_g,
              cmp_pos_k, cmp_w1_k, cmp_w2_k, cmp_pos_v, cmp_w1_v, cmp_w2_v, nsa_norm_g,
              w_out, norm_ffn_g, w_group, b_group, w_router, b_router,
              w_gate, w_up, w_down, norm_final_g):
    cuts = [int(c) for c in np.cumsum(IN_SPLITS)[:-1]]
    for l in range(DEPTH):
        h = rms_norm(x, norm_mix_g[l])
        proj = jnp.einsum('bsd,de->bse', h, w_in[l])
        (dn_qkv, dn_z, dn_b, dn_a, nsa_q, k_cmp, v_cmp, k_sel, v_sel,
         k_win, v_win, nsa_gate) = jnp.split(proj, cuts, axis=-1)
        y_dn = deltanet_heads(dn_qkv, dn_z, dn_b, dn_a, conv_w[l], dt_bias[l], a_log[l], dn_norm_g[l])
        y_nsa = nsa_heads(nsa_q, k_cmp, v_cmp, k_sel, v_sel, k_win, v_win, nsa_gate,
                          cmp_pos_k[l], cmp_w1_k[l], cmp_w2_k[l], cmp_pos_v[l], cmp_w1_v[l], cmp_w2_v[l],
                          nsa_norm_g[l])
        x = x + jnp.einsum('bse,ed->bsd', jnp.concatenate([y_dn, y_nsa], axis=-1), w_out[l])
        x = x + hierarchical_moe(rms_norm(x, norm_ffn_g[l]), w_group[l], b_group[l], w_router[l],
                                 b_router[l], w_gate[l], w_up[l], w_down[l])
    return rms_norm(x, norm_final_g)
```

```cpp
#include <hip/hip_runtime.h>
#include <cstdio>
#include <cstdint>

#define LAS __attribute__((address_space(3)))
typedef unsigned short bf16_t;
typedef short bf16x8 __attribute__((ext_vector_type(8)));
typedef short s16x4 __attribute__((ext_vector_type(4)));
typedef float f32x4 __attribute__((ext_vector_type(4)));
typedef float f32x2 __attribute__((ext_vector_type(2)));
typedef unsigned u32x4 __attribute__((ext_vector_type(4)));
typedef unsigned u32x2 __attribute__((ext_vector_type(2)));

constexpr int NB = 2, SEQ = 16384, T = NB * SEQ, DM = 2048;
constexpr int NPROJ = 6656;
constexpr int C_Q = 0, C_K = 1024, C_V = 2048, C_Z = 3072, C_NQ = 4096, C_KCMP = 5120, C_VCMP = 5376, C_KSEL = 5632, C_VSEL = 5888, C_KWIN = 6144, C_VWIN = 6400, C_SMALL = 6656;
constexpr int NEXP = 64, DEXP = 512;
constexpr float EPS = 1e-6f;
constexpr float LOG2E = 1.4426950408889634f;

constexpr size_t MiB = 1u << 20;
constexpr size_t WS_CTL = 0, CTL_BYTES = 1 * MiB;
constexpr size_t WS_BTIN = 1 * MiB, WS_BTOUT = 28 * MiB, WS_W1T = 36 * MiB, WS_WR = 40 * MiB, WS_CMPBUF = 41 * MiB, WS_HIDC = 74 * MiB, WS_KC = 78 * MiB;
constexpr size_t WS_SMALL = 80 * MiB, WS_RSTD1 = 88 * MiB, WS_RSTD2 = 88 * MiB + 131072, WS_BETA = 89 * MiB, WS_GDEC = 90 * MiB;
constexpr size_t WS_R0 = 100 * MiB, WS_R1 = 228 * MiB, WS_R2 = 660 * MiB, WS_WN = 852 * MiB, WS_QK = 916 * MiB, WS_MN = 948 * MiB, WS_SST = 980 * MiB, WS_HIDS = 996 * MiB, WS_END = 1012 * MiB;
constexpr size_t WS_BTGU = WS_R1, WS_BTD = WS_R1 + 256 * MiB, WS_YMOE = WS_R1;
constexpr size_t WS_QN = WS_R2, WS_KN = WS_R2 + 64 * MiB, WS_VN = WS_R2 + 128 * MiB;
constexpr size_t WS_X1B = WS_R2, WS_LISTS = WS_R2 + 128 * MiB, WS_GATEW = WS_R2 + 136 * MiB;
constexpr int CW_BAR = 4096, CW_CNT = 8192, CW_BIAS = 8448, CW_NSAQ = 8704, CW_PBDONE = 9216;

__device__ __forceinline__ unsigned f2bf(float f) { unsigned u = __builtin_bit_cast(unsigned, f); return (u + 0x7fffu + ((u >> 16) & 1u)) >> 16; }
__device__ __forceinline__ unsigned pk2(float lo, float hi) { return f2bf(lo) | (f2bf(hi) << 16); }
typedef __bf16 bf16x2_t __attribute__((ext_vector_type(2)));
__device__ __forceinline__ unsigned cvtpk(float lo, float hi) { const f32x2 v = {lo, hi}; const bf16x2_t r = __builtin_convertvector(v, bf16x2_t); return __builtin_bit_cast(unsigned, r); }
__device__ __forceinline__ float ex2(float x) { return __builtin_amdgcn_exp2f(x); }
__device__ __forceinline__ float bf2f(unsigned b) { return __builtin_bit_cast(float, b << 16); }
__device__ __forceinline__ float bflo(unsigned w) { return __builtin_bit_cast(float, w << 16); }
__device__ __forceinline__ float bfhi(unsigned w) { return __builtin_bit_cast(float, w & 0xffff0000u); }
template <int CTRL> __device__ __forceinline__ float dpp_f(float v) { return __builtin_bit_cast(float, __builtin_amdgcn_update_dpp(0, __builtin_bit_cast(int, v), CTRL, 0xF, 0xF, true)); }
__device__ __forceinline__ float row16_sum(float v) { v += dpp_f<0xB1>(v); v += dpp_f<0x4E>(v); v += dpp_f<0x141>(v); v += dpp_f<0x140>(v); return v; }
__device__ __forceinline__ float quad_sum(float v) { v += dpp_f<0xB1>(v); v += dpp_f<0x4E>(v); return v; }
template <int CTRL, int RM> __device__ __forceinline__ float dpp_rm(float v) { return __builtin_bit_cast(float, __builtin_amdgcn_update_dpp(0, __builtin_bit_cast(int, v), CTRL, RM, 0xF, false)); }
__device__ __forceinline__ float wave_sum(float v) { v = row16_sum(v); v += dpp_rm<0x142, 0xA>(v); v += dpp_rm<0x143, 0xC>(v); return __builtin_bit_cast(float, __builtin_amdgcn_readlane(__builtin_bit_cast(int, v), 63)); }
__device__ __forceinline__ float wave_scan(float v) { v += dpp_f<0x111>(v); v += dpp_f<0x112>(v); v += dpp_f<0x114>(v); v += dpp_f<0x118>(v); v += dpp_rm<0x142, 0xA>(v); v += dpp_rm<0x143, 0xC>(v); return v; }
__device__ __forceinline__ void lds_barrier() { asm volatile("s_waitcnt lgkmcnt(0)" ::: "memory"); __builtin_amdgcn_s_barrier(); asm volatile("" ::: "memory"); }
__device__ __forceinline__ float silu_f(float x) { return x * __builtin_amdgcn_rcpf(1.0f + __expf(-x)); }
__device__ __forceinline__ float sigmoid_f(float x) { return __builtin_amdgcn_rcpf(1.0f + __expf(-x)); }

#define XB_TMO      128
#define XB_XCNT(j)  (256  + 64 * (j))
#define XB_XSUB(j)  (1280 + 64 * (j))
#define XB_XGEN(j)  (2304 + 64 * (j))
#define XB_TOP      3328
#define XB_TOPGEN   3392
#define XCD_BAR_WORDS 3456
#define XB_SPIN_CAP (1u << 24)
__device__ __forceinline__ unsigned xb_ld(unsigned* p)              { return __hip_atomic_load(p, __ATOMIC_RELAXED, __HIP_MEMORY_SCOPE_AGENT); }
__device__ __forceinline__ unsigned xb_add(unsigned* p, unsigned v) { return __hip_atomic_fetch_add(p, v, __ATOMIC_RELAXED, __HIP_MEMORY_SCOPE_AGENT); }
__device__ __forceinline__ unsigned xb_xcc_id() { return (unsigned)__builtin_amdgcn_s_getreg((3 << 11) | 20) & 0xFu; }
#define XB_SPIN(cond, bar) do { unsigned _sp = 0; while (cond) { __builtin_amdgcn_s_sleep(1); \
    if ((++_sp & 255u) == 0u) { if (xb_ld(&(bar)[XB_TMO])) break; if (_sp > XB_SPIN_CAP) { atomicAdd(&(bar)[XB_TMO], 1u); break; } } } } while (0)
struct XcdBarrier { unsigned* bar; unsigned x; volatile LAS unsigned* st; };
__device__ __forceinline__ XcdBarrier xcd_barrier_post(unsigned* bar, volatile LAS unsigned* st) {
    XcdBarrier b; b.bar = bar; b.x = xb_xcc_id(); b.st = st;
    if (threadIdx.x == 0) (void)xb_add(&bar[XB_XCNT(b.x)], 1u);
    return b;
}
__device__ __forceinline__ void xcd_barrier_complete(unsigned* bar, unsigned x, unsigned& nloc, unsigned& nx) {
    const unsigned G = gridDim.x * gridDim.y * gridDim.z;
    unsigned sum, cnt, mine, sp = 0u;
    for (;;) {
        sum = 0u; cnt = 0u; mine = 0u;
#pragma unroll
        for (unsigned j = 0; j < 16; ++j) { const unsigned c = xb_ld(&bar[XB_XCNT(j)]); sum += c; cnt += (c > 0u) ? 1u : 0u; mine = (j == x) ? c : mine; }
        if (sum == G) break;
        __builtin_amdgcn_s_sleep(1);
        if ((++sp & 255u) == 0u) { if (xb_ld(&bar[XB_TMO])) break; if (sp > XB_SPIN_CAP) { atomicAdd(&bar[XB_TMO], 1u); break; } }
    }
    nloc = mine > 0u ? mine : 1u; nx = cnt > 0u ? cnt : 1u;
}
__device__ __forceinline__ void xcd_barrier(const XcdBarrier& b) {
    asm volatile("s_waitcnt vmcnt(0)" ::: "memory");
    __syncthreads();
    if (threadIdx.x == 0) {
        unsigned* bar = b.bar;
        __builtin_amdgcn_s_waitcnt(0);
        unsigned nloc = b.st[0], nx = b.st[1];
        if (nloc == 0u) { xcd_barrier_complete(bar, b.x, nloc, nx); b.st[0] = nloc; b.st[1] = nx; }
        const unsigned old = xb_add(&bar[XB_XSUB(b.x)], 1u);
        const unsigned gen = old / nloc;
        if (old + 1u == (gen + 1u) * nloc) {
            __builtin_amdgcn_fence(__ATOMIC_RELEASE, "agent");
            asm volatile("s_waitcnt vmcnt(0)" ::: "memory");
            const unsigned og = xb_add(&bar[XB_TOP], 1u);
            const unsigned tg = og / nx;
            if (og + 1u == (tg + 1u) * nx) xb_add(&bar[XB_TOPGEN], 1u);
            else XB_SPIN(xb_ld(&bar[XB_TOPGEN]) == tg, bar);
            __builtin_amdgcn_fence(__ATOMIC_ACQUIRE, "agent");
            xb_add(&bar[XB_XGEN(b.x)], 1u);
            asm volatile("s_waitcnt vmcnt(0)" ::: "memory");
        } else {
            XB_SPIN(xb_ld(&bar[XB_XGEN(b.x)]) == gen, bar);
            __builtin_amdgcn_fence(__ATOMIC_ACQUIRE, "agent");
            asm volatile("s_waitcnt vmcnt(0)" ::: "memory");
        }
    }
    __syncthreads();
}

struct Params {
    const float *x, *norm_mix_g, *w_in, *conv_w, *dt_bias, *a_log, *dn_norm_g;
    const float *cmp_pos_k, *cmp_w1_k, *cmp_w2_k, *cmp_pos_v, *cmp_w1_v, *cmp_w2_v, *nsa_norm_g;
    const float *w_out, *norm_ffn_g, *w_group, *b_group, *w_router, *b_router;
    const float *w_gate, *w_up, *w_down, *norm_final_g;
    float* out; unsigned char* ws; int ph_lo, ph_hi;
};

namespace pg8 {
constexpr int BM = 256, BK = 64, HALF = 128, HTB = HALF * BK * 2, STAGE_BYTES = 8 * HTB;
__device__ __forceinline__ int lds_byte(int r, int c) { const int st = (r >> 4) * 2 + (c >> 5), rr = r & 15, cc = c & 31, ob = rr * 64 + cc * 2; return st * 1024 + (ob ^ (((ob >> 9) & 1) << 5)); }
__device__ __forceinline__ void stage_rc(int b, int& R, int& C) { const int st = b / 1024, sb = b % 1024, swz = sb ^ (((sb >> 9) & 1) << 5); R = (st >> 1) * 16 + swz / 64; C = (st & 1) * 32 + (swz % 64) / 2; }
__device__ __forceinline__ int perm32(int rho) { const int n = rho >> 4, i = rho & 15; return 8 * (i >> 2) + 4 * n + (i & 3); }
struct Unit { int pm, pn; const char* a; const char* b; int x0, x1, x2, x3; };
__device__ __forceinline__ unsigned cvt_pk_bf16(float lo, float hi) { unsigned r; asm volatile("v_cvt_pk_bf16_f32 %0, %1, %2" : "=v"(r) : "v"(lo), "v"(hi)); return r; }

template <class Epi, class Sched>
__device__ __forceinline__ void gemm_phase(LAS unsigned char* lds, const int K, const int lda, const int ldb, const Sched& S, const Epi& E) {
    int tid = threadIdx.x; asm volatile("" : "+v"(tid));
    const int wid = __builtin_amdgcn_readfirstlane(tid >> 6), lane = tid & 63, wr = wid >> 2, wc = wid & 3, fr = lane & 15, fq = lane >> 4;
    const int nt = K / BK;
    unsigned voffA[2], voffB[2];
    unsigned gofA[2][2], ngofA[2][2];
#pragma unroll
    for (int i = 0; i < 2; ++i) { int R, C; stage_rc(tid * 16 + i * 8192, R, C); const int Rb = Epi::PERM ? ((R & ~31) + perm32(R & 31)) : R;
        voffA[i] = (unsigned)(R * lda + C) * 2u; voffB[i] = (unsigned)(Rb * ldb + C) * 2u; }
    const size_t kstep = (size_t)(BK * 2);
    const size_t hstepA = Sched::GATHER ? 0 : (size_t)HALF * lda * 2, hstepB = (size_t)HALF * ldb * 2;
    const unsigned ldsw = (unsigned)wid * 1024u;
    const int aoff = lds_byte(wr * 64 + fr, fq * 8), boff = lds_byte(wc * 32 + fr, fq * 8);
#define PG8_SA(b, h) (((b) * 2 + (h)) * HTB)
#define PG8_SB(b, h) ((4 + (b) * 2 + (h)) * HTB)
#define PG8_STAGE(bufoff, gbase, voff) do { _Pragma("unroll") for (int _i = 0; _i < 2; ++_i) \
        __builtin_amdgcn_global_load_lds((const unsigned*)((const char*)(gbase) + (voff)[_i]), (LAS unsigned*)(lds + (bufoff) + ldsw + _i * 8192), 16, 0, 0); } while (0)
#define PG8_STAGE_A(bufoff, gbase, h, nx) do { if constexpr (Sched::GATHER) { if (nx) PG8_STAGE(bufoff, gbase, ngofA[h]); else PG8_STAGE(bufoff, gbase, gofA[h]); } else PG8_STAGE(bufoff, (gbase) + (h) * hstepA, voffA); } while (0)
#define PG8_LDA(dst, b, h) do { _Pragma("unroll") for (int m = 0; m < 4; ++m) _Pragma("unroll") for (int k = 0; k < 2; ++k) dst[m][k] = *(const LAS bf16x8*)(lds + PG8_SA(b, h) + aoff + m * 2048 + k * 1024); } while (0)
#define PG8_LDB(dst, b, h) do { _Pragma("unroll") for (int n = 0; n < 2; ++n) _Pragma("unroll") for (int k = 0; k < 2; ++k) dst[n][k] = *(const LAS bf16x8*)(lds + PG8_SB(b, h) + boff + n * 2048 + k * 1024); } while (0)
#define PG8_MMA(ai, bj, At, Bt) do { __builtin_amdgcn_s_setprio(1); _Pragma("unroll") for (int m = 0; m < 4; ++m) _Pragma("unroll") for (int n = 0; n < 2; ++n) _Pragma("unroll") for (int k = 0; k < 2; ++k) \
        acc[ai][bj][m][n] = __builtin_amdgcn_mfma_f32_16x16x32_bf16(Bt[n][k], At[m][k], acc[ai][bj][m][n], 0, 0, 0); __builtin_amdgcn_s_setprio(0); } while (0)
#define PG8_WAIT_V(n) asm volatile("s_waitcnt vmcnt(" #n ")" ::: "memory")
#define PG8_WAIT_L(n) asm volatile("s_waitcnt lgkmcnt(" #n ")" ::: "memory")
#define PG8_BAR __builtin_amdgcn_s_barrier()
#define PG8_SCHED __builtin_amdgcn_sched_barrier(0)
    Unit cur, nxt; int ui = 0;
    if (!S.next(0, cur)) return;
    if constexpr (Sched::GATHER) {
#pragma unroll
        for (int i = 0; i < 2; ++i) { int R, C; stage_rc(tid * 16 + i * 8192, R, C);
#pragma unroll
            for (int h = 0; h < 2; ++h) { gofA[h][i] = S.row_off(cur, h * HALF + R) + (unsigned)C * 2u; ngofA[h][i] = gofA[h][i]; } }
    }
    f32x4 acc[2][2][4][2];
#pragma unroll
    for (int a = 0; a < 2; ++a)
#pragma unroll
        for (int b = 0; b < 2; ++b)
#pragma unroll
            for (int m = 0; m < 4; ++m)
#pragma unroll
                for (int n = 0; n < 2; ++n) acc[a][b][m][n] = (f32x4){0.f, 0.f, 0.f, 0.f};
    bf16x8 At[4][2], B0[2][2], B1[2][2];
    const char* cA = cur.a; const char* cB = cur.b;
    PG8_STAGE(PG8_SB(0, 0), cB, voffB); PG8_STAGE_A(PG8_SA(0, 0), cA, 0, false); PG8_STAGE(PG8_SB(0, 1), cB + hstepB, voffB); PG8_STAGE_A(PG8_SA(0, 1), cA, 1, false);
    if (wr == 1) PG8_BAR;
    PG8_WAIT_V(4); PG8_BAR;
    PG8_STAGE(PG8_SB(1, 0), cB + kstep, voffB); PG8_STAGE_A(PG8_SA(1, 0), cA + kstep, 0, false); PG8_STAGE(PG8_SB(1, 1), cB + hstepB + kstep, voffB);
    PG8_WAIT_V(6); PG8_BAR;
    for (;;) {
        const bool has_next = S.next(ui + 1, nxt);
        const char* nA = has_next ? nxt.a : cA; const char* nB = has_next ? nxt.b : cB;
        if constexpr (Sched::GATHER) {
            if (has_next) {
#pragma unroll
                for (int i = 0; i < 2; ++i) { int R, C; stage_rc(tid * 16 + i * 8192, R, C);
#pragma unroll
                    for (int h = 0; h < 2; ++h) ngofA[h][i] = S.row_off(nxt, h * HALF + R) + (unsigned)C * 2u; }
            }
        }
        for (int t = 0; t < nt; t += 2) {
            const bool last = (t == nt - 2);
            const char* a1 = cA + (size_t)(t + 1) * kstep;
            const char* a2 = last ? nA : cA + (size_t)(t + 2) * kstep; const char* b2 = last ? nB : cB + (size_t)(t + 2) * kstep;
            const char* a3 = a2 + kstep; const char* b3 = b2 + kstep;
            PG8_LDB(B0, 0, 0); PG8_SCHED; PG8_LDA(At, 0, 0); PG8_STAGE_A(PG8_SA(1, 1), a1, 1, false);
            PG8_WAIT_L(8); PG8_BAR; PG8_WAIT_L(0); PG8_MMA(0, 0, At, B0); PG8_BAR; PG8_SCHED;
            PG8_LDB(B1, 0, 1); PG8_STAGE(PG8_SB(0, 0), b2, voffB);
            PG8_BAR; PG8_WAIT_L(0); PG8_MMA(0, 1, At, B1); PG8_BAR;
            PG8_LDA(At, 0, 1); PG8_STAGE_A(PG8_SA(0, 0), a2, 0, last);
            PG8_BAR; PG8_WAIT_L(0); PG8_MMA(1, 0, At, B0); PG8_BAR; PG8_SCHED;
            PG8_STAGE(PG8_SB(0, 1), b2 + hstepB, voffB);
            PG8_WAIT_V(6); PG8_BAR; PG8_MMA(1, 1, At, B1); PG8_BAR;
            PG8_LDB(B0, 1, 0); PG8_SCHED; PG8_LDA(At, 1, 0); PG8_STAGE_A(PG8_SA(0, 1), a2, 1, last);
            PG8_WAIT_L(8); PG8_BAR; PG8_WAIT_L(0); PG8_MMA(0, 0, At, B0); PG8_BAR; PG8_SCHED;
            PG8_LDB(B1, 1, 1); PG8_STAGE(PG8_SB(1, 0), b3, voffB);
            PG8_BAR; PG8_WAIT_L(0); PG8_MMA(0, 1, At, B1); PG8_BAR;
            PG8_LDA(At, 1, 1); PG8_STAGE_A(PG8_SA(1, 0), a3, 0, last);
            PG8_BAR; PG8_WAIT_L(0); PG8_MMA(1, 0, At, B0); PG8_BAR; PG8_SCHED;
            PG8_STAGE(PG8_SB(1, 1), b3 + hstepB, voffB);
            PG8_WAIT_V(6); PG8_BAR; PG8_MMA(1, 1, At, B1); PG8_BAR;
        }
        E(acc, cur, wr, wc, fr, fq);
        if (!has_next) break;
#pragma unroll
        for (int a = 0; a < 2; ++a)
#pragma unroll
            for (int b = 0; b < 2; ++b)
#pragma unroll
                for (int m = 0; m < 4; ++m)
#pragma unroll
                    for (int n = 0; n < 2; ++n) acc[a][b][m][n] = (f32x4){0.f, 0.f, 0.f, 0.f};
        cur = nxt; cA = nA; cB = nB; ++ui;
        if constexpr (Sched::GATHER) {
#pragma unroll
            for (int i = 0; i < 2; ++i)
#pragma unroll
                for (int h = 0; h < 2; ++h) gofA[h][i] = ngofA[h][i];
        }
    }
    PG8_WAIT_V(0);
    if (wr == 0) PG8_BAR;
    PG8_BAR;
#undef PG8_SA
#undef PG8_SB
#undef PG8_STAGE
#undef PG8_STAGE_A
#undef PG8_LDA
#undef PG8_LDB
#undef PG8_MMA
#undef PG8_WAIT_V
#undef PG8_WAIT_L
#undef PG8_BAR
#undef PG8_SCHED
}

struct DenseOrder {
    static constexpr bool GATHER = false;
    int nM, nN, nwg, G, c; const char* A; const char* Bt; size_t tstepA, tstepB;
    __device__ void init(const void* A_, const void* Bt_, int M, int N, int lda, int ldb, int G_, int c_) { A = (const char*)A_; Bt = (const char*)Bt_; nM = M / BM; nN = N / BM; nwg = nM * nN; G = G_; c = c_; tstepA = (size_t)BM * lda * 2; tstepB = (size_t)BM * ldb * 2; }
    __device__ __forceinline__ bool next(int i, Unit& u) const {
        const long L = (long)i * G + c; if (L >= nwg) return false;
        int wgid = (int)L; { const int q = nwg / 8, r = nwg % 8, xcd = wgid % 8, off = wgid / 8; wgid = (xcd < r ? xcd * (q + 1) : r * (q + 1) + (xcd - r) * q) + off; }
        const int nig = 8 * nN, gid = wgid / nig, fm = gid * 8, gsz = (nM - fm) < 8 ? (nM - fm) : 8;
        u.pm = fm + ((wgid % nig) % gsz); u.pn = (wgid % nig) / gsz; u.a = A + (size_t)u.pm * tstepA; u.b = Bt + (size_t)u.pn * tstepB; u.x0 = u.x1 = u.x2 = u.x3 = 0; return true;
    }
    __device__ __forceinline__ unsigned row_off(const Unit&, int) const { return 0u; }
};
}

struct EpiProj {
    static constexpr bool PERM = true;
    bf16_t* proj; bf16_t* cmpbuf; float* small; const float* rstd;
    __device__ __forceinline__ void operator()(const f32x4 (&acc)[2][2][4][2], const pg8::Unit& u, int wr, int wc, int fr_, int fq_) const {
        int fr = fr_, fq = fq_; asm volatile("" : "+v"(fr), "+v"(fq));
        const int pn = u.pn;
#pragma unroll
        for (int ai = 0; ai < 2; ++ai)
#pragma unroll
            for (int m = 0; m < 4; ++m) {
                const int r = u.pm * 256 + ai * 128 + wr * 64 + m * 16 + fr; const float rs = 1.0f;
                {
#pragma unroll
                    for (int bj = 0; bj < 2; ++bj) {
                        const f32x4 v0 = acc[ai][bj][m][0] * rs, v1 = acc[ai][bj][m][1] * rs;
                        u32x4 w; w.x = cvtpk(v0[0], v0[1]); w.y = cvtpk(v0[2], v0[3]); w.z = cvtpk(v1[0], v1[1]); w.w = cvtpk(v1[2], v1[3]);
                        bf16_t* d;
                        if (pn == 20 || pn == 21) { const int b = r >> 14, s = r & 16383; d = cmpbuf + ((size_t)(((pn - 20) * 2 + b) * 2 + bj) * SEQ + s) * 128 + 32 * wc + 8 * fq; }
                        else d = proj + (size_t)r * NPROJ + pn * 256 + bj * 128 + 32 * wc + 8 * fq;
                        *(u32x4*)d = w;
                    }
                }
            }
    }
};
__device__ __forceinline__ float gelu_tanh(float x) { const float u = 0.7978845608028654f * (x + 0.044715f * x * x * x); return 0.5f * x * (1.0f + tanhf(u)); }
struct EpiCmp1 {
    static constexpr bool PERM = false;
    float* hids;
    __device__ __forceinline__ void operator()(const f32x4 (&acc)[2][2][4][2], const pg8::Unit& u, int wr, int wc, int fr_, int fq_) const {
        int fr = fr_, fq = fq_; asm volatile("" : "+v"(fr), "+v"(fq));
        const int seg = u.x0, kq = u.x1;
#pragma unroll
        for (int n = 0; n < 2; ++n) {
            const int h = 32 * wc + 16 * n + 4 * fq;
#pragma unroll
            for (int ai = 0; ai < 2; ++ai)
#pragma unroll
                for (int m = 0; m < 4; ++m) { const int nr = u.pm * 256 + ai * 128 + wr * 64 + m * 16 + fr;
                    *(f32x4*)(hids + (((size_t)kq * 8 + seg) * 1024 + nr) * 128 + h) = acc[ai][0][m][n]; }
        }
    }
};
struct CmpOrder {
    static constexpr bool GATHER = false;
    const char* cmpbuf; const char* w1t; int G, c;
    __device__ __forceinline__ bool next(int i, pg8::Unit& u) const { const int L = i * G + c; if (L >= 128) return false; const int kq = L & 3, seg = L >> 4; u.pm = (L >> 2) & 3; u.pn = 0; u.x0 = seg; u.x1 = kq; u.x2 = u.x3 = 0;
        u.a = cmpbuf + (size_t)seg * SEQ * 128 * 2 + (size_t)u.pm * 256 * 2048 * 2 + (size_t)kq * 1024 * 2; u.b = w1t + (size_t)(seg >> 2) * 256 * 4096 * 2 + (size_t)kq * 1024 * 2; return true; }
    __device__ __forceinline__ unsigned row_off(const pg8::Unit&, int) const { return 0u; }
};
struct EpiOut {
    static constexpr bool PERM = true;
    const float* x; float* x1; bf16_t* x1b;
    __device__ __forceinline__ void operator()(const f32x4 (&acc)[2][2][4][2], const pg8::Unit& u, int wr, int wc, int fr_, int fq_) const {
        int fr = fr_, fq = fq_; asm volatile("" : "+v"(fr), "+v"(fq));
#pragma unroll
        for (int ai = 0; ai < 2; ++ai)
#pragma unroll
            for (int mp = 0; mp < 2; ++mp) {
                f32x4 xv[2][2][2];
#pragma unroll
                for (int mm = 0; mm < 2; ++mm) { const size_t off = (size_t)(u.pm * 256 + ai * 128 + wr * 64 + (2 * mp + mm) * 16 + fr) * DM + u.pn * 256 + wc * 32 + 8 * fq;
#pragma unroll
                    for (int bj = 0; bj < 2; ++bj)
#pragma unroll
                        for (int n = 0; n < 2; ++n) xv[mm][bj][n] = *(const f32x4*)(x + off + bj * 128 + n * 4); }
#pragma unroll
                for (int mm = 0; mm < 2; ++mm) { const int m = 2 * mp + mm; const size_t off = (size_t)(u.pm * 256 + ai * 128 + wr * 64 + m * 16 + fr) * DM + u.pn * 256 + wc * 32 + 8 * fq;
#pragma unroll
                    for (int bj = 0; bj < 2; ++bj) { const f32x4 v0 = xv[mm][bj][0] + acc[ai][bj][m][0], v1 = xv[mm][bj][1] + acc[ai][bj][m][1];
                        u32x4 w; w.x = cvtpk(v0[0], v0[1]); w.y = cvtpk(v0[2], v0[3]); w.z = cvtpk(v1[0], v1[1]); w.w = cvtpk(v1[2], v1[3]); *(u32x4*)(x1b + off + bj * 128) = w; } }
            }
    }
};
constexpr int LDS_TAB = 155648;
struct MoeOrder {
    static constexpr bool GATHER_ = true;
    const LAS int* tpre; const LAS int* cnt; const int* lists; const char* A; const char* Bt; size_t bstride_e; size_t tstepB; int npn, G, c; unsigned rowbytes; bool gather;
};
template <bool GATH> struct MoeOrderT {
    static constexpr bool GATHER = GATH;
    const LAS int* tpre; const LAS int* cnt; const int* lists; const char* A; const char* Bt; size_t bstride_e, tstepB; int npn, G, c; unsigned rowbytes;
    __device__ __forceinline__ bool next(int i, pg8::Unit& u) const {
        const int ntile = tpre[64]; int tt;
        if (G == 256) {
            const int tpx = 32 / npn, xcd = c & 7, slot = c >> 3; tt = (i * 8 + xcd) * tpx + (slot % tpx); u.pn = slot / tpx; if (tt >= ntile) return false;
        } else { const long L = (long)i * G + c; if (L >= (long)ntile * npn) return false; tt = (int)(L / npn); u.pn = (int)(L % npn); }
        int lo = 0, hi = 64;
        while (hi - lo > 1) { const int mid = (lo + hi) >> 1; if (tpre[mid] <= tt) lo = mid; else hi = mid; }
        const int e = lo, tile = tt - tpre[e]; const int ce = cnt[e];
        u.pm = tt; u.x0 = e; u.x1 = tile; u.x2 = (ce - tile * 256) < 256 ? (ce - tile * 256) : 256; u.x3 = 0;
        u.a = GATH ? A : A + (size_t)tt * 256 * rowbytes; u.b = Bt + (size_t)e * bstride_e + (size_t)u.pn * tstepB; return true;
    }
    __device__ __forceinline__ unsigned row_off(const pg8::Unit& u, int r) const {
        const int idx = (r < u.x2) ? u.x1 * 256 + r : 0; const int a = lists[(size_t)u.x0 * T + idx]; return (unsigned)(a >> 1) * rowbytes;
    }
};
struct EpiGU {
    static constexpr bool PERM = true;
    bf16_t* hid; const int* lists; const float* rstd2;
    __device__ __forceinline__ void operator()(const f32x4 (&acc)[2][2][4][2], const pg8::Unit& u, int wr, int wc, int fr_, int fq_) const {
        int fr = fr_, fq = fq_; asm volatile("" : "+v"(fr), "+v"(fq));
        int av[8]; float rsv[8];
#pragma unroll
        for (int q = 0; q < 8; ++q) { const int rr = (q >> 2) * 128 + wr * 64 + (q & 3) * 16 + fr; const int idx = (rr < u.x2) ? u.x1 * 256 + rr : 0; av[q] = lists[(size_t)u.x0 * T + idx]; }
#pragma unroll
        for (int q = 0; q < 8; ++q) rsv[q] = rstd2[av[q] >> 1];
#pragma unroll
        for (int ai = 0; ai < 2; ++ai)
#pragma unroll
            for (int m = 0; m < 4; ++m) { const int rr = ai * 128 + wr * 64 + m * 16 + fr; const float rs = rsv[ai * 4 + m];
                f32x4 g0 = acc[ai][0][m][0] * rs, g1 = acc[ai][0][m][1] * rs, u0 = acc[ai][1][m][0] * rs, u1 = acc[ai][1][m][1] * rs;
                u32x4 w; w.x = cvtpk(silu_f(g0[0]) * u0[0], silu_f(g0[1]) * u0[1]); w.y = cvtpk(silu_f(g0[2]) * u0[2], silu_f(g0[3]) * u0[3]);
                w.z = cvtpk(silu_f(g1[0]) * u1[0], silu_f(g1[1]) * u1[1]); w.w = cvtpk(silu_f(g1[2]) * u1[2], silu_f(g1[3]) * u1[3]);
                *(u32x4*)(hid + ((size_t)u.pm * 256 + rr) * DEXP + u.pn * 128 + wc * 32 + 8 * fq) = w; }
    }
};
struct EpiDown {
    static constexpr bool PERM = true;
    bf16_t* ymoe; const int* lists; const float* gatew;
    __device__ __forceinline__ void operator()(const f32x4 (&acc)[2][2][4][2], const pg8::Unit& u, int wr, int wc, int fr_, int fq_) const {
        int fr = fr_, fq = fq_; asm volatile("" : "+v"(fr), "+v"(fq));
        int av[8]; float gwv[8];
#pragma unroll
        for (int q = 0; q < 8; ++q) { const int rr = (q >> 2) * 128 + wr * 64 + (q & 3) * 16 + fr; const int idx = (rr < u.x2) ? u.x1 * 256 + rr : 0; av[q] = lists[(size_t)u.x0 * T + idx]; }
#pragma unroll
        for (int q = 0; q < 8; ++q) gwv[q] = gatew[av[q]];
#pragma unroll
        for (int ai = 0; ai < 2; ++ai)
#pragma unroll
            for (int m = 0; m < 4; ++m) { const int rr = ai * 128 + wr * 64 + m * 16 + fr; if (rr < u.x2) { const int a = av[ai * 4 + m]; const float gw = gwv[ai * 4 + m];
#pragma unroll
                for (int bj = 0; bj < 2; ++bj) { const f32x4 v0 = acc[ai][bj][m][0] * gw, v1 = acc[ai][bj][m][1] * gw;
                    u32x4 w; w.x = cvtpk(v0[0], v0[1]); w.y = cvtpk(v0[2], v0[3]); w.z = cvtpk(v1[0], v1[1]); w.w = cvtpk(v1[2], v1[3]);
                    *(u32x4*)(ymoe + (size_t)a * DM + u.pn * 256 + bj * 128 + wc * 32 + 8 * fq) = w; } } }
    }
};

struct Frame { unsigned char* lds; int tid, lane, wave, G, bid, gw, NGW; };
__device__ __forceinline__ Frame reframe(const Frame& F_) { Frame F = F_; int t = F_.tid; asm volatile("" : "+v"(t)); F.tid = t; F.lane = t & 63; F.wave = __builtin_amdgcn_readfirstlane(t >> 6); F.gw = F.bid * 8 + F.wave; return F; }

template <class SRC>
__device__ __forceinline__ void tr_load(const SRC& src, f32x4 (&v)[8], int lane) {
#pragma unroll
    for (int i = 0; i < 4; ++i) { const int kk = 16 * i + 2 * (lane >> 3); v[2 * i] = src(kk, (lane & 7) * 4); v[2 * i + 1] = src(kk + 1, (lane & 7) * 4); }
}
__device__ __forceinline__ void tr_store(const f32x4 (&v)[8], bf16_t* dst, size_t ldd, float* scr_, int lane) {
    unsigned* scr = (unsigned*)scr_;
#pragma unroll
    for (int i = 0; i < 4; ++i) { const int kp = 8 * i + (lane >> 3); unsigned* q = scr + ((lane & 7) * 4) * 36 + kp;
        q[0] = cvtpk(v[2 * i][0], v[2 * i + 1][0]); q[36] = cvtpk(v[2 * i][1], v[2 * i + 1][1]); q[72] = cvtpk(v[2 * i][2], v[2 * i + 1][2]); q[108] = cvtpk(v[2 * i][3], v[2 * i + 1][3]); }
    __builtin_amdgcn_s_waitcnt(0xc07f); asm volatile("" ::: "memory");
    const int c = lane & 7;
#pragma unroll
    for (int j = 0; j < 4; ++j) { const int n = (lane >> 3) + 8 * j; *(u32x4*)(dst + (size_t)n * ldd + 8 * c) = *(const u32x4*)(scr + n * 36 + 4 * c); }
    __builtin_amdgcn_s_waitcnt(0xc07f); asm volatile("" ::: "memory");
}
template <class SRC>
__device__ __forceinline__ void tr_item(const SRC& src, bf16_t* dst, size_t ldd, float* scr, int lane) { f32x4 v[8]; tr_load(src, v, lane); tr_store(v, dst, ldd, scr, lane); }
__device__ __forceinline__ int colmap(int n) {
    if (n < 4096) return n;
    if (n < 6656) return n + 16;
    if (n < 6672) return n - 6656 + 4096;
    if (n < 6696) return n;
    return -1;
}
__device__ __forceinline__ void p0_prologue(const Params& P, Frame& F_) { Frame F = reframe(F_);
    float* scr = (float*)(F.lds + F.wave * 8448);
    unsigned char* ws = P.ws;
    bf16_t* btin = (bf16_t*)(ws + WS_BTIN); bf16_t* btout = (bf16_t*)(ws + WS_BTOUT); bf16_t* w1t = (bf16_t*)(ws + WS_W1T);
    constexpr int I_IN = 32 * 216, I_OUT = 32 * 64, I_W1 = 2 * 64 * 8;
    for (int it = F.gw; it < I_IN + I_OUT + I_W1; it += F.NGW) {
        int r = it;
        if (r < I_IN) { const int kb = r / 216, nb = r % 216, k0 = kb * 64, n0 = nb * 32; const float* w = P.w_in; const float* g = P.norm_mix_g;
            tr_item([&](int kk, int nn) { const int c = colmap(n0 + nn); return c < 0 ? (f32x4){0.f, 0.f, 0.f, 0.f} : *(const f32x4*)(w + (size_t)(k0 + kk) * 6696 + c) * g[k0 + kk]; }, btin + (size_t)n0 * DM + k0, DM, scr, F.lane); continue; }
        r -= I_IN;
        if (r < I_OUT) { const int kb = r / 64, nb = r % 64, k0 = kb * 64, n0 = nb * 32; const float* w = P.w_out;
            tr_item([&](int kk, int nn) { return *(const f32x4*)(w + (size_t)(k0 + kk) * DM + n0 + nn); }, btout + (size_t)n0 * DM + k0, DM, scr, F.lane); continue; }
        r -= I_OUT;
        { const int tensor = r / 512, rr = r % 512, kb = rr / 8, nb = rr % 8, k0 = kb * 64, n0 = nb * 32; const float* w = tensor ? P.cmp_w1_v : P.cmp_w1_k;
            tr_item([&](int kk, int nn) { return (n0 + nn) < 128 ? *(const f32x4*)(w + (size_t)(k0 + kk) * 128 + n0 + nn) : (f32x4){0.f, 0.f, 0.f, 0.f}; }, w1t + (size_t)tensor * 256 * 4096 + (size_t)n0 * 4096 + k0, 4096, scr, F.lane); }
    }
    float* biasp = (float*)(ws + WS_RSTD1);
    for (int it = F.NGW - 1 - F.gw; it < 128; it += F.NGW) { const int tensor = it >> 6, hh = (it >> 5) & 1, kc = it & 31; const float* w = tensor ? P.cmp_w1_v : P.cmp_w1_k; const float* pos = tensor ? P.cmp_pos_v : P.cmp_pos_k;
        float a0 = 0.f, a1 = 0.f, a2 = 0.f, a3 = 0.f; const int h = hh * 64 + F.lane;
#pragma unroll 8
        for (int k = kc * 128; k < kc * 128 + 128; k += 4) { a0 += pos[k] * w[(size_t)k * 128 + h]; a1 += pos[k + 1] * w[(size_t)(k + 1) * 128 + h]; a2 += pos[k + 2] * w[(size_t)(k + 2) * 128 + h]; a3 += pos[k + 3] * w[(size_t)(k + 3) * 128 + h]; }
        biasp[(tensor * 32 + kc) * 128 + h] = (a0 + a1) + (a2 + a3); }
    { bf16_t* whi = (bf16_t*)(ws + WS_WR); bf16_t* wlo = (bf16_t*)(ws + WS_WR + 512 * 1024);
      for (int it = F.bid * 512 + F.tid; it < 80 * 256; it += F.G * 512) { const int n = it >> 8, k0 = (it & 255) * 8; unsigned hi[8], lo[8];
          const float* wsrc = n < 8 ? P.w_group + n : P.w_router + (n < 72 ? n - 8 : 0); const int wstr = n < 8 ? 8 : 64; const bool wok = n < 72;
#pragma unroll
          for (int j = 0; j < 8; ++j) { const int k = k0 + j; float v = wsrc[(size_t)k * wstr]; v = wok ? v * P.norm_ffn_g[k] : 0.f;
              hi[j] = f2bf(v); lo[j] = f2bf(v - bf2f(hi[j])); }
          u32x4 a, b; a.x = hi[0] | (hi[1] << 16); a.y = hi[2] | (hi[3] << 16); a.z = hi[4] | (hi[5] << 16); a.w = hi[6] | (hi[7] << 16);
          b.x = lo[0] | (lo[1] << 16); b.y = lo[2] | (lo[3] << 16); b.z = lo[4] | (lo[5] << 16); b.w = lo[6] | (lo[7] << 16);
          *(u32x4*)(whi + (size_t)n * DM + k0) = a; *(u32x4*)(wlo + (size_t)n * DM + k0) = b; } }
    { bf16_t* w2t = (bf16_t*)(ws + WS_WR + 896 * 1024);
      for (int it = F.bid * 512 + F.tid; it < 2 * 128 * 128; it += F.G * 512) { const int t = it >> 14, n = (it >> 7) & 127, k = it & 127; const float* w2 = t ? P.cmp_w2_v : P.cmp_w2_k; w2t[it] = (bf16_t)f2bf(w2[k * 128 + n]); } }
    bf16_t* xb = (bf16_t*)(ws + WS_R0); float* rstd1 = (float*)(ws + WS_RSTD1);
    for (int m = F.gw; m < T; m += 2 * F.NGW) {
        const int m2 = m + F.NGW; const bool has2 = m2 < T; const int m2c = has2 ? m2 : m;
        const f32x4* xr = (const f32x4*)(P.x + (size_t)m * DM) + F.lane; const f32x4* xr2 = (const f32x4*)(P.x + (size_t)m2c * DM) + F.lane; f32x4 v[8], v2[8]; float s = 0.f, s2 = 0.f;
#pragma unroll
        for (int j = 0; j < 8; ++j) v[j] = xr[64 * j];
#pragma unroll
        for (int j = 0; j < 8; ++j) v2[j] = xr2[64 * j];
#pragma unroll
        for (int j = 0; j < 8; ++j) { s += (v[j][0] * v[j][0] + v[j][1] * v[j][1]) + (v[j][2] * v[j][2] + v[j][3] * v[j][3]); s2 += (v2[j][0] * v2[j][0] + v2[j][1] * v2[j][1]) + (v2[j][2] * v2[j][2] + v2[j][3] * v2[j][3]); }
        s = wave_sum(s); s2 = wave_sum(s2); const float rs = rsqrtf(s * (1.0f / DM) + EPS), rs2 = rsqrtf(s2 * (1.0f / DM) + EPS);
        u32x2* o = (u32x2*)(xb + (size_t)m * DM) + F.lane; u32x2* o2 = (u32x2*)(xb + (size_t)m2c * DM) + F.lane;
#pragma unroll
        for (int j = 0; j < 8; ++j) { u32x2 w; w.x = cvtpk(v[j][0] * rs, v[j][1] * rs); w.y = cvtpk(v[j][2] * rs, v[j][3] * rs); o[64 * j] = w; }
        if (has2) {
#pragma unroll
            for (int j = 0; j < 8; ++j) { u32x2 w; w.x = cvtpk(v2[j][0] * rs2, v2[j][1] * rs2); w.y = cvtpk(v2[j][2] * rs2, v2[j][3] * rs2); o2[64 * j] = w; } }
    }
    { u32x4* pad = (u32x4*)(ws + WS_CMPBUF + 32 * MiB); for (int i = F.bid * 512 + F.tid; i < 4096; i += F.G * 512) pad[i] = (u32x4){0u, 0u, 0u, 0u}; }
}

__device__ __forceinline__ void cmp2_phase(const Params& P, Frame& F_) { Frame F = reframe(F_);
    if (F.G == 256) {
        unsigned char* ws = P.ws; const float* hids = (const float*)(ws + WS_HIDS); const float* bias = (const float*)(ws + WS_RSTD1); bf16_t* kc = (bf16_t*)(ws + WS_KC); const bf16_t* w2t = (const bf16_t*)(ws + WS_WR + 896 * 1024);
        unsigned char* Gl = F.lds;
        const int tid = F.tid, lane = F.lane, w = F.wave, r16 = lane & 15, gq = lane >> 4, rl = tid >> 7, e = tid & 127;
        bf16x8 bfr[2][4];
#pragma unroll
        for (int t = 0; t < 2; ++t)
#pragma unroll
            for (int ks = 0; ks < 4; ++ks) bfr[t][ks] = *(const bf16x8*)(w2t + (size_t)(t * 128 + 16 * w + r16) * 128 + 32 * ks + 8 * gq);
        const size_t sl = (size_t)8 * 1024 * 128;
        float hv[8];
#pragma unroll
        for (int it = 0; it < 8; ++it) { const int rowi = (F.bid + 256 * it) * 4 + rl; const float* hr = hids + (size_t)rowi * 128 + e; hv[it] = (hr[0] + hr[sl]) + (hr[2 * sl] + hr[3 * sl]); }
        float bs[2] = {0.f, 0.f};
#pragma unroll
        for (int t = 0; t < 2; ++t) for (int kq = 0; kq < 32; ++kq) bs[t] += bias[(t * 32 + kq) * 128 + e];
        __syncthreads();
#pragma unroll
        for (int it = 0; it < 8; ++it) { const int t = it >> 2, row16 = (it & 3) * 4 + rl; *(bf16_t*)(Gl + t * 4352 + row16 * 272 + e * 2) = (bf16_t)f2bf(gelu_tanh(hv[it] + bs[t])); }
        __syncthreads();
#pragma unroll
        for (int t = 0; t < 2; ++t) { f32x4 acc = (f32x4){0.f, 0.f, 0.f, 0.f};
#pragma unroll
            for (int ks = 0; ks < 4; ++ks) { const bf16x8 a = *(const bf16x8*)(Gl + t * 4352 + r16 * 272 + (32 * ks + 8 * gq) * 2); acc = __builtin_amdgcn_mfma_f32_16x16x32_bf16(a, bfr[t][ks], acc, 0, 0, 0); }
#pragma unroll
            for (int r = 0; r < 4; ++r) { const int row16 = 4 * gq + r, it = t * 4 + (row16 >> 2), rowi = (F.bid + 256 * it) * 4 + (row16 & 3), n = rowi & 1023;
                kc[(size_t)rowi * 128 + 16 * w + r16] = (bf16_t)(n < 1023 ? f2bf(acc[r]) : 0u); } }
        __syncthreads();
        return;
    }
    unsigned char* ws = P.ws; const float* hids = (const float*)(ws + WS_HIDS); const float* bias = (const float*)(ws + WS_RSTD1); bf16_t* kc = (bf16_t*)(ws + WS_KC);
    float* hl = (float*)F.lds;
    const int rl = F.tid >> 7, e = F.tid & 127; int cur_t = -1; float bsum = 0.f;
    for (int rg = F.bid; rg < 2048; rg += F.G) {
        const int rowi = rg * 4 + rl, seg = rowi >> 10, n = rowi & 1023; const float* w2 = (seg >> 2) ? P.cmp_w2_v : P.cmp_w2_k;
        if ((seg >> 2) != cur_t) { cur_t = seg >> 2; bsum = 0.f; for (int kc = 0; kc < 32; ++kc) bsum += bias[(cur_t * 32 + kc) * 128 + e]; }
        const float* hr = hids + (size_t)rowi * 128 + e;
        const float hv = ((hr[0] + hr[(size_t)8 * 1024 * 128]) + (hr[(size_t)2 * 8 * 1024 * 128] + hr[(size_t)3 * 8 * 1024 * 128])) + bsum;
        __syncthreads();
        hl[rl * 128 + e] = gelu_tanh(hv);
        __syncthreads();
        float a = 0.f; const float* hrow = hl + rl * 128;
#pragma unroll 8
        for (int hh = 0; hh < 128; ++hh) a += hrow[hh] * w2[hh * 128 + e];
        kc[(size_t)rowi * 128 + e] = (bf16_t)(n < 1023 ? f2bf(a) : 0u);
    }
}

__device__ __forceinline__ unsigned off_b(unsigned row, unsigned ch) { return 256u * row + 16u * (ch ^ (((row & 3u) << 2) | ((row >> 2) & 3u))); }
__device__ __forceinline__ void stage_tile(unsigned char* dst, const bf16_t* src, size_t stride, int tid) {
    const int row = tid >> 3, ch0 = (tid & 7) * 2; const u32x4* s = (const u32x4*)(src + (size_t)row * stride + ch0 * 8);
    const u32x4 a = s[0], b = s[1];
    *(u32x4*)(dst + off_b(row, ch0)) = a; *(u32x4*)(dst + off_b(row, ch0 + 1)) = b;
}
struct T2 { u32x4 a, b; };
__device__ __forceinline__ void t2_load(T2& R, const bf16_t* src, size_t stride, int tid) { const int row = tid >> 3, ch0 = (tid & 7) * 2; const u32x4* sp = (const u32x4*)(src + (size_t)row * stride + ch0 * 8); R.a = sp[0]; R.b = sp[1]; }
__device__ __forceinline__ void t2_store(const T2& R, unsigned char* dst, int tid) { const int row = tid >> 3, ch0 = (tid & 7) * 2; *(u32x4*)(dst + off_b(row, ch0)) = R.a; *(u32x4*)(dst + off_b(row, ch0 + 1)) = R.b; }
struct NsaLane { int r16, gq, kaddr[4], vaddr[8], a8[4][2], ubase, kb, kh, vb, vh; };
__device__ __forceinline__ void qk_tile(const unsigned char* Kt, const NsaLane& L, const bf16x8 (&qf)[4], f32x4 (&acc)[4]) {
#pragma unroll
    for (int rb = 0; rb < 4; ++rb) { acc[rb] = (f32x4){0.f, 0.f, 0.f, 0.f};
#pragma unroll
        for (int ks = 0; ks < 4; ++ks) { const bf16x8 a = *(const bf16x8*)(Kt + L.kaddr[ks] + rb * 4096); acc[rb] = __builtin_amdgcn_mfma_f32_16x16x32_bf16(a, qf[ks], acc[rb], 0, 0, 0); } }
}
__device__ __forceinline__ void pv_tile(const unsigned char* Vt, const NsaLane& L, const f32x4 (&p)[4], f32x4 (&o)[8]) {
#pragma unroll
    for (int ks2 = 0; ks2 < 2; ++ks2) {
        u32x4 pw; pw.x = cvtpk(p[2 * ks2][0], p[2 * ks2][1]); pw.y = cvtpk(p[2 * ks2][2], p[2 * ks2][3]); pw.z = cvtpk(p[2 * ks2 + 1][0], p[2 * ks2 + 1][1]); pw.w = cvtpk(p[2 * ks2 + 1][2], p[2 * ks2 + 1][3]);
        const bf16x8 pb = __builtin_bit_cast(bf16x8, pw);
#pragma unroll
        for (int c = 0; c < 8; ++c) {
            const s16x4 v0 = __builtin_amdgcn_ds_read_tr16_b64_v4i16((LAS s16x4*)(Vt + L.vaddr[c] + 256 * (32 * ks2)));
            const s16x4 v1 = __builtin_amdgcn_ds_read_tr16_b64_v4i16((LAS s16x4*)(Vt + L.vaddr[c] + 256 * (32 * ks2 + 16)));
            const bf16x8 va = {v0[0], v0[1], v0[2], v0[3], v1[0], v1[1], v1[2], v1[3]};
            o[c] = __builtin_amdgcn_mfma_f32_16x16x32_bf16(va, pb, o[c], 0, 0, 0);
        }
    }
}
__device__ __forceinline__ float red_gq_max(float v) { v = fmaxf(v, __shfl_xor(v, 16)); v = fmaxf(v, __shfl_xor(v, 32)); return v; }
__device__ __forceinline__ float red_gq_sum(float v) { v += __shfl_xor(v, 16); v += __shfl_xor(v, 32); return v; }
__device__ __forceinline__ void osm_step(f32x4 (&s2)[4], float& m, float& l, f32x4 (&o)[8]) {
    float tm = -INFINITY;
#pragma unroll
    for (int rb = 0; rb < 4; ++rb) tm = fmaxf(tm, fmaxf(fmaxf(s2[rb][0], s2[rb][1]), fmaxf(s2[rb][2], s2[rb][3])));
    tm = red_gq_max(tm);
    const float mn = fmaxf(m, tm), alpha = exp2f(m - mn); float ps = 0.f;
#pragma unroll
    for (int rb = 0; rb < 4; ++rb)
#pragma unroll
        for (int r = 0; r < 4; ++r) { const float p = exp2f(s2[rb][r] - mn); s2[rb][r] = p; ps += p; }
    l = l * alpha + ps; m = mn;
#pragma unroll
    for (int c = 0; c < 8; ++c) o[c] *= alpha;
}
constexpr int NSA_KV0 = 0, NSA_KV1 = 32768, NSA_IMP = 65536, NSA_SELM = 131072, NSA_UNI = 133120, NSA_LIST = 133248, NSA_GATE = 133632;
struct DmaLane { unsigned rowl, chx, chk; };
template <bool KIMG> __device__ __forceinline__ void tile_dma(const bf16_t* src, size_t stride, unsigned char* dst, const DmaLane& D, int w) {
    unsigned ln = D.rowl; asm volatile("" : "+v"(ln));
    const unsigned rowl = ln >> 4, ch = KIMG ? ((ln & 15u) ^ ((4u * ((unsigned)w & 3u) + rowl) & 15u)) : ((ln & 15u) ^ ((rowl << 2) | ((unsigned)w & 3u)));
#pragma unroll
    for (int i2 = 0; i2 < 2; ++i2) { const int row = 4 * (8 * i2 + w) + (int)rowl;
        __builtin_amdgcn_global_load_lds((const unsigned*)(src + (size_t)row * stride + ch * 8), (LAS unsigned*)(dst + (8 * i2 + w) * 1024), 16, 0, 0); }
}
#define DMA_WAIT() asm volatile("s_waitcnt vmcnt(0)" ::: "memory")
__device__ __forceinline__ void qk_tile2(const unsigned char* Kt, const NsaLane& L, const bf16x8 (&qf)[2][4], f32x4 (&acc)[2][4]) {
    int kh = L.kh; asm volatile("" : "+v"(kh)); const unsigned char* Kb = Kt + L.kb;
    bf16x8 fr[4];
#define QK_LD(f) fr[(f) & 3] = *(const bf16x8*)(Kb + ((64 * ((f) & 3)) ^ kh) + ((f) >> 2) * 4096)
    QK_LD(0); QK_LD(1); QK_LD(2);
#pragma unroll
    for (int f = 0; f < 16; ++f) { const int rb = f >> 2, ks = f & 3;
        if (f + 3 < 16) QK_LD(f + 3);
        if (ks == 0) { acc[0][rb] = (f32x4){0.f, 0.f, 0.f, 0.f}; acc[1][rb] = (f32x4){0.f, 0.f, 0.f, 0.f}; }
        acc[0][rb] = __builtin_amdgcn_mfma_f32_16x16x32_bf16(fr[f & 3], qf[0][ks], acc[0][rb], 0, 0, 0); acc[1][rb] = __builtin_amdgcn_mfma_f32_16x16x32_bf16(fr[f & 3], qf[1][ks], acc[1][rb], 0, 0, 0);
        __builtin_amdgcn_sched_barrier(0); }
#undef QK_LD
}
__device__ __forceinline__ void pv_tile2(const unsigned char* Vt, const NsaLane& L, const f32x4 (&p)[2][4], f32x4 (&o)[2][8]) {
    int vh = L.vh; asm volatile("" : "+v"(vh)); const unsigned char* Vb = Vt + L.vb;
    bf16x8 pb[2][2];
#pragma unroll
    for (int ks2 = 0; ks2 < 2; ++ks2)
#pragma unroll
        for (int j = 0; j < 2; ++j) { u32x4 pw; pw.x = cvtpk(p[j][2 * ks2][0], p[j][2 * ks2][1]); pw.y = cvtpk(p[j][2 * ks2][2], p[j][2 * ks2][3]); pw.z = cvtpk(p[j][2 * ks2 + 1][0], p[j][2 * ks2 + 1][1]); pw.w = cvtpk(p[j][2 * ks2 + 1][2], p[j][2 * ks2 + 1][3]); pb[ks2][j] = __builtin_bit_cast(bf16x8, pw); }
    s16x4 va[3][2];
#define PV_LD(f) do { const unsigned char* a_ = Vb + ((32 * ((f) & 7)) ^ vh) + 256 * (32 * ((f) >> 3)); \
        va[(f) % 3][0] = __builtin_amdgcn_ds_read_tr16_b64_v4i16((LAS s16x4*)a_); va[(f) % 3][1] = __builtin_amdgcn_ds_read_tr16_b64_v4i16((LAS s16x4*)(a_ + 256 * 16)); } while (0)
    PV_LD(0); PV_LD(1);
#pragma unroll
    for (int f = 0; f < 16; ++f) { const int c = f & 7, ks2 = f >> 3;
        if (f + 2 < 16) PV_LD(f + 2);
        const s16x4 v0 = va[f % 3][0], v1 = va[f % 3][1];
        const bf16x8 vv = {v0[0], v0[1], v0[2], v0[3], v1[0], v1[1], v1[2], v1[3]};
        o[0][c] = __builtin_amdgcn_mfma_f32_16x16x32_bf16(vv, pb[ks2][0], o[0][c], 0, 0, 0); o[1][c] = __builtin_amdgcn_mfma_f32_16x16x32_bf16(vv, pb[ks2][1], o[1][c], 0, 0, 0);
        __builtin_amdgcn_sched_barrier(0); }
#undef PV_LD
}
__device__ __forceinline__ float max16(const f32x4 (&t)[4]) {
    float tm = fmaxf(fmaxf(fmaxf(t[0][0], t[0][1]), fmaxf(t[0][2], t[0][3])), fmaxf(fmaxf(t[1][0], t[1][1]), fmaxf(t[1][2], t[1][3])));
    return fmaxf(tm, fmaxf(fmaxf(fmaxf(t[2][0], t[2][1]), fmaxf(t[2][2], t[2][3])), fmaxf(fmaxf(t[3][0], t[3][1]), fmaxf(t[3][2], t[3][3]))));
}
__device__ __forceinline__ void osm_fast2(f32x4 (&t)[2][4], float (&m)[2], float (&l)[2], f32x4 (&o)[2][8]) {
#pragma unroll
    for (int j = 0; j < 2; ++j) {
        const float tml = max16(t[j]);
        if (__any(tml > m[j] + 8.0f)) { const float tm = red_gq_max(tml); const float mn = fmaxf(m[j], tm), alpha = ex2(m[j] - mn); l[j] *= alpha; m[j] = mn;
#pragma unroll
            for (int c = 0; c < 8; ++c) o[j][c] *= alpha; }
        float ps = 0.f;
#pragma unroll
        for (int rb = 0; rb < 4; ++rb)
#pragma unroll
            for (int r = 0; r < 4; ++r) { const float p = ex2(t[j][rb][r] - m[j]); t[j][rb][r] = p; ps += p; }
        l[j] += ps;
    }
}
#ifndef NREP_CMP
#define NREP_CMP 1
#endif
#ifndef NREP_WIN
#define NREP_WIN 1
#endif
#ifndef NREP_SEL
#define NREP_SEL 1
#endif
__device__ __forceinline__ void nsa_unit(const Params& P, Frame& F_, int unit) { Frame F = reframe(F_);
    unsigned char* ws = P.ws; const bf16_t* proj = (const bf16_t*)(ws + WS_R1); const bf16_t* kcb = (const bf16_t*)(ws + WS_KC); const float* small = (const float*)(ws + WS_SMALL);
    bf16_t* ymix = (bf16_t*)(ws + WS_R0);
    unsigned char* lds = F.lds; float* imp = (float*)(lds + NSA_IMP); unsigned* selm = (unsigned*)(lds + NSA_SELM); unsigned* uni = (unsigned*)(lds + NSA_UNI); unsigned char* slist = lds + NSA_LIST;
    const int tid = F.tid, lane = F.lane, w = F.wave;
    NsaLane L; L.r16 = lane & 15; L.gq = lane >> 4;
    const int qi = L.r16 >> 2, h = L.r16 & 3;
    {
      L.kb = 256 * L.r16 + 16 * (L.gq ^ (L.r16 & 3)); L.kh = (L.r16 & 12) << 4;
      const unsigned q4 = (unsigned)L.r16 >> 2, p = L.r16 & 3u, Xv = (q4 << 2) | (unsigned)L.gq;
      L.vb = 256 * (4 * L.gq + (int)q4) + 8 * (int)(p & 1u) + 16 * (int)((p >> 1) ^ (Xv & 1u)); L.vh = (int)((Xv & 14u) << 4); }
    const int qb = unit & 255, g = (unit >> 8) & 1, b = unit >> 9;
    const int t0 = qb * 64, head = g * 4 + h;
    int tq[2]; size_t rowq[2];
#pragma unroll
    for (int j = 0; j < 2; ++j) { tq[j] = t0 + 8 * w + 4 * j + qi; rowq[j] = (size_t)b * SEQ + tq[j]; }
    const float slope2 = exp2f(-(float)(head + 1)) * LOG2E, sc2 = 0.08838834764831845f * LOG2E;
    const float lb = slope2 * (float)(4 * L.gq);
    bf16x8 qf[2][4]; float* gatel = (float*)(lds + NSA_GATE) + w * 96 + L.r16;
#pragma unroll
    for (int j = 0; j < 2; ++j) { const bf16_t* qrow = proj + rowq[j] * NPROJ + C_NQ + head * 128;
#pragma unroll
        for (int ks = 0; ks < 4; ++ks) qf[j][ks] = *(const bf16x8*)(qrow + 32 * ks + 8 * L.gq);
#pragma unroll
        for (int k = 0; k < 3; ++k) { const float gv = sigmoid_f(small[rowq[j] * 64 + 16 + head * 3 + k]); if (L.gq == 0) gatel[(j * 3 + k) * 16] = gv; } }
    for (int i = tid; i < 64 * 256; i += 512) imp[i] = 0.f;
    f32x4 o[2][8], acc[2][4];
    u32x2* finl = (u32x2*)(lds + NSA_IMP) + w * 1024 + lane;
    DmaLane D; D.rowl = (unsigned)lane; D.chx = 0u; D.chk = 0u;
    const int ntc = ((t0 + 32) >> 4) / 64 + 1;
    int nlim[2]; nlim[0] = (tq[0] - 31) >> 4; nlim[1] = (tq[1] - 31) >> 4;
    const bf16_t* kc = kcb + (size_t)(0 * 4 + b * 2 + g) * 1024 * 128; const bf16_t* vc = kcb + (size_t)(1 * 4 + b * 2 + g) * 1024 * 128;
    const float slope16 = 16.f * slope2, lbc = 16.f * lb;
    lds_barrier();
    for (int rep_c = 0; rep_c < NREP_CMP; ++rep_c) {
    float m[2] = {-1e30f, -1e30f}, l[2] = {0.f, 0.f};
    lds_barrier();
    tile_dma<true>(kc, 128, lds + NSA_KV0, D, w);
    DMA_WAIT(); lds_barrier();
    for (int tl = 0; tl < ntc; ++tl) {
        const unsigned char* Kt = lds + (tl & 1) * 32768;
        if (tl + 1 < ntc) tile_dma<true>(kc + (size_t)(tl + 1) * 64 * 128, 128, lds + ((tl + 1) & 1) * 32768, D, w);
        qk_tile2(Kt, L, qf, acc);
        const float tb = lbc + slope16 * (float)(64 * tl);
        const bool full = __all(64 * tl + 63 <= nlim[0] && 64 * tl + 63 <= nlim[1]);
#pragma unroll
        for (int j = 0; j < 2; ++j) {
            if (full) {
#pragma unroll
                for (int rb = 0; rb < 4; ++rb)
#pragma unroll
                    for (int r = 0; r < 4; ++r) acc[j][rb][r] = fmaf(acc[j][rb][r], sc2, tb + slope16 * (float)(16 * rb + r));
            } else {
#pragma unroll
                for (int rb = 0; rb < 4; ++rb)
#pragma unroll
                    for (int r = 0; r < 4; ++r) { const int n = 64 * tl + 16 * rb + 4 * L.gq + r; acc[j][rb][r] = (n <= nlim[j]) ? fmaf(acc[j][rb][r], sc2, tb + slope16 * (float)(16 * rb + r)) : -INFINITY; }
            }
            const float tml = max16(acc[j]);
            if (__any(tml > m[j] + 8.0f)) { const float mn = fmaxf(m[j], red_gq_max(tml)); l[j] *= ex2(m[j] - mn); m[j] = mn; }
            float ps = 0.f;
#pragma unroll
            for (int rb = 0; rb < 4; ++rb)
#pragma unroll
                for (int r = 0; r < 4; ++r) ps += ex2(acc[j][rb][r] - m[j]);
            l[j] += ps;
        }
        DMA_WAIT(); lds_barrier();
    }
    float lg_inv[2];
#pragma unroll
    for (int j = 0; j < 2; ++j) { const float lt = red_gq_sum(l[j]); lg_inv[j] = lt > 0.f ? -__log2f(lt) - m[j] : -INFINITY;
#pragma unroll
        for (int c = 0; c < 8; ++c) o[j][c] = (f32x4){0.f, 0.f, 0.f, 0.f}; }
    tile_dma<true>(kc, 128, lds + NSA_KV0, D, w); tile_dma<false>(vc, 128, lds + NSA_KV0 + 16384, D, w);
    DMA_WAIT(); lds_barrier();
    for (int tl = 0; tl < ntc; ++tl) {
        const unsigned char* Kt = lds + (tl & 1) * 32768;
        if (tl + 1 < ntc) { unsigned char* nb_ = lds + ((tl + 1) & 1) * 32768; tile_dma<true>(kc + (size_t)(tl + 1) * 64 * 128, 128, nb_, D, w); tile_dma<false>(vc + (size_t)(tl + 1) * 64 * 128, 128, nb_ + 16384, D, w); }
        qk_tile2(Kt, L, qf, acc);
#pragma unroll
        for (int j = 0; j < 2; ++j) {
            const float tb = lbc + slope16 * (float)(64 * tl) + lg_inv[j];
#pragma unroll
            for (int rb = 0; rb < 4; ++rb) {
#pragma unroll
                for (int r = 0; r < 4; ++r) { const int n = 64 * tl + 16 * rb + 4 * L.gq + r; acc[j][rb][r] = (n <= nlim[j]) ? ex2(fmaf(acc[j][rb][r], sc2, tb + slope16 * (float)(16 * rb + r))) : 0.f; }
                float ia = 2.f * (acc[j][rb][0] + acc[j][rb][1] + acc[j][rb][2]) + acc[j][rb][3], ib = acc[j][rb][3];
                ia = quad_sum(ia); ib = quad_sum(ib);
                const int s0 = 16 * tl + 4 * rb + L.gq;
                if (h == 0 && rep_c == NREP_CMP - 1) { float* ip = imp + (8 * w + 4 * j + qi) * 256 + s0; atomicAdd(ip, ia); if (s0 + 1 < 256) atomicAdd(ip + 1, ib); }
            }
        }
        pv_tile2(Kt + 16384, L, acc, o);
        DMA_WAIT(); lds_barrier();
    }
    }
    const bf16_t* kwin = proj + (size_t)b * SEQ * NPROJ + C_KWIN + g * 128; const bf16_t* vwin = proj + (size_t)b * SEQ * NPROJ + C_VWIN + g * 128;
    const int kt0 = (t0 - 511) > 0 ? (t0 - 511) >> 6 : 0, kt1 = (t0 + 63) >> 6, nwt = kt1 - kt0 + 1;
    for (int jq0 = 0; jq0 < 8; jq0 += 4) {
        unsigned long long comb[4][4], cand[4];
#pragma unroll
        for (int u4 = 0; u4 < 4; ++u4) { const int qq = 8 * w + jq0 + u4, t = t0 + qq, cur = t >> 6; cand[u4] = 0ull;
#pragma unroll
            for (int i = 0; i < 4; ++i) { const int s = lane + 64 * i; const float v = imp[qq * 256 + s]; const bool forced = (s == 0) || (s == cur) || (s == cur - 1); const bool valid = s <= cur;
                const unsigned key = forced ? 0x7F000000u : (valid ? __builtin_bit_cast(unsigned, v) + 1u : 0u);
                comb[u4][i] = ((unsigned long long)key << 8) | (unsigned long long)(255 - s); } }
        for (int bit = 38; bit >= 0; --bit) {
#pragma unroll
            for (int u4 = 0; u4 < 4; ++u4) { const unsigned long long trial = cand[u4] | (1ull << bit);
                const int cnt = __popcll(__ballot(comb[u4][0] >= trial)) + __popcll(__ballot(comb[u4][1] >= trial)) + __popcll(__ballot(comb[u4][2] >= trial)) + __popcll(__ballot(comb[u4][3] >= trial));
                if (cnt >= 16) cand[u4] = trial; } }
#pragma unroll
        for (int u4 = 0; u4 < 4; ++u4) { const int qq = 8 * w + jq0 + u4;
#pragma unroll
            for (int i = 0; i < 4; ++i) { const unsigned long long mk = __ballot(comb[u4][i] >= cand[u4]); if (lane == 0) { selm[qq * 8 + 2 * i] = (unsigned)mk; selm[qq * 8 + 2 * i + 1] = (unsigned)(mk >> 32); } } }
    }
    lds_barrier();
    if (tid < 8) { unsigned uu = 0u; for (int q = 0; q < 64; ++q) uu |= selm[q * 8 + tid]; uni[tid] = uu; }
    const float gt0[2] = {gatel[0], gatel[3 * 16]};
#pragma unroll
    for (int j = 0; j < 2; ++j)
#pragma unroll
        for (int c = 0; c < 8; ++c) { u32x2 fv; fv.x = cvtpk(o[j][c][0] * gt0[j], o[j][c][1] * gt0[j]); fv.y = cvtpk(o[j][c][2] * gt0[j], o[j][c][3] * gt0[j]); finl[(j * 8 + c) * 64] = fv; }
    lds_barrier();
    int nsel = 0;
    { int pre = 0;
#pragma unroll
      for (int wd = 0; wd < 8; ++wd) { const unsigned uw = uni[wd]; if (wd == (tid >> 5) && tid < 256 && ((uw >> (tid & 31)) & 1u)) slist[pre + __popc(uw & ((1u << (tid & 31)) - 1u))] = (unsigned char)tid; pre += __popc(uw); }
      nsel = pre; }
    for (int rep_w = 0; rep_w < NREP_WIN; ++rep_w) {
        float mw_[2] = {-1e30f, -1e30f}, lw[2] = {0.f, 0.f};
        lds_barrier();
        tile_dma<true>(kwin + (size_t)kt1 * 64 * NPROJ, NPROJ, lds + NSA_KV0, D, w); tile_dma<false>(vwin + (size_t)kt1 * 64 * NPROJ, NPROJ, lds + NSA_KV0 + 16384, D, w);
#pragma unroll
        for (int j = 0; j < 2; ++j)
#pragma unroll
            for (int c = 0; c < 8; ++c) o[j][c] = (f32x4){0.f, 0.f, 0.f, 0.f};
        DMA_WAIT(); lds_barrier();
        for (int it = 0; it < nwt; ++it) {
            const unsigned char* Kt = lds + (it & 1) * 32768; const int kt = kt1 - it;
            if (it + 1 < nwt) { unsigned char* nb_ = lds + ((it + 1) & 1) * 32768; tile_dma<true>(kwin + (size_t)(kt - 1) * 64 * NPROJ, NPROJ, nb_, D, w); tile_dma<false>(vwin + (size_t)(kt - 1) * 64 * NPROJ, NPROJ, nb_ + 16384, D, w); }
            qk_tile2(Kt, L, qf, acc);
            const float tb = lb + slope2 * (float)(64 * kt); const int d0[2] = {tq[0] - 64 * kt, tq[1] - 64 * kt};
            const bool full = __all(d0[0] >= 63 && d0[0] < 512 && d0[1] >= 63 && d0[1] < 512);
#pragma unroll
            for (int j = 0; j < 2; ++j) {
                if (full) {
#pragma unroll
                    for (int rb = 0; rb < 4; ++rb)
#pragma unroll
                        for (int r = 0; r < 4; ++r) acc[j][rb][r] = fmaf(acc[j][rb][r], sc2, tb + slope2 * (float)(16 * rb + r));
                } else {
#pragma unroll
                    for (int rb = 0; rb < 4; ++rb)
#pragma unroll
                        for (int r = 0; r < 4; ++r) { const int dist = d0[j] - (16 * rb + 4 * L.gq + r); acc[j][rb][r] = (dist >= 0 && dist < 512) ? fmaf(acc[j][rb][r], sc2, tb + slope2 * (float)(16 * rb + r)) : -INFINITY; }
                }
            }
            osm_fast2(acc, mw_, lw, o);
            pv_tile2(Kt + 16384, L, acc, o);
            DMA_WAIT(); lds_barrier();
        }
        if (rep_w == NREP_WIN - 1) {
#pragma unroll
        for (int j = 0; j < 2; ++j) { const float lt = red_gq_sum(lw[j]); const float il = lt > 0.f ? gatel[(j * 3 + 2) * 16] / lt : 0.f;
#pragma unroll
            for (int c = 0; c < 8; ++c) { const u32x2 fp = finl[(j * 8 + c) * 64]; const float f0 = bflo(fp.x) + o[j][c][0] * il, f1 = bfhi(fp.x) + o[j][c][1] * il, f2 = bflo(fp.y) + o[j][c][2] * il, f3 = bfhi(fp.y) + o[j][c][3] * il;
                u32x2 fv; fv.x = cvtpk(f0, f1); fv.y = cvtpk(f2, f3); finl[(j * 8 + c) * 64] = fv; } } }
    }
    for (int rep_s = 0; rep_s < NREP_SEL; ++rep_s) {
        float ms[2] = {-1e30f, -1e30f}, ls[2] = {0.f, 0.f};
        lds_barrier();
#pragma unroll
        for (int j = 0; j < 2; ++j)
#pragma unroll
            for (int c = 0; c < 8; ++c) o[j][c] = (f32x4){0.f, 0.f, 0.f, 0.f};
        const bf16_t* ksel = proj + (size_t)b * SEQ * NPROJ + C_KSEL + g * 128; const bf16_t* vsel = proj + (size_t)b * SEQ * NPROJ + C_VSEL + g * 128;
        { const int s0_ = slist[nsel - 1]; tile_dma<true>(ksel + (size_t)s0_ * 64 * NPROJ, NPROJ, lds + NSA_KV0, D, w); tile_dma<false>(vsel + (size_t)s0_ * 64 * NPROJ, NPROJ, lds + NSA_KV0 + 16384, D, w); }
        DMA_WAIT(); lds_barrier();
        for (int it = 0; it < nsel; ++it) {
            const unsigned char* Kt = lds + (it & 1) * 32768; const int sblk = slist[nsel - 1 - it];
            if (it + 1 < nsel) { const int sn = slist[nsel - 2 - it]; unsigned char* nb_ = lds + ((it + 1) & 1) * 32768; tile_dma<true>(ksel + (size_t)sn * 64 * NPROJ, NPROJ, nb_, D, w); tile_dma<false>(vsel + (size_t)sn * 64 * NPROJ, NPROJ, nb_ + 16384, D, w); }
            bool mine[2];
#pragma unroll
            for (int j = 0; j < 2; ++j) mine[j] = (selm[(8 * w + 4 * j + qi) * 8 + (sblk >> 5)] >> (sblk & 31)) & 1u;
            if (__any(mine[0] || mine[1])) {
                qk_tile2(Kt, L, qf, acc);
                const float tb = lb + slope2 * (float)(64 * sblk); const int d0[2] = {tq[0] - 64 * sblk, tq[1] - 64 * sblk};
                const bool full = __all(mine[0] && mine[1] && d0[0] >= 63 && d0[1] >= 63);
#pragma unroll
                for (int j = 0; j < 2; ++j) {
                    if (full) {
#pragma unroll
                        for (int rb = 0; rb < 4; ++rb)
#pragma unroll
                            for (int r = 0; r < 4; ++r) acc[j][rb][r] = fmaf(acc[j][rb][r], sc2, tb + slope2 * (float)(16 * rb + r));
                    } else {
#pragma unroll
                        for (int rb = 0; rb < 4; ++rb)
#pragma unroll
                            for (int r = 0; r < 4; ++r) { const int dist = d0[j] - (16 * rb + 4 * L.gq + r); acc[j][rb][r] = (mine[j] && dist >= 0) ? fmaf(acc[j][rb][r], sc2, tb + slope2 * (float)(16 * rb + r)) : -INFINITY; }
                    }
                }
                osm_fast2(acc, ms, ls, o);
                pv_tile2(Kt + 16384, L, acc, o);
            }
            DMA_WAIT(); lds_barrier();
        }
        if (rep_s == NREP_SEL - 1) {
#pragma unroll
        for (int j = 0; j < 2; ++j) { const float lt = red_gq_sum(ls[j]); const float il = lt > 0.f ? gatel[(j * 3 + 1) * 16] / lt : 0.f;
            f32x4 fin[8]; float ss = 0.f;
#pragma unroll
            for (int c = 0; c < 8; ++c) { const u32x2 fp = finl[(j * 8 + c) * 64]; fin[c][0] = bflo(fp.x) + o[j][c][0] * il; fin[c][1] = bfhi(fp.x) + o[j][c][1] * il; fin[c][2] = bflo(fp.y) + o[j][c][2] * il; fin[c][3] = bfhi(fp.y) + o[j][c][3] * il;
                ss += (fin[c][0] * fin[c][0] + fin[c][1] * fin[c][1]) + (fin[c][2] * fin[c][2] + fin[c][3] * fin[c][3]); }
            ss = red_gq_sum(ss);
            const float rn = rsqrtf(ss * (1.0f / 128.f) + EPS);
            bf16_t* yo = ymix + ((size_t)b * SEQ + (t0 + 8 * w + 4 * j + qi)) * DM + 1024 + head * 128;
#pragma unroll
            for (int c = 0; c < 8; ++c) { const int d = 16 * c + 4 * L.gq; const f32x4 gg = *(const f32x4*)(P.nsa_norm_g + d);
                u32x2 wv; wv.x = cvtpk(fin[c][0] * rn * gg[0], fin[c][1] * rn * gg[1]); wv.y = cvtpk(fin[c][2] * rn * gg[2], fin[c][3] * rn * gg[3]); *(u32x2*)(yo + d) = wv; } } }
    }
}
__device__ __forceinline__ bf16x8 afrag8(const unsigned char* img, const NsaLane& L, int mb, int ks) {
    const u32x2 lo = *(const u32x2*)(img + L.a8[ks][0] + mb * 4096), hi = *(const u32x2*)(img + L.a8[ks][1] + mb * 4096);
    const u32x4 v = {lo.x, lo.y, hi.x, hi.y}; return __builtin_bit_cast(bf16x8, v);
}
__device__ __forceinline__ int perm32k(int c) { return (c & ~31) | (((c >> 2) & 3) << 3) | (((c >> 4) & 1) << 2) | (c & 3); }
__device__ __forceinline__ bf16x8 afrag16(const unsigned char* img, const NsaLane& L, int mb, int ks) { return *(const bf16x8*)(img + L.kaddr[ks] + mb * 4096); }
__device__ __forceinline__ void dn_lane_init(NsaLane& L, int lane, int w) {
    L.r16 = lane & 15; L.gq = lane >> 4;
    const unsigned Xk = ((L.r16 & 3u) << 2) | ((unsigned)L.r16 >> 2);
#pragma unroll
    for (int ks = 0; ks < 4; ++ks) { L.kaddr[ks] = 256 * L.r16 + 16 * (int)(((unsigned)(4 * ks + L.gq)) ^ Xk);
#pragma unroll
        for (int hf = 0; hf < 2; ++hf) L.a8[ks][hf] = 256 * L.r16 + 16 * (int)(((unsigned)(4 * ks + 2 * hf + (L.gq >> 1))) ^ Xk) + 8 * (L.gq & 1); }
    const unsigned q4 = (unsigned)L.r16 >> 2, p = L.r16 & 3u, Xv = (q4 << 2) | (unsigned)L.gq;
#pragma unroll
    for (int c = 0; c < 8; ++c) L.vaddr[c] = 256 * (4 * L.gq + (int)q4) + 16 * (int)(((unsigned)(2 * c) + (p >> 1)) ^ Xv) + 8 * (int)(p & 1u);
    L.ubase = 256 * (4 * L.gq + (int)q4) + 16 * (int)(((unsigned)(2 * w) + (p >> 1)) ^ Xv) + 8 * (int)(p & 1u);
}
__device__ __forceinline__ f32x4 tr_c4(const unsigned char* img, const NsaLane& L, int mb) {
    const s16x4 t = __builtin_amdgcn_ds_read_tr16_b64_v4i16((LAS s16x4*)(img + L.ubase + mb * 4096));
    return (f32x4){bf2f((unsigned short)t[0]), bf2f((unsigned short)t[1]), bf2f((unsigned short)t[2]), bf2f((unsigned short)t[3])};
}
__device__ __forceinline__ void pack_tiles(const f32x4* X, int ntile2, bf16x8* out) {
    for (int k = 0; k < ntile2; ++k) { u32x4 v; v.x = cvtpk(X[2 * k][0], X[2 * k][1]); v.y = cvtpk(X[2 * k][2], X[2 * k][3]); v.z = cvtpk(X[2 * k + 1][0], X[2 * k + 1][1]); v.w = cvtpk(X[2 * k + 1][2], X[2 * k + 1][3]); out[k] = __builtin_bit_cast(bf16x8, v); }
}
template <bool HAS_U, bool HAS_OUT>
__device__ __forceinline__ void dn_step(const unsigned char* Wimg, const unsigned char* Kimg, const unsigned char* Uimg, const unsigned char* Qimg, const unsigned char* QKimg,
                                        const float* gct, const NsaLane& L, f32x4 (&S)[8], f32x4 (&o)[4]) {
    bf16x8 sf[4];
#pragma unroll
    for (int k = 0; k < 4; ++k) { u32x4 v; v.x = cvtpk(S[2 * k][0], S[2 * k][1]); v.y = cvtpk(S[2 * k][2], S[2 * k][3]); v.z = cvtpk(S[2 * k + 1][0], S[2 * k + 1][1]); v.w = cvtpk(S[2 * k + 1][2], S[2 * k + 1][3]); sf[k] = __builtin_bit_cast(bf16x8, v); }
    f32x4 wsv[4], o1[4];
#pragma unroll
    for (int mb = 0; mb < 4; ++mb) { wsv[mb] = (f32x4){0.f, 0.f, 0.f, 0.f}; o1[mb] = (f32x4){0.f, 0.f, 0.f, 0.f};
#pragma unroll
        for (int ks = 0; ks < 4; ++ks) { wsv[mb] = __builtin_amdgcn_mfma_f32_16x16x32_bf16(afrag16(Wimg, L, mb, ks), sf[ks], wsv[mb], 0, 0, 0);
            if (HAS_OUT) o1[mb] = __builtin_amdgcn_mfma_f32_16x16x32_bf16(afrag16(Qimg, L, mb, ks), sf[ks], o1[mb], 0, 0, 0); }
        if (mb & 1) asm volatile("" ::: "memory"); }
    f32x4 vn[4], vs[4];
#pragma unroll
    for (int mb = 0; mb < 4; ++mb) { f32x4 uu = (f32x4){0.f, 0.f, 0.f, 0.f}; if (HAS_U) uu = tr_c4(Uimg, L, mb); vn[mb] = uu - wsv[mb];
        vs[mb] = vn[mb] * *(const f32x4*)(gct + 64 + 16 * mb + 4 * L.gq); }
    const float dl = gct[191];
#pragma unroll
    for (int c = 0; c < 8; ++c) S[c] *= dl;
    pv_tile(Kimg, L, vs, S);
    if (HAS_OUT) {
        bf16x8 vf[2];
#pragma unroll
        for (int k = 0; k < 2; ++k) { u32x4 v; v.x = cvtpk(vn[2 * k][0], vn[2 * k][1]); v.y = cvtpk(vn[2 * k][2], vn[2 * k][3]); v.z = cvtpk(vn[2 * k + 1][0], vn[2 * k + 1][1]); v.w = cvtpk(vn[2 * k + 1][2], vn[2 * k + 1][3]); vf[k] = __builtin_bit_cast(bf16x8, v); }
#pragma unroll
        for (int mb = 0; mb < 4; ++mb) { f32x4 o2 = (f32x4){0.f, 0.f, 0.f, 0.f};
#pragma unroll
            for (int k2 = 0; k2 < 2; ++k2) o2 = __builtin_amdgcn_mfma_f32_16x16x32_bf16(afrag16(QKimg, L, mb, k2), vf[k2], o2, 0, 0, 0);
            o[mb] = *(const f32x4*)(gct + 128 + 16 * mb + 4 * L.gq) * o1[mb] + o2; }
    }
}
constexpr int DP_K = 0, DP_Q = 16384, DP_V = 32768, DP_LOFF = 49152, DP_LD = 65536, DP_T = 69632, DP_TAB = 71680, DP_RAW = 73728;
__device__ __forceinline__ void dn_prep_unit(const Params& P, Frame& F_, int unit) { Frame F = reframe(F_);
    unsigned char* ws = P.ws; const bf16_t* proj = (const bf16_t*)(ws + WS_R1); const float* small = (const float*)(ws + WS_SMALL);
    bf16_t* qn = (bf16_t*)(ws + WS_QN); bf16_t* kn = (bf16_t*)(ws + WS_KN); bf16_t* ub = (bf16_t*)(ws + WS_VN); bf16_t* wb = (bf16_t*)(ws + WS_WN); bf16_t* qkb = (bf16_t*)(ws + WS_QK); float* gcb = (float*)(ws + WS_GDEC);
    unsigned char* lds = F.lds; unsigned char* Kimg = lds + DP_K; unsigned char* Qimg = lds + DP_Q; unsigned char* Vimg = lds + DP_V; unsigned char* Loff = lds + DP_LOFF; float* Ld = (float*)(lds + DP_LD); unsigned char* Timg = lds + DP_T;
    float* gt = (float*)(lds + DP_TAB); float* bt = gt + 64; float* gct = gt + 128; unsigned char* raw = lds + DP_RAW;
    const int tid = F.tid, lane = F.lane, w = F.wave;
    const int chain = unit >> 8, cch = unit & 255, b = chain >> 3, h = chain & 7, t0 = cch * 64; const size_t row0 = (size_t)b * SEQ + t0;
    { u32x4 rv[7];
#pragma unroll
      for (int k = 0; k < 7; ++k) { const int i = tid + 512 * k, ic = i < 67 * 48 ? i : 67 * 48 - 1; const int rr = ic / 48, cc = ic % 48, s = cc >> 4, c16 = cc & 15; const int tr = (t0 + rr - 3) >= 0 ? rr - 3 : -t0;
          rv[k] = *(const u32x4*)(proj + (row0 + tr) * NPROJ + s * 1024 + h * 128 + c16 * 8); }
#pragma unroll
      for (int k = 0; k < 7; ++k) { const int i = tid + 512 * k; if (i < 67 * 48) { const int rr = i / 48, cc = i % 48; const bool ok = (t0 + rr - 3) >= 0;
          *(u32x4*)(raw + rr * 768 + cc * 16) = ok ? rv[k] : (u32x4){0u, 0u, 0u, 0u}; } } }
    float cw[3][4][2];
#pragma unroll
    for (int s = 0; s < 3; ++s)
#pragma unroll
        for (int i = 0; i < 4; ++i) { cw[s][i][0] = P.conv_w[i * 3072 + s * 1024 + h * 128 + 2 * lane]; cw[s][i][1] = P.conv_w[i * 3072 + s * 1024 + h * 128 + 2 * lane + 1]; }
    const float Ah = -__expf(P.a_log[h]), dtb = P.dt_bias[h];
    const size_t grow = row0 + 8 * w + (lane & 7); const float sb1 = small[grow * 64 + h], sa1 = small[grow * 64 + 8 + h];
    lds_barrier();
#pragma unroll
    for (int ii = 0; ii < 8; ++ii) {
        const int i = 8 * w + ii; const size_t row = row0 + i;
        float o[3][2];
#pragma unroll
        for (int s = 0; s < 3; ++s) { float a0 = 0.f, a1 = 0.f;
#pragma unroll
            for (int j = 0; j < 4; ++j) { const unsigned wv = *(const unsigned*)(raw + (i + j) * 768 + s * 256 + 4 * lane); a0 += cw[s][j][0] * bflo(wv); a1 += cw[s][j][1] * bfhi(wv); }
            o[s][0] = silu_f(a0); o[s][1] = silu_f(a1); }
        const float sq = wave_sum(o[0][0] * o[0][0] + o[0][1] * o[0][1]), sk = wave_sum(o[1][0] * o[1][0] + o[1][1] * o[1][1]);
        const float rq = rsqrtf(sq + EPS) * 0.08838834764831845f, rk = rsqrtf(sk + EPS);
        const unsigned qw = cvtpk(o[0][0] * rq, o[0][1] * rq), kw = cvtpk(o[1][0] * rk, o[1][1] * rk), vw = cvtpk(o[2][0], o[2][1]);
        const size_t oo = row * 1024 + h * 128 + 2 * lane;
        *(unsigned*)(qn + row * 1024 + h * 128 + perm32k(2 * lane)) = qw; *(unsigned*)(kn + oo) = kw;
        const unsigned io = off_b(i, lane >> 2) + (lane & 3) * 4;
        *(unsigned*)(Kimg + io) = kw; *(unsigned*)(Qimg + io) = qw; *(unsigned*)(Vimg + io) = vw;
    }
    { const float bb = sigmoid_f(sb1); const float aa = sa1 + dtb; const float gi = Ah * (aa > 20.f ? aa : log1pf(__expf(aa)));
      if (lane < 8) { gt[8 * w + lane] = gi; bt[8 * w + lane] = bb; } }
    lds_barrier();
    { const float g = wave_scan(gt[lane]);
      gct[lane] = g;
      if (w == 0) { const float g63 = __builtin_bit_cast(float, __builtin_amdgcn_readlane(__builtin_bit_cast(int, g), 63)); gcb[(row0 + lane) * 8 + h] = __expf(g); ((float*)(ws + WS_BETA))[(row0 + lane) * 8 + h] = __expf(g63 - g); } }
    NsaLane L; dn_lane_init(L, lane, w);
#define DN_GTILE(which, tI_) do { const int mb = ((tI_) >> 2) & 3, nb = (tI_) & 3; f32x4 acc = (f32x4){0.f, 0.f, 0.f, 0.f}; \
        if (mb >= nb) { const unsigned char* Aimg = (which) ? Qimg : Kimg; \
            _Pragma("unroll") for (int ks = 0; ks < 4; ++ks) { const bf16x8 a = *(const bf16x8*)(Aimg + L.kaddr[ks] + mb * 4096), bq = *(const bf16x8*)(Kimg + L.kaddr[ks] + nb * 4096); acc = __builtin_amdgcn_mfma_f32_16x16x32_bf16(a, bq, acc, 0, 0, 0); } } \
        const int j = 16 * nb + L.r16; const float gj = gct[j]; \
        _Pragma("unroll") for (int r = 0; r < 4; ++r) { const int i = 16 * mb + 4 * L.gq + r; const float dec = __expf(gct[i] - gj); \
            if ((which) == 0) { const float lv = (i > j) ? bt[i] * dec * acc[r] : 0.f; \
                *(bf16_t*)(Loff + off_b(i, j >> 3) + (j & 7) * 2) = (bf16_t)f2bf(mb > nb ? lv : 0.f); \
                if (mb == nb) Ld[mb * 256 + (4 * L.gq + r) * 16 + L.r16] = lv; } \
            else qkb[(size_t)unit * 4096 + i * 64 + perm32k(j)] = (bf16_t)f2bf((i >= j) ? dec * acc[r] : 0.f); } } while (0)
    DN_GTILE(0, 2 * w); DN_GTILE(0, 2 * w + 1);
    lds_barrier();
    if (w > 0) { for (int tI = w - 1; tI < 16; tI += 7) DN_GTILE(1, tI); }
    if (w == 0) { const int blk = lane >> 4, c = lane & 15; const float* Lb = Ld + blk * 256; asm volatile("" : "+v"(Lb));
        float Tc[16];
#pragma unroll
        for (int i = 0; i < 16; ++i) { float a = (i == c) ? 1.0f : 0.f;
#pragma unroll
            for (int j4 = 0; j4 < (i + 3) / 4; ++j4) { const f32x4 l4 = *(const f32x4*)(Lb + i * 16 + 4 * j4);
#pragma unroll
                for (int jj = 0; jj < 4; ++jj) if (4 * j4 + jj < i) a -= l4[jj] * Tc[4 * j4 + jj]; }
            Tc[i] = a; *(bf16_t*)(Timg + blk * 512 + i * 32 + c * 2) = (bf16_t)f2bf(a); }
    }
#undef DN_GTILE
    lds_barrier();
    {
        const bool isw = w >= 4; const unsigned char* Simg = isw ? Kimg : Vimg; bf16_t* dstb = (isw ? wb : ub) + row0 * 1024 + h * 128;
        const unsigned q4 = (unsigned)L.r16 >> 2, p = L.r16 & 3u, Xv = (q4 << 2) | (unsigned)L.gq;
        int ub_[2];
#pragma unroll
        for (int cbi = 0; cbi < 2; ++cbi) { const int cb = 2 * (w & 3) + cbi; ub_[cbi] = 256 * (4 * L.gq + (int)q4) + 16 * (int)(((unsigned)(2 * cb) + (p >> 1)) ^ Xv) + 8 * (int)(p & 1u); }
        f32x4 X[2][4];
#pragma unroll
        for (int cbi = 0; cbi < 2; ++cbi)
#pragma unroll
            for (int bb = 0; bb < 4; ++bb) X[cbi][bb] = (f32x4){0.f, 0.f, 0.f, 0.f};
#pragma unroll
        for (int bb = 0; bb < 4; ++bb) {
            const f32x4 bt4 = *(const f32x4*)(bt + 16 * bb + 4 * L.gq), gc4 = *(const f32x4*)(gct + 16 * bb + 4 * L.gq);
            const u32x2 tl = *(const u32x2*)(Timg + bb * 512 + L.r16 * 32 + L.gq * 8);
            const u32x4 ta = {tl.x, tl.y, 0u, 0u};
            f32x4 Y[2];
#pragma unroll
            for (int cbi = 0; cbi < 2; ++cbi) {
                const s16x4 tv = __builtin_amdgcn_ds_read_tr16_b64_v4i16((LAS s16x4*)(Simg + ub_[cbi] + bb * 4096));
#pragma unroll
                for (int r = 0; r < 4; ++r) Y[cbi][r] = bf2f((unsigned short)tv[r]) * bt4[r] * (isw ? __expf(gc4[r]) : 1.0f);
            }
            if (bb > 0) {
#pragma unroll
                for (int cbi = 0; cbi < 2; ++cbi) { f32x4 upd = (f32x4){0.f, 0.f, 0.f, 0.f};
#pragma unroll
                    for (int ks = 0; ks < 2; ++ks) if (2 * ks < bb) { u32x4 xv; xv.x = cvtpk(X[cbi][2 * ks][0], X[cbi][2 * ks][1]); xv.y = cvtpk(X[cbi][2 * ks][2], X[cbi][2 * ks][3]); xv.z = cvtpk(X[cbi][2 * ks + 1][0], X[cbi][2 * ks + 1][1]); xv.w = cvtpk(X[cbi][2 * ks + 1][2], X[cbi][2 * ks + 1][3]);
                        upd = __builtin_amdgcn_mfma_f32_16x16x32_bf16(afrag8(Loff, L, bb, ks), __builtin_bit_cast(bf16x8, xv), upd, 0, 0, 0); }
                    Y[cbi] = Y[cbi] - upd; }
            }
#pragma unroll
            for (int cbi = 0; cbi < 2; ++cbi) { const int cb = 2 * (w & 3) + cbi;
                const u32x4 yb = {cvtpk(Y[cbi][0], Y[cbi][1]), cvtpk(Y[cbi][2], Y[cbi][3]), 0u, 0u};
                X[cbi][bb] = __builtin_amdgcn_mfma_f32_16x16x32_bf16(__builtin_bit_cast(bf16x8, ta), __builtin_bit_cast(bf16x8, yb), (f32x4){0.f, 0.f, 0.f, 0.f}, 0, 0, 0);
#pragma unroll
                for (int r = 0; r < 4; ++r) dstb[(size_t)(16 * bb + 4 * L.gq + r) * 1024 + (isw ? perm32k(16 * cb + L.r16) : 16 * cb + L.r16)] = (bf16_t)f2bf(X[cbi][bb][r]); }
        }
    }
    lds_barrier();
}
constexpr int DQ_K = 0, DQ_Q = 16384, DQ_V = 32768, DQ_R = 49152, DQ_LD = DQ_R + 16384, DQ_T = DQ_R + 20480, DQ_TAB = DQ_R + 22528, DQ_HALF = 73728;
__device__ __forceinline__ void dn_prep_pair(const Params& P, Frame& F_, int c, int k) { Frame F = reframe(F_);
    unsigned char* ws = P.ws; const bf16_t* proj = (const bf16_t*)(ws + WS_R1); const float* small = (const float*)(ws + WS_SMALL);
    bf16_t* qn = (bf16_t*)(ws + WS_QN); bf16_t* kn = (bf16_t*)(ws + WS_KN); bf16_t* ub = (bf16_t*)(ws + WS_VN); bf16_t* wb = (bf16_t*)(ws + WS_WN); bf16_t* qkb = (bf16_t*)(ws + WS_QK); float* gcb = (float*)(ws + WS_GDEC);
    const int tid = F.tid, lane = F.lane, w = F.wave, hf = w >> 2, hw = w & 3, htid = tid & 255;
    unsigned char* lds = F.lds + hf * DQ_HALF; unsigned char* Kimg = lds + DQ_K; unsigned char* Qimg = lds + DQ_Q; unsigned char* Vimg = lds + DQ_V; unsigned char* Loff = lds + DQ_R; float* Ld = (float*)(lds + DQ_LD); unsigned char* Timg = lds + DQ_T;
    float* gt = (float*)(lds + DQ_TAB); float* bt = gt + 64; float* gct = gt + 128; unsigned char* raw = lds + DQ_R;
    const int chain = hf * 8 + k, b = hf, h = k, unit = chain * 256 + c, t0 = c * 64; const size_t row0 = (size_t)b * SEQ + t0;
    u32x4 rv[3][5];
#pragma unroll
    for (int s = 0; s < 3; ++s)
#pragma unroll
        for (int kk = 0; kk < 5; ++kk) { const int i = htid + 256 * kk, ic = i < 67 * 16 ? i : 67 * 16 - 1; const int rr = ic >> 4, c16 = ic & 15; const int tr = (t0 + rr - 3) >= 0 ? rr - 3 : -t0;
            rv[s][kk] = *(const u32x4*)(proj + (row0 + tr) * NPROJ + s * 1024 + h * 128 + c16 * 8); }
    float cw[3][4][2];
#pragma unroll
    for (int s = 0; s < 3; ++s)
#pragma unroll
        for (int i = 0; i < 4; ++i) { const float2 c2 = *(const float2*)(P.conv_w + i * 3072 + s * 1024 + h * 128 + 2 * lane); cw[s][i][0] = c2.x; cw[s][i][1] = c2.y; }
    const float Ah = -__expf(P.a_log[h]), dtb = P.dt_bias[h];
    const size_t grow = row0 + 16 * hw + (lane & 15); const float sb1 = small[grow * 64 + h], sa1 = small[grow * 64 + 8 + h];
#pragma unroll
    for (int s = 0; s < 3; ++s) {
#pragma unroll
        for (int kk = 0; kk < 5; ++kk) { const int i = htid + 256 * kk; if (i < 67 * 16) { const bool ok = (t0 + (i >> 4) - 3) >= 0; *(u32x4*)(raw + 16 * i) = ok ? rv[s][kk] : (u32x4){0u, 0u, 0u, 0u}; } }
        lds_barrier();
        unsigned char* img = s == 0 ? Qimg : (s == 1 ? Kimg : Vimg);
        float o0[16], o1[16], sm[16];
#pragma unroll
        for (int ii = 0; ii < 16; ++ii) { const int i = 16 * hw + ii;
            float a0 = 0.f, a1 = 0.f;
#pragma unroll
            for (int j = 0; j < 4; ++j) { const unsigned wv = *(const unsigned*)(raw + (i + j) * 256 + 4 * lane); a0 += cw[s][j][0] * bflo(wv); a1 += cw[s][j][1] * bfhi(wv); }
            o0[ii] = silu_f(a0); o1[ii] = silu_f(a1); sm[ii] = o0[ii] * o0[ii] + o1[ii] * o1[ii]; }
        if (s < 2) {
#pragma unroll
            for (int ii = 0; ii < 16; ++ii) sm[ii] = wave_sum(sm[ii]); }
#pragma unroll
        for (int ii = 0; ii < 16; ++ii) { const int i = 16 * hw + ii; const size_t row = row0 + i;
            unsigned pk;
            if (s < 2) { const float r = __builtin_amdgcn_rsqf(sm[ii] + EPS) * (s == 0 ? 0.08838834764831845f : 1.0f); pk = cvtpk(o0[ii] * r, o1[ii] * r);
                if (s == 0) *(unsigned*)(qn + row * 1024 + h * 128 + perm32k(2 * lane)) = pk; else *(unsigned*)(kn + row * 1024 + h * 128 + 2 * lane) = pk; }
            else pk = cvtpk(o0[ii], o1[ii]);
            *(unsigned*)(img + off_b(i, lane >> 2) + (lane & 3) * 4) = pk;
        }
        if (s == 2) { const float bb = sigmoid_f(sb1); const float aa = sa1 + dtb; const float gi = Ah * (aa > 20.f ? aa : log1pf(__expf(aa)));
            if (lane < 16) { gt[16 * hw + lane] = gi; bt[16 * hw + lane] = bb; } }
        lds_barrier();
    }
    { const float g = wave_scan(gt[lane]);
      gct[lane] = g;
      if (hw == 0) { const float g63 = __builtin_bit_cast(float, __builtin_amdgcn_readlane(__builtin_bit_cast(int, g), 63)); gcb[(row0 + lane) * 8 + h] = __expf(g); ((float*)(ws + WS_BETA))[(row0 + lane) * 8 + h] = __expf(g63 - g); } }
    NsaLane L; dn_lane_init(L, lane, hw);
#define DN_GTILE(which, tI_) do { const int mb = ((tI_) >> 2) & 3, nb = (tI_) & 3; f32x4 acc = (f32x4){0.f, 0.f, 0.f, 0.f}; \
        const f32x4 gi4 = *(const f32x4*)(gct + 16 * mb + 4 * L.gq), bi4 = *(const f32x4*)(bt + 16 * mb + 4 * L.gq); const int j = 16 * nb + L.r16; const float gj = gct[j];        \
        if (mb >= nb) { const unsigned char* Aimg = (which) ? Qimg : Kimg; \
            _Pragma("unroll") for (int ks = 0; ks < 4; ++ks) { const bf16x8 a = *(const bf16x8*)(Aimg + L.kaddr[ks] + mb * 4096), bq = *(const bf16x8*)(Kimg + L.kaddr[ks] + nb * 4096); acc = __builtin_amdgcn_mfma_f32_16x16x32_bf16(a, bq, acc, 0, 0, 0); } } \
        _Pragma("unroll") for (int r = 0; r < 4; ++r) { const int i = 16 * mb + 4 * L.gq + r; const float dec = __expf(gi4[r] - gj); \
            if ((which) == 0) { const float lv = (i > j) ? bi4[r] * dec * acc[r] : 0.f; \
                *(bf16_t*)(Loff + off_b(i, j >> 3) + (j & 7) * 2) = (bf16_t)f2bf(mb > nb ? lv : 0.f); \
                if (mb == nb) Ld[mb * 256 + (4 * L.gq + r) * 16 + L.r16] = lv; } \
            else qkb[(size_t)unit * 4096 + i * 64 + perm32k(j)] = (bf16_t)f2bf((i >= j) ? dec * acc[r] : 0.f); } } while (0)
    for (int q = 0; q < 4; ++q) DN_GTILE(0, 4 * hw + q);
    lds_barrier();
    if (hw > 0) { for (int tI = hw - 1; tI < 16; tI += 3) DN_GTILE(1, tI); }
    if (hw == 0) { int blk = lane >> 4; const int cc = lane & 15; asm volatile("" : "+v"(blk));
        const LAS float* Lb = (const LAS float*)(LAS unsigned char*)Ld + blk * 256;
        float Tc[16];
#pragma unroll
        for (int i = 0; i < 16; ++i) { float a = (i == cc) ? 1.0f : 0.f;
#pragma unroll
            for (int j4 = 0; j4 < (i + 3) / 4; ++j4) { const f32x4 l4 = *(const LAS f32x4*)(Lb + i * 16 + 4 * j4);
#pragma unroll
                for (int jj = 0; jj < 4; ++jj) if (4 * j4 + jj < i) a -= l4[jj] * Tc[4 * j4 + jj]; }
            Tc[i] = a; *(bf16_t*)(Timg + blk * 512 + i * 32 + cc * 2) = (bf16_t)f2bf(a); }
    }
#undef DN_GTILE
    lds_barrier();
    {
        const bool isw = hw >= 2; const unsigned char* Simg = isw ? Kimg : Vimg; bf16_t* dstb = (isw ? wb : ub) + row0 * 1024 + h * 128;
        const unsigned q4 = (unsigned)L.r16 >> 2, p = L.r16 & 3u, Xv = (q4 << 2) | (unsigned)L.gq;
        int ub_[4];
#pragma unroll
        for (int cbi = 0; cbi < 4; ++cbi) { const int cb = 4 * (hw & 1) + cbi; ub_[cbi] = 256 * (4 * L.gq + (int)q4) + 16 * (int)(((unsigned)(2 * cb) + (p >> 1)) ^ Xv) + 8 * (int)(p & 1u); }
        f32x4 X[4][4];
#pragma unroll
        for (int cbi = 0; cbi < 4; ++cbi)
#pragma unroll
            for (int bb = 0; bb < 4; ++bb) X[cbi][bb] = (f32x4){0.f, 0.f, 0.f, 0.f};
#pragma unroll
        for (int bb = 0; bb < 4; ++bb) {
            const f32x4 bt4 = *(const f32x4*)(bt + 16 * bb + 4 * L.gq), gc4 = *(const f32x4*)(gct + 16 * bb + 4 * L.gq);
            const u32x2 tl = *(const u32x2*)(Timg + bb * 512 + L.r16 * 32 + L.gq * 8);
            const u32x4 ta = {tl.x, tl.y, 0u, 0u};
            f32x4 Y[4];
#pragma unroll
            for (int cbi = 0; cbi < 4; ++cbi) {
                const s16x4 tv = __builtin_amdgcn_ds_read_tr16_b64_v4i16((LAS s16x4*)(Simg + ub_[cbi] + bb * 4096));
#pragma unroll
                for (int r = 0; r < 4; ++r) Y[cbi][r] = bf2f((unsigned short)tv[r]) * bt4[r] * (isw ? __expf(gc4[r]) : 1.0f);
            }
            if (bb > 0) {
#pragma unroll
                for (int cbi = 0; cbi < 4; ++cbi) { f32x4 upd = (f32x4){0.f, 0.f, 0.f, 0.f};
#pragma unroll
                    for (int ks = 0; ks < 2; ++ks) if (2 * ks < bb) { u32x4 xv; xv.x = cvtpk(X[cbi][2 * ks][0], X[cbi][2 * ks][1]); xv.y = cvtpk(X[cbi][2 * ks][2], X[cbi][2 * ks][3]); xv.z = cvtpk(X[cbi][2 * ks + 1][0], X[cbi][2 * ks + 1][1]); xv.w = cvtpk(X[cbi][2 * ks + 1][2], X[cbi][2 * ks + 1][3]);
                        upd = __builtin_amdgcn_mfma_f32_16x16x32_bf16(afrag8(Loff, L, bb, ks), __builtin_bit_cast(bf16x8, xv), upd, 0, 0, 0); }
                    Y[cbi] = Y[cbi] - upd; }
            }
#pragma unroll
            for (int cbi = 0; cbi < 4; ++cbi) { const int cb = 4 * (hw & 1) + cbi;
                const u32x4 yb = {cvtpk(Y[cbi][0], Y[cbi][1]), cvtpk(Y[cbi][2], Y[cbi][3]), 0u, 0u};
                X[cbi][bb] = __builtin_amdgcn_mfma_f32_16x16x32_bf16(__builtin_bit_cast(bf16x8, ta), __builtin_bit_cast(bf16x8, yb), (f32x4){0.f, 0.f, 0.f, 0.f}, 0, 0, 0);
                { const unsigned p01 = cvtpk(X[cbi][bb][0], X[cbi][bb][1]), p23 = cvtpk(X[cbi][bb][2], X[cbi][bb][3]);
                  bf16_t* d0 = dstb + (size_t)(16 * bb + 4 * L.gq) * 1024 + (isw ? perm32k(16 * cb + L.r16) : 16 * cb + L.r16);
                  d0[0] = (bf16_t)p01; d0[1024] = (bf16_t)(p01 >> 16); d0[2048] = (bf16_t)p23; d0[3072] = (bf16_t)(p23 >> 16); } }
        }
    }
    lds_barrier();
}
__device__ __forceinline__ void small_gemm_chunk(const Params& P, Frame& F_, int c) { Frame F = reframe(F_);
    unsigned char* ws = P.ws; const bf16_t* xb = (const bf16_t*)(ws + WS_R0); const bf16_t* bt = (const bf16_t*)(ws + WS_BTIN) + (size_t)6656 * DM; float* small = (float*)(ws + WS_SMALL);
    unsigned char* lds = F.lds;
    const int tid = F.tid, lane = F.lane, w = F.wave, r16 = lane & 15, gq = lane >> 4; const size_t row0 = (size_t)(w >> 2) * SEQ + 64 * c + 16 * (w & 3);
    const bf16_t* xr = xb + (row0 + r16) * DM + 8 * gq;
    f32x4 acc[3];
#pragma unroll
    for (int nb = 0; nb < 3; ++nb) acc[nb] = (f32x4){0.f, 0.f, 0.f, 0.f};
    for (int kq = 0; kq < 4; ++kq) {
        u32x4 wv[6]; bf16x8 a[16];
#pragma unroll
        for (int i = 0; i < 6; ++i) { const int ci = tid + 512 * i, rr = ci >> 6, cc = ci & 63; wv[i] = *(const u32x4*)(bt + (size_t)rr * DM + kq * 512 + cc * 8); }
#pragma unroll
        for (int k = 0; k < 16; ++k) a[k] = *(const bf16x8*)(xr + 32 * (kq * 16 + k));
        __syncthreads();
#pragma unroll
        for (int i = 0; i < 6; ++i) { const int ci = tid + 512 * i, rr = ci >> 6, cc = ci & 63; *(u32x4*)(lds + rr * 1040 + cc * 16) = wv[i]; }
        __syncthreads();
#pragma unroll
        for (int k = 0; k < 16; ++k)
#pragma unroll
            for (int nb = 0; nb < 3; ++nb) { const bf16x8 bq = *(const bf16x8*)(lds + (16 * nb + r16) * 1040 + (4 * k + gq) * 16); acc[nb] = __builtin_amdgcn_mfma_f32_16x16x32_bf16(a[k], bq, acc[nb], 0, 0, 0); }
    }
#pragma unroll
    for (int nb = 0; nb < 3; ++nb)
#pragma unroll
        for (int r = 0; r < 4; ++r) small[(row0 + 4 * gq + r) * 64 + 16 * nb + r16] = acc[nb][r];
}
constexpr int DS_W = 0, DS_K = 16384, DS_U = 32768, DS_Q = 49152, DS_QK = 65536, DS_Z = 81920, DS_TAB = 98304;
constexpr int NSEG = 16, CPS = 16;
__device__ __forceinline__ void dn_passA_unit(const Params& P, Frame& F_, int unit) { Frame F = reframe(F_);
    unsigned char* ws = P.ws; const bf16_t* kn = (const bf16_t*)(ws + WS_KN); const bf16_t* ub = (const bf16_t*)(ws + WS_VN); const bf16_t* wb = (const bf16_t*)(ws + WS_WN); const float* gcb = (const float*)(ws + WS_GDEC); float* mn = (float*)(ws + WS_MN);
    unsigned char* lds = F.lds; float* gct = (float*)(lds + DS_TAB);
    const int tid = F.tid, lane = F.lane, w = F.wave; const int part = unit & 1, cs = unit >> 1, chain = cs / 15, seg = cs % 15, b = chain >> 3, h = chain & 7;
    NsaLane L; dn_lane_init(L, lane, w);
    f32x4 S[8], dummy[4];
#pragma unroll
    for (int c = 0; c < 8; ++c)
#pragma unroll
        for (int r = 0; r < 4; ++r) S[c][r] = (part && c == w && 4 * L.gq + r == L.r16) ? 1.0f : 0.f;
    T2 rW, rK, rU; float rg = 0.f; const float* ekb = (const float*)(ws + WS_BETA);
    { const size_t row0 = (size_t)b * SEQ + (size_t)(seg * CPS) * 64; const size_t go = row0 * 1024 + h * 128;
      t2_load(rW, wb + go, 1024, tid); t2_load(rK, kn + go, 1024, tid); if (!part) t2_load(rU, ub + go, 1024, tid); if (tid < 128) rg = (tid < 64 ? ekb : gcb)[(row0 + (tid & 63)) * 8 + h]; }
    for (int cc = 0; cc < CPS; ++cc) {
        lds_barrier();
        t2_store(rW, lds + DS_W, tid); t2_store(rK, lds + DS_K, tid); if (!part) t2_store(rU, lds + DS_U, tid); if (tid < 128) gct[64 + tid] = rg;
        if (cc + 1 < CPS) { const size_t row0 = (size_t)b * SEQ + (size_t)(seg * CPS + cc + 1) * 64; const size_t go = row0 * 1024 + h * 128;
            t2_load(rW, wb + go, 1024, tid); t2_load(rK, kn + go, 1024, tid); if (!part) t2_load(rU, ub + go, 1024, tid); if (tid < 128) rg = (tid < 64 ? ekb : gcb)[(row0 + (tid & 63)) * 8 + h]; }
        lds_barrier();
        if (!part) dn_step<true, false>(lds + DS_W, lds + DS_K, lds + DS_U, lds + DS_Q, lds + DS_QK, gct, L, S, dummy);
        else dn_step<false, false>(lds + DS_W, lds + DS_K, lds + DS_U, lds + DS_Q, lds + DS_QK, gct, L, S, dummy);
    }
    float* no = mn + ((size_t)(chain * NSEG + seg) * 2 + part) * 16384;
#pragma unroll
    for (int c = 0; c < 8; ++c)
#pragma unroll
        for (int r = 0; r < 4; ++r) no[(16 * c + 4 * L.gq + r) * 128 + 16 * w + L.r16] = S[c][r];
}
__device__ __forceinline__ void dn_passB_unit(const Params& P, Frame& F_, int chain) { Frame F = reframe(F_);
    unsigned char* ws = P.ws; const float* mn = (const float*)(ws + WS_MN); float* sst = (float*)(ws + WS_SST);
    unsigned char* lds = F.lds; const int tid = F.tid, lane = F.lane, w = F.wave;
    NsaLane L; dn_lane_init(L, lane, w);
    f32x4 S[8];
#pragma unroll
    for (int c = 0; c < 8; ++c) S[c] = (f32x4){0.f, 0.f, 0.f, 0.f};
    for (int seg = 0; seg < NSEG - 1; ++seg) {
        const float* nB = mn + ((size_t)(chain * NSEG + seg) * 2 + 0) * 16384; const float* nA = nB + 16384;
        lds_barrier();
#pragma unroll
        for (int k = 0; k < 4; ++k) { const int idx = tid + 512 * k, row = idx >> 4, ch = idx & 15; const f32x4 a = *(const f32x4*)(nA + row * 128 + ch * 8), bq = *(const f32x4*)(nA + row * 128 + ch * 8 + 4);
            u32x4 v; v.x = cvtpk(a[0], a[1]); v.y = cvtpk(a[2], a[3]); v.z = cvtpk(bq[0], bq[1]); v.w = cvtpk(bq[2], bq[3]); *(u32x4*)(lds + off_b(row, ch)) = v; }
        lds_barrier();
        bf16x8 sf[4];
#pragma unroll
        for (int k = 0; k < 4; ++k) { u32x4 v; v.x = cvtpk(S[2 * k][0], S[2 * k][1]); v.y = cvtpk(S[2 * k][2], S[2 * k][3]); v.z = cvtpk(S[2 * k + 1][0], S[2 * k + 1][1]); v.w = cvtpk(S[2 * k + 1][2], S[2 * k + 1][3]); sf[k] = __builtin_bit_cast(bf16x8, v); }
        float* so = sst + ((size_t)chain * NSEG + seg + 1) * 16384;
        f32x4 nv[8];
#pragma unroll
        for (int mb = 0; mb < 8; ++mb)
#pragma unroll
            for (int r = 0; r < 4; ++r) nv[mb][r] = nB[(16 * mb + 4 * L.gq + r) * 128 + 16 * w + L.r16];
#pragma unroll
        for (int mb = 0; mb < 8; ++mb) { f32x4 acc = nv[mb];
#pragma unroll
            for (int ks = 0; ks < 4; ++ks) acc = __builtin_amdgcn_mfma_f32_16x16x32_bf16(afrag8(lds, L, mb, ks), sf[ks], acc, 0, 0, 0);
            S[mb] = acc;
#pragma unroll
            for (int r = 0; r < 4; ++r) so[(16 * mb + 4 * L.gq + r) * 128 + 16 * w + L.r16] = acc[r]; }
    }
}
__device__ __forceinline__ void dn_passC_unit(const Params& P, Frame& F_, int unit) { Frame F = reframe(F_);
    unsigned char* ws = P.ws; const bf16_t* proj = (const bf16_t*)(ws + WS_R1); const bf16_t* qn = (const bf16_t*)(ws + WS_QN); const bf16_t* kn = (const bf16_t*)(ws + WS_KN); const bf16_t* ub = (const bf16_t*)(ws + WS_VN); const bf16_t* wb = (const bf16_t*)(ws + WS_WN);
    const bf16_t* qkb = (const bf16_t*)(ws + WS_QK); const float* gcb = (const float*)(ws + WS_GDEC); const float* sst = (const float*)(ws + WS_SST); bf16_t* ymix = (bf16_t*)(ws + WS_R0);
    unsigned char* lds = F.lds; float* gct = (float*)(lds + DS_TAB); float* part = gct + 256; float* rnt = part + 512;
    const int tid = F.tid, lane = F.lane, w = F.wave; const int chain = unit >> 4, seg = unit & 15, b = chain >> 3, h = chain & 7;
    NsaLane L; dn_lane_init(L, lane, w);
    f32x4 S[8], o[4];
    { const float* si = sst + ((size_t)chain * NSEG + seg) * 16384;
#pragma unroll
      for (int c = 0; c < 8; ++c)
#pragma unroll
          for (int r = 0; r < 4; ++r) { const float sv = si[(16 * c + 4 * L.gq + r) * 128 + 16 * w + L.r16]; S[c][r] = seg ? sv : 0.f; } }
    const float gnorm = P.dn_norm_g[16 * w + L.r16];
    T2 rW, rK, rU, rQ, rZ; u32x4 rQK; float rg = 0.f; const float* ekb = (const float*)(ws + WS_BETA);
#define DN_C_LOAD(chunk_) do { const size_t row0_ = (size_t)b * SEQ + (size_t)(chunk_) * 64; const size_t go_ = row0_ * 1024 + h * 128; \
        t2_load(rW, wb + go_, 1024, tid); t2_load(rK, kn + go_, 1024, tid); t2_load(rU, ub + go_, 1024, tid); t2_load(rQ, qn + go_, 1024, tid); \
        t2_load(rZ, proj + row0_ * NPROJ + C_Z + h * 128, NPROJ, tid); \
        rQK = *(const u32x4*)(qkb + (size_t)(chain * 256 + (chunk_)) * 4096 + (tid >> 3) * 64 + (tid & 7) * 8); \
        if (tid < 128) rg = (tid < 64 ? ekb : gcb)[(row0_ + (tid & 63)) * 8 + h]; } while (0)
    DN_C_LOAD(seg * CPS);
    for (int cc = 0; cc < CPS; ++cc) {
        const int chunk = seg * CPS + cc; const size_t row0 = (size_t)b * SEQ + (size_t)chunk * 64;
        lds_barrier();
        t2_store(rW, lds + DS_W, tid); t2_store(rK, lds + DS_K, tid); t2_store(rU, lds + DS_U, tid); t2_store(rQ, lds + DS_Q, tid); t2_store(rZ, lds + DS_Z, tid);
        *(u32x4*)(lds + DS_QK + off_b(tid >> 3, tid & 7)) = rQK; if (tid < 128) gct[64 + tid] = rg;
        if (cc + 1 < CPS) DN_C_LOAD(chunk + 1);
        lds_barrier();
        dn_step<true, true>(lds + DS_W, lds + DS_K, lds + DS_U, lds + DS_Q, lds + DS_QK, gct, L, S, o);
        float rs_[4][4];
#pragma unroll
        for (int mb = 0; mb < 4; ++mb)
#pragma unroll
            for (int r = 0; r < 4; ++r) rs_[mb][r] = row16_sum(o[mb][r] * o[mb][r]);
#pragma unroll
        for (int mb = 0; mb < 4; ++mb)
#pragma unroll
            for (int r = 0; r < 4; ++r) { if (L.r16 == 0) part[(16 * mb + 4 * L.gq + r) * 8 + w] = rs_[mb][r]; }
        lds_barrier();
        if (tid < 64) { float s = 0.f;
#pragma unroll
            for (int k = 0; k < 8; ++k) s += part[tid * 8 + k];
            rnt[tid] = rsqrtf(s * (1.0f / 128.f) + EPS); }
        lds_barrier();
#pragma unroll
        for (int mb = 0; mb < 4; ++mb) { const f32x4 rn4 = *(const f32x4*)(rnt + 16 * mb + 4 * L.gq); const f32x4 z4 = tr_c4(lds + DS_Z, L, mb);
#pragma unroll
            for (int r = 0; r < 4; ++r) ymix[(row0 + 16 * mb + 4 * L.gq + r) * DM + h * 128 + 16 * w + L.r16] = (bf16_t)f2bf(o[mb][r] * rn4[r] * gnorm * silu_f(z4[r])); }
    }
}

__device__ __forceinline__ void router_phase(const Params& P, Frame& F_) { Frame F = reframe(F_);
    unsigned char* ws = P.ws; const bf16_t* x1b = (const bf16_t*)(ws + WS_X1B); const bf16_t* whi = (const bf16_t*)(ws + WS_WR); const bf16_t* wlo = (const bf16_t*)(ws + WS_WR + 512 * 1024);
    float* rstd2 = (float*)(ws + WS_RSTD2); int* lists = (int*)(ws + WS_LISTS); float* gatew = (float*)(ws + WS_GATEW); unsigned* cnt = (unsigned*)(ws + WS_CTL) + CW_CNT;
    float* lg = (float*)(F.lds + 86016 + F.wave * (16 * 80 * 4));
    unsigned char* lds = F.lds; const int tid = F.tid;
    const int lane = F.lane, r16 = lane & 15, gq = lane >> 4;
    for (int tb = F.bid; tb < T / 128; tb += F.G) {
        const int task = tb * 8 + F.wave;
        const int row = task * 16 + r16; const bf16_t* xr = x1b + (size_t)row * DM + 8 * gq;
        f32x4 acc[5];
#pragma unroll
        for (int nb = 0; nb < 5; ++nb) acc[nb] = (f32x4){0.f, 0.f, 0.f, 0.f};
        float ssq = 0.f;
        for (int e8 = 0; e8 < 8; ++e8) {
            u32x4 wv[10], xa[8];
#pragma unroll
            for (int i = 0; i < 10; ++i) { const int ci = tid + 512 * i, rr = ci >> 5, cc = ci & 31; wv[i] = *(const u32x4*)((rr < 80 ? whi + (size_t)rr * DM : wlo + (size_t)(rr - 80) * DM) + e8 * 256 + cc * 8); }
#pragma unroll
            for (int k = 0; k < 8; ++k) xa[k] = *(const u32x4*)(xr + 32 * (e8 * 8 + k));
            __syncthreads();
#pragma unroll
            for (int i = 0; i < 10; ++i) { const int ci = tid + 512 * i, rr = ci >> 5, cc = ci & 31; *(u32x4*)(lds + rr * 528 + cc * 16) = wv[i]; }
            __syncthreads();
#pragma unroll
            for (int k = 0; k < 8; ++k) { const u32x4 xw = xa[k];
                { const float a0 = bflo(xw.x), a1 = bfhi(xw.x), a2 = bflo(xw.y), a3 = bfhi(xw.y), a4 = bflo(xw.z), a5 = bfhi(xw.z), a6 = bflo(xw.w), a7 = bfhi(xw.w);
                  ssq += (a0 * a0 + a1 * a1) + (a2 * a2 + a3 * a3) + (a4 * a4 + a5 * a5) + (a6 * a6 + a7 * a7); }
                const bf16x8 xh = __builtin_bit_cast(bf16x8, xw);
#pragma unroll
                for (int nb = 0; nb < 5; ++nb) { const bf16x8 bh = *(const bf16x8*)(lds + (16 * nb + r16) * 528 + (4 * k + gq) * 16), bl = *(const bf16x8*)(lds + (80 + 16 * nb + r16) * 528 + (4 * k + gq) * 16);
                    acc[nb] = __builtin_amdgcn_mfma_f32_16x16x32_bf16(bh, xh, acc[nb], 0, 0, 0);
                    acc[nb] = __builtin_amdgcn_mfma_f32_16x16x32_bf16(bl, xh, acc[nb], 0, 0, 0); } }
        }
        ssq = red_gq_sum(ssq); const float rs = rsqrtf(ssq * (1.0f / DM) + EPS);
#pragma unroll
        for (int nb = 0; nb < 5; ++nb)
#pragma unroll
            for (int r = 0; r < 4; ++r) lg[r16 * 80 + 16 * nb + 4 * gq + r] = acc[nb][r] * rs;
        __builtin_amdgcn_s_waitcnt(0xc07f); asm volatile("" ::: "memory");
        if (lane < 16) {
            const float* L = lg + lane * 80; const int tok = task * 16 + lane;
            float mx = L[0]; for (int j = 1; j < 8; ++j) mx = fmaxf(mx, L[j]);
            float se = 0.f; for (int j = 0; j < 8; ++j) se += __expf(L[j] - mx);
            int gs = 0; float bv = L[0] + P.b_group[0]; for (int j = 1; j < 8; ++j) { const float v = L[j] + P.b_group[j]; if (v > bv) { bv = v; gs = j; } }
            const float pg = __expf(L[gs] - mx) / se;
            const float* el = L + 8 + 8 * gs; const float* br = P.b_router + 8 * gs;
            int i1 = 0; float s1 = el[0] + br[0]; for (int j = 1; j < 8; ++j) { const float v = el[j] + br[j]; if (v > s1) { s1 = v; i1 = j; } }
            int i2 = -1; float s2 = -INFINITY; for (int j = 0; j < 8; ++j) { if (j == i1) continue; const float v = el[j] + br[j]; if (v > s2) { s2 = v; i2 = j; } }
            const float e1 = el[i1], e2 = el[i2], em = fmaxf(e1, e2), x1e = __expf(e1 - em), x2e = __expf(e2 - em), inv = 1.0f / (x1e + x2e);
            const int ex1 = gs * 8 + i1, ex2 = gs * 8 + i2;
            const unsigned p1 = atomicAdd(cnt + ex1, 1u), p2 = atomicAdd(cnt + ex2, 1u);
            lists[(size_t)ex1 * T + p1] = tok * 2; lists[(size_t)ex2 * T + p2] = tok * 2 + 1;
            gatew[tok * 2] = pg * x1e * inv; gatew[tok * 2 + 1] = pg * x2e * inv; rstd2[tok] = rs;
        }
        __builtin_amdgcn_s_waitcnt(0xc07f); asm volatile("" ::: "memory");
    }
}
__device__ __forceinline__ void convert_phase(const Params& P, Frame& F_) { Frame F = reframe(F_);
    unsigned char* ws = P.ws;
    float* scr = (float*)(F.lds + F.wave * 8448);
    bf16_t* btgu = (bf16_t*)(ws + WS_BTGU); bf16_t* btd = (bf16_t*)(ws + WS_BTD); const float* gf = P.norm_ffn_g;
    constexpr int I_GU = 64 * 2 * 32 * 16, I_D = 64 * 8 * 64, NI = I_GU + I_D, NB_ = 2;
#define CONV_LOAD(vq, dq, lq, it_) do { const int it = (it_); dq = nullptr; lq = 0; \
        if (it < I_GU) { const int nb = it & 15, kb = (it >> 4) & 31, which = (it >> 9) & 1, e = it >> 10; const int k0 = kb * 64, f0 = nb * 32; \
            const float* w = (which ? P.w_up : P.w_gate) + (size_t)e * DM * DEXP; \
            tr_load([&](int kk, int nn) { return *(const f32x4*)(w + (size_t)(k0 + kk) * DEXP + f0 + nn) * gf[k0 + kk]; }, vq, F.lane); \
            dq = btgu + ((size_t)e * 1024 + 256 * (f0 >> 7) + which * 128 + (f0 & 127)) * DM + k0; lq = DM; \
        } else if (it < NI) { const int r = it - I_GU, nb = r & 63, kb = (r >> 6) & 7, e = r >> 9; const int k0 = kb * 64, n0 = nb * 32; const float* w = P.w_down + (size_t)e * DEXP * DM; \
            tr_load([&](int kk, int nn) { return *(const f32x4*)(w + (size_t)(k0 + kk) * DM + n0 + nn); }, vq, F.lane); \
            dq = btd + ((size_t)e * DM + n0) * DEXP + k0; lq = DEXP; } } while (0)
    f32x4 va[NB_][8], vb[NB_][8]; bf16_t* da[NB_]; bf16_t* db[NB_]; size_t la[NB_], lb[NB_];
#pragma unroll
    for (int q = 0; q < NB_; ++q) CONV_LOAD(va[q], da[q], la[q], F.gw + q * F.NGW);
    for (int it0 = F.gw; it0 < NI; it0 += 2 * NB_ * F.NGW) {
#pragma unroll
        for (int q = 0; q < NB_; ++q) CONV_LOAD(vb[q], db[q], lb[q], it0 + (NB_ + q) * F.NGW);
#pragma unroll
        for (int q = 0; q < NB_; ++q) if (da[q]) tr_store(va[q], da[q], la[q], scr, F.lane);
#pragma unroll
        for (int q = 0; q < NB_; ++q) CONV_LOAD(va[q], da[q], la[q], it0 + (2 * NB_ + q) * F.NGW);
#pragma unroll
        for (int q = 0; q < NB_; ++q) if (db[q]) tr_store(vb[q], db[q], lb[q], scr, F.lane);
    }
#undef CONV_LOAD
}
__device__ __forceinline__ void moe_tables(const Params& P, Frame& F_) { Frame F = reframe(F_);
    LAS int* tab = (LAS int*)((LAS unsigned char*)F.lds + LDS_TAB); const unsigned* cnt = (const unsigned*)(P.ws + WS_CTL) + CW_CNT;
    if (F.tid < 64) { const int c = (int)cnt[F.tid]; const int ntl = (c + 255) >> 8; int incl = ntl;
#pragma unroll
        for (int o = 1; o < 64; o <<= 1) { const int t = __shfl_up(incl, o); if (F.lane >= o) incl += t; }
        tab[F.tid] = incl - ntl; tab[65 + F.tid] = c; if (F.tid == 63) tab[64] = incl; }
    __syncthreads();
}
__device__ __forceinline__ void final_phase(const Params& P, Frame& F_) { Frame F = reframe(F_);
    const bf16_t* ymoe = (const bf16_t*)(P.ws + WS_YMOE); float* out = P.out; const int lane = F.lane;
    const bf16_t* x1b = (const bf16_t*)(P.ws + WS_X1B);
    for (int m = F.gw; m < T; m += F.NGW) { f32x4* xr = (f32x4*)(out + (size_t)m * DM) + lane; const u32x2* x0 = (const u32x2*)(x1b + (size_t)m * DM) + lane; const u32x2* y0 = (const u32x2*)(ymoe + (size_t)(2 * m) * DM) + lane; const u32x2* y1 = (const u32x2*)(ymoe + (size_t)(2 * m + 1) * DM) + lane;
        f32x4 v[8]; float s = 0.f;
#pragma unroll
        for (int j = 0; j < 8; ++j) { const u32x2 xx = x0[64 * j], a = y0[64 * j], b = y1[64 * j];
            v[j][0] = bflo(xx.x) + (bflo(a.x) + bflo(b.x)); v[j][1] = bfhi(xx.x) + (bfhi(a.x) + bfhi(b.x)); v[j][2] = bflo(xx.y) + (bflo(a.y) + bflo(b.y)); v[j][3] = bfhi(xx.y) + (bfhi(a.y) + bfhi(b.y));
            s += (v[j][0] * v[j][0] + v[j][1] * v[j][1]) + (v[j][2] * v[j][2] + v[j][3] * v[j][3]); }
        s = wave_sum(s); const float rn = rsqrtf(s * (1.0f / DM) + EPS);
#pragma unroll
        for (int j = 0; j < 8; ++j) { const f32x4 gg = ((const f32x4*)P.norm_final_g)[lane + 64 * j]; xr[64 * j] = v[j] * rn * gg; } }
}

constexpr int LDS_MISC = LDS_TAB + 1024;
constexpr int LDS_BYTES = LDS_TAB + 2048;
constexpr int NPHASE = 11;
__global__ void __launch_bounds__(512, 2) fwd(Params P) {
    extern __shared__ __attribute__((aligned(16))) unsigned char lds[];
    Frame F; F.lds = lds; F.tid = threadIdx.x; F.lane = F.tid & 63; F.wave = __builtin_amdgcn_readfirstlane(F.tid >> 6); F.G = gridDim.x; F.bid = blockIdx.x; F.gw = F.bid * 8 + F.wave; F.NGW = F.G * 8;
    LAS unsigned char* ldsl = (LAS unsigned char*)lds;
    unsigned char* ws = P.ws;
    if (F.tid < 4) ((LAS unsigned*)(ldsl + LDS_MISC))[F.tid] = 0u;
    __syncthreads();
    const int lo = P.ph_lo, hi = P.ph_hi;
    const bool multi = (hi - lo) > 1;
    XcdBarrier bar; bar.bar = (unsigned*)(ws + WS_CTL) + CW_BAR; bar.x = 0; bar.st = nullptr;
    if (multi) bar = xcd_barrier_post((unsigned*)(ws + WS_CTL) + CW_BAR, (volatile LAS unsigned*)(ldsl + LDS_MISC));
#ifndef REPEAT_MASK
#define REPEAT_MASK 0
#endif
#define REP(k) for (int rep_ = 0; rep_ < (((REPEAT_MASK) >> (k)) & 1) + 1; ++rep_)
#define IN(k) (lo <= (k) && (k) < hi)
#define SEAM(k) do { if (IN(k) && IN((k) + 1)) xcd_barrier(bar); } while (0)
    if (IN(0)) REP(0) { p0_prologue(P, F); }
    SEAM(0);
    if (IN(1)) REP(1) {
        pg8::DenseOrder S; S.init(ws + WS_R0, ws + WS_BTIN, T, NPROJ, DM, DM, F.G, F.bid);
        EpiProj E{(bf16_t*)(ws + WS_R1), (bf16_t*)(ws + WS_CMPBUF), (float*)(ws + WS_SMALL), (const float*)(ws + WS_RSTD1)};
        pg8::gemm_phase<EpiProj, pg8::DenseOrder>(ldsl, DM, DM, DM, S, E);
    }
    SEAM(1);
    if (IN(2)) REP(2) {
        for (int c = F.bid; c < 256; c += F.G) {
            small_gemm_chunk(P, F, c);
            asm volatile("s_waitcnt vmcnt(0)" ::: "memory"); __syncthreads();
            { const int dly = (int)(F.bid & 3u);
              for (int q = 0; q < dly; ++q) __builtin_amdgcn_s_sleep(127); }
            for (int k = 0; k < 8; ++k) dn_prep_pair(P, F, c, k);
        }
        __syncthreads();
        CmpOrder S{(const char*)(ws + WS_CMPBUF), (const char*)(ws + WS_W1T), F.G, F.bid};
        EpiCmp1 E{(float*)(ws + WS_HIDS)};
        pg8::gemm_phase<EpiCmp1, CmpOrder>(ldsl, 1024, 2048, 4096, S, E);
    }
    SEAM(2);
    if (IN(3)) REP(3) { cmp2_phase(P, F); for (int u = F.bid; u < 480; u += F.G) dn_passA_unit(P, F, u); }
    SEAM(3);
    if (IN(4)) REP(4) {
        if (F.bid < 16) { dn_passB_unit(P, F, F.bid);
            asm volatile("s_waitcnt vmcnt(0)" ::: "memory"); __syncthreads();
            if (F.tid == 0) { __builtin_amdgcn_fence(__ATOMIC_RELEASE, "agent"); asm volatile("s_waitcnt vmcnt(0)" ::: "memory"); (void)xb_add((unsigned*)(ws + WS_CTL) + CW_PBDONE, 1u); } }
        __syncthreads();
        { unsigned* qctr = (unsigned*)(ws + WS_CTL) + CW_NSAQ + 64 * rep_; LAS unsigned* qs = (LAS unsigned*)(ldsl + LDS_MISC + 16);
          for (;;) {
              __syncthreads();
              if (F.tid == 0) *qs = atomicAdd(qctr, 1u);
              __syncthreads();
              const unsigned q = *qs; if (q >= 1024u) break;
              nsa_unit(P, F, (int)(((q & 3u) << 8) | (255u - (q >> 2))));
          } }
        if (IN(5)) {
            if (F.tid == 0) { unsigned* pb = (unsigned*)(ws + WS_CTL) + CW_PBDONE; XB_SPIN(xb_ld(pb) < 16u, bar.bar); __builtin_amdgcn_fence(__ATOMIC_ACQUIRE, "agent"); asm volatile("s_waitcnt vmcnt(0)" ::: "memory"); }
            __syncthreads();
            for (int u = F.bid; u < 256; u += F.G) dn_passC_unit(P, F, u);
        }
    }
    if (!(IN(4) && IN(5))) SEAM(4);
    if (IN(5) && !IN(4)) REP(5) { for (int u = F.bid; u < 256; u += F.G) dn_passC_unit(P, F, u); }
    SEAM(5);
    if (IN(6)) REP(6) {
        const int NG = (F.G == 256) ? 171 : F.G;
        if (F.bid >= NG || NG == F.G) { Frame Fc = F; if (NG < F.G) { Fc.bid = F.bid - NG; Fc.G = F.G - NG; Fc.NGW = Fc.G * 8; } convert_phase(P, Fc); }
        if (F.bid < NG) {
        pg8::DenseOrder S; S.init(ws + WS_R0, ws + WS_BTOUT, T, DM, DM, DM, NG, F.bid);
        EpiOut E{P.x, P.out, (bf16_t*)(ws + WS_X1B)};
        pg8::gemm_phase<EpiOut, pg8::DenseOrder>(ldsl, DM, DM, DM, S, E);
        }
    }
    SEAM(6);
    if (IN(7)) { router_phase(P, F); }
    SEAM(7);
    if (IN(8)) REP(8) {
        moe_tables(P, F);
        MoeOrderT<true> S{(const LAS int*)(ldsl + LDS_TAB), (const LAS int*)(ldsl + LDS_TAB + 65 * 4), (const int*)(ws + WS_LISTS), (const char*)(ws + WS_X1B), (const char*)(ws + WS_BTGU), (size_t)1024 * DM * 2, (size_t)256 * DM * 2, 4, F.G, F.bid, (unsigned)(DM * 2)};
        EpiGU E{(bf16_t*)(ws + WS_R0), (const int*)(ws + WS_LISTS), (const float*)(ws + WS_RSTD2)};
        pg8::gemm_phase<EpiGU, MoeOrderT<true>>(ldsl, DM, DM, DM, S, E);
    }
    SEAM(8);
    if (IN(9)) REP(9) {
        moe_tables(P, F);
        MoeOrderT<false> S{(const LAS int*)(ldsl + LDS_TAB), (const LAS int*)(ldsl + LDS_TAB + 65 * 4), (const int*)(ws + WS_LISTS), (const char*)(ws + WS_R0), (const char*)(ws + WS_BTD), (size_t)DM * DEXP * 2, (size_t)256 * DEXP * 2, 8, F.G, F.bid, (unsigned)(DEXP * 2)};
        EpiDown E{(bf16_t*)(ws + WS_YMOE), (const int*)(ws + WS_LISTS), (const float*)(ws + WS_GATEW)};
        pg8::gemm_phase<EpiDown, MoeOrderT<false>>(ldsl, DEXP, DEXP, DEXP, S, E);
    }
    SEAM(9);
    if (IN(10)) REP(10) { final_phase(P, F); }
#undef IN
#undef SEAM
}

extern "C" void kernel_launch(void* const* d_in, const int* in_sizes, int n_in, void* d_out, int out_size, void* d_ws, size_t ws_size, hipStream_t stream) {
    static int grid = 0;
    if (grid == 0) {
        if (n_in != 24 || in_sizes[0] != T * DM || out_size != T * DM || ws_size < WS_END) { fprintf(stderr, "kernel_launch: unexpected shapes (n_in %d, ws %zu)\n", n_in, ws_size); grid = -1; return; }
        int dev = 0, cus = 0;
        if (hipGetDevice(&dev) != hipSuccess || hipDeviceGetAttribute(&cus, hipDeviceAttributeMultiprocessorCount, dev) != hipSuccess) { grid = -1; return; }
        if (hipFuncSetAttribute((const void*)fwd, hipFuncAttributeMaxDynamicSharedMemorySize, LDS_BYTES) != hipSuccess) { fprintf(stderr, "kernel_launch: hipFuncSetAttribute failed\n"); grid = -1; return; }
        int per_cu = 0;
        if (hipOccupancyMaxActiveBlocksPerMultiprocessor(&per_cu, (const void*)fwd, 512, LDS_BYTES) != hipSuccess || per_cu < 1) fprintf(stderr, "kernel_launch: occupancy query says %d\n", per_cu);
        (void)hipGetLastError();
        grid = cus;
    }
    if (grid < 0) return;
    (void)hipMemsetAsync((char*)d_ws + WS_CTL, 0, CTL_BYTES, stream);
    Params p{};
    const float** pp = (const float**)&p;
    for (int i = 0; i < 24; ++i) pp[i] = (const float*)d_in[i];
    p.out = (float*)d_out; p.ws = (unsigned char*)d_ws;
#define ONE_LAUNCH 1
#ifndef ONE_LAUNCH
    for (int ph = 0; ph < NPHASE; ++ph) { p.ph_lo = ph; p.ph_hi = ph + 1; hipLaunchKernelGGL(fwd, dim3(grid), dim3(512), LDS_BYTES, stream, p); }
#else
    p.ph_lo = 0; p.ph_hi = NPHASE; hipLaunchKernelGGL(fwd, dim3(grid), dim3(512), LDS_BYTES, stream, p);
#endif
}
```

```cpp
#include <hip/hip_runtime.h>
#include <cstdio>
#include <cstdint>

#define LAS __attribute__((address_space(3)))
typedef unsigned short bf16_t;
typedef short bf16x8 __attribute__((ext_vector_type(8)));
typedef short s16x4 __attribute__((ext_vector_type(4)));
typedef float f32x4 __attribute__((ext_vector_type(4)));
typedef float f32x2 __attribute__((ext_vector_type(2)));
typedef unsigned u32x4 __attribute__((ext_vector_type(4)));
typedef unsigned u32x2 __attribute__((ext_vector_type(2)));

constexpr int NB = 2, SEQ = 16384, T = NB * SEQ, DM = 2048;
constexpr int NPROJ = 6656;
constexpr int C_Q = 0, C_K = 1024, C_V = 2048, C_Z = 3072, C_NQ = 4096, C_KCMP = 5120, C_VCMP = 5376, C_KSEL = 5632, C_VSEL = 5888, C_KWIN = 6144, C_VWIN = 6400, C_SMALL = 6656;
constexpr int NEXP = 64, DEXP = 512;
constexpr float EPS = 1e-6f;
constexpr float LOG2E = 1.4426950408889634f;

constexpr size_t MiB = 1u << 20;
constexpr size_t WS_CTL = 0, CTL_BYTES = 1 * MiB;
constexpr size_t WS_BTIN = 1 * MiB, WS_BTOUT = 28 * MiB, WS_W1T = 36 * MiB, WS_WR = 40 * MiB, WS_CMPBUF = 41 * MiB, WS_HIDC = 74 * MiB, WS_KC = 78 * MiB;
constexpr size_t WS_SMALL = 80 * MiB, WS_RSTD1 = 88 * MiB, WS_RSTD2 = 88 * MiB + 131072, WS_BETA = 89 * MiB, WS_GDEC = 90 * MiB;
constexpr size_t WS_R0 = 100 * MiB, WS_R1 = 228 * MiB, WS_R2 = 660 * MiB, WS_WN = 852 * MiB, WS_QK = 916 * MiB, WS_MN = 948 * MiB, WS_SST = 980 * MiB, WS_HIDS = 996 * MiB, WS_END = 1012 * MiB;
constexpr size_t WS_BTGU = WS_R1, WS_BTD = WS_R1 + 256 * MiB, WS_YMOE = WS_R1;
constexpr size_t WS_QN = WS_R2, WS_KN = WS_R2 + 64 * MiB, WS_VN = WS_R2 + 128 * MiB;
constexpr size_t WS_X1B = WS_R2, WS_LISTS = WS_R2 + 128 * MiB, WS_GATEW = WS_R2 + 136 * MiB;
constexpr int CW_BAR = 4096, CW_CNT = 8192, CW_BIAS = 8448, CW_NSAQ = 8704, CW_PBDONE = 9216;

__device__ __forceinline__ unsigned f2bf(float f) { unsigned u = __builtin_bit_cast(unsigned, f); return (u + 0x7fffu + ((u >> 16) & 1u)) >> 16; }
__device__ __forceinline__ unsigned pk2(float lo, float hi) { return f2bf(lo) | (f2bf(hi) << 16); }
typedef __bf16 bf16x2_t __attribute__((ext_vector_type(2)));
__device__ __forceinline__ unsigned cvtpk(float lo, float hi) { const f32x2 v = {lo, hi}; const bf16x2_t r = __builtin_convertvector(v, bf16x2_t); return __builtin_bit_cast(unsigned, r); }
__device__ __forceinline__ float ex2(float x) { return __builtin_amdgcn_exp2f(x); }
__device__ __forceinline__ float bf2f(unsigned b) { return __builtin_bit_cast(float, b << 16); }
__device__ __forceinline__ float bflo(unsigned w) { return __builtin_bit_cast(float, w << 16); }
__device__ __forceinline__ float bfhi(unsigned w) { return __builtin_bit_cast(float, w & 0xffff0000u); }
template <int CTRL> __device__ __forceinline__ float dpp_f(float v) { return __builtin_bit_cast(float, __builtin_amdgcn_update_dpp(0, __builtin_bit_cast(int, v), CTRL, 0xF, 0xF, true)); }
__device__ __forceinline__ float row16_sum(float v) { v += dpp_f<0xB1>(v); v += dpp_f<0x4E>(v); v += dpp_f<0x141>(v); v += dpp_f<0x140>(v); return v; }
__device__ __forceinline__ float quad_sum(float v) { v += dpp_f<0xB1>(v); v += dpp_f<0x4E>(v); return v; }
template <int CTRL, int RM> __device__ __forceinline__ float dpp_rm(float v) { return __builtin_bit_cast(float, __builtin_amdgcn_update_dpp(0, __builtin_bit_cast(int, v), CTRL, RM, 0xF, false)); }
__device__ __forceinline__ float wave_sum(float v) { v = row16_sum(v); v += dpp_rm<0x142, 0xA>(v); v += dpp_rm<0x143, 0xC>(v); return __builtin_bit_cast(float, __builtin_amdgcn_readlane(__builtin_bit_cast(int, v), 63)); }
__device__ __forceinline__ float wave_scan(float v) { v += dpp_f<0x111>(v); v += dpp_f<0x112>(v); v += dpp_f<0x114>(v); v += dpp_f<0x118>(v); v += dpp_rm<0x142, 0xA>(v); v += dpp_rm<0x143, 0xC>(v); return v; }
__device__ __forceinline__ void lds_barrier() { asm volatile("s_waitcnt lgkmcnt(0)" ::: "memory"); __builtin_amdgcn_s_barrier(); asm volatile("" ::: "memory"); }
__device__ __forceinline__ float silu_f(float x) { return x * __builtin_amdgcn_rcpf(1.0f + __expf(-x)); }
__device__ __forceinline__ float sigmoid_f(float x) { return __builtin_amdgcn_rcpf(1.0f + __expf(-x)); }

#define XB_TMO      128
#define XB_XCNT(j)  (256  + 64 * (j))
#define XB_XSUB(j)  (1280 + 64 * (j))
#define XB_XGEN(j)  (2304 + 64 * (j))
#define XB_TOP      3328
#define XB_TOPGEN   3392
#define XCD_BAR_WORDS 3456
#define XB_SPIN_CAP (1u << 24)
__device__ __forceinline__ unsigned xb_ld(unsigned* p)              { return __hip_atomic_load(p, __ATOMIC_RELAXED, __HIP_MEMORY_SCOPE_AGENT); }
__device__ __forceinline__ unsigned xb_add(unsigned* p, unsigned v) { return __hip_atomic_fetch_add(p, v, __ATOMIC_RELAXED, __HIP_MEMORY_SCOPE_AGENT); }
__device__ __forceinline__ unsigned xb_xcc_id() { return (unsigned)__builtin_amdgcn_s_getreg((3 << 11) | 20) & 0xFu; }
#define XB_SPIN(cond, bar) do { unsigned _sp = 0; while (cond) { __builtin_amdgcn_s_sleep(1); \
    if ((++_sp & 255u) == 0u) { if (xb_ld(&(bar)[XB_TMO])) break; if (_sp > XB_SPIN_CAP) { atomicAdd(&(bar)[XB_TMO], 1u); break; } } } } while (0)
struct XcdBarrier { unsigned* bar; unsigned x; volatile LAS unsigned* st; };
__device__ __forceinline__ XcdBarrier xcd_barrier_post(unsigned* bar, volatile LAS unsigned* st) {
    XcdBarrier b; b.bar = bar; b.x = xb_xcc_id(); b.st = st;
    if (threadIdx.x == 0) (void)xb_add(&bar[XB_XCNT(b.x)], 1u);
    return b;
}
__device__ __forceinline__ void xcd_barrier_complete(unsigned* bar, unsigned x, unsigned& nloc, unsigned& nx) {
    const unsigned G = gridDim.x * gridDim.y * gridDim.z;
    unsigned sum, cnt, mine, sp = 0u;
    for (;;) {
        sum = 0u; cnt = 0u; mine = 0u;
#pragma unroll
        for (unsigned j = 0; j < 16; ++j) { const unsigned c = xb_ld(&bar[XB_XCNT(j)]); sum += c; cnt += (c > 0u) ? 1u : 0u; mine = (j == x) ? c : mine; }
        if (sum == G) break;
        __builtin_amdgcn_s_sleep(1);
        if ((++sp & 255u) == 0u) { if (xb_ld(&bar[XB_TMO])) break; if (sp > XB_SPIN_CAP) { atomicAdd(&bar[XB_TMO], 1u); break; } }
    }
    nloc = mine > 0u ? mine : 1u; nx = cnt > 0u ? cnt : 1u;
}
__device__ __forceinline__ void xcd_barrier(const XcdBarrier& b) {
    asm volatile("s_waitcnt vmcnt(0)" ::: "memory");
    __syncthreads();
    if (threadIdx.x == 0) {
        unsigned* bar = b.bar;
        __builtin_amdgcn_s_waitcnt(0);
        unsigned nloc = b.st[0], nx = b.st[1];
        if (nloc == 0u) { xcd_barrier_complete(bar, b.x, nloc, nx); b.st[0] = nloc; b.st[1] = nx; }
        const unsigned old = xb_add(&bar[XB_XSUB(b.x)], 1u);
        const unsigned gen = old / nloc;
        if (old + 1u == (gen + 1u) * nloc) {
            __builtin_amdgcn_fence(__ATOMIC_RELEASE, "agent");
            asm volatile("s_waitcnt vmcnt(0)" ::: "memory");
            const unsigned og = xb_add(&bar[XB_TOP], 1u);
            const unsigned tg = og / nx;
            if (og + 1u == (tg + 1u) * nx) xb_add(&bar[XB_TOPGEN], 1u);
            else XB_SPIN(xb_ld(&bar[XB_TOPGEN]) == tg, bar);
            __builtin_amdgcn_fence(__ATOMIC_ACQUIRE, "agent");
            xb_add(&bar[XB_XGEN(b.x)], 1u);
            asm volatile("s_waitcnt vmcnt(0)" ::: "memory");
        } else {
            XB_SPIN(xb_ld(&bar[XB_XGEN(b.x)]) == gen, bar);
            __builtin_amdgcn_fence(__ATOMIC_ACQUIRE, "agent");
            asm volatile("s_waitcnt vmcnt(0)" ::: "memory");
        }
    }
    __syncthreads();
}

struct Params {
    const float *x, *norm_mix_g, *w_in, *conv_w, *dt_bias, *a_log, *dn_norm_g;
    const float *cmp_pos_k, *cmp_w1_k, *cmp_w2_k, *cmp_pos_v, *cmp_w1_v, *cmp_w2_v, *nsa_norm_g;
    const float *w_out, *norm_ffn_g, *w_group, *b_group, *w_router, *b_router;
    const float *w_gate, *w_up, *w_down, *norm_final_g;
    float* out; unsigned char* ws; int ph_lo, ph_hi;
};

namespace pg8 {
constexpr int BM = 256, BK = 64, HALF = 128, HTB = HALF * BK * 2, STAGE_BYTES = 8 * HTB;
__device__ __forceinline__ int lds_byte(int r, int c) { const int st = (r >> 4) * 2 + (c >> 5), rr = r & 15, cc = c & 31, ob = rr * 64 + cc * 2; return st * 1024 + (ob ^ (((ob >> 9) & 1) << 5)); }
__device__ __forceinline__ void stage_rc(int b, int& R, int& C) { const int st = b / 1024, sb = b % 1024, swz = sb ^ (((sb >> 9) & 1) << 5); R = (st >> 1) * 16 + swz / 64; C = (st & 1) * 32 + (swz % 64) / 2; }
__device__ __forceinline__ int perm32(int rho) { const int n = rho >> 4, i = rho & 15; return 8 * (i >> 2) + 4 * n + (i & 3); }
struct Unit { int pm, pn; const char* a; const char* b; int x0, x1, x2, x3; };
__device__ __forceinline__ unsigned cvt_pk_bf16(float lo, float hi) { unsigned r; asm volatile("v_cvt_pk_bf16_f32 %0, %1, %2" : "=v"(r) : "v"(lo), "v"(hi)); return r; }

template <class Epi, class Sched>
__device__ __forceinline__ void gemm_phase(LAS unsigned char* lds, const int K, const int lda, const int ldb, const Sched& S, const Epi& E) {
    int tid = threadIdx.x; asm volatile("" : "+v"(tid));
    const int wid = __builtin_amdgcn_readfirstlane(tid >> 6), lane = tid & 63, wr = wid >> 2, wc = wid & 3, fr = lane & 15, fq = lane >> 4;
    const int nt = K / BK;
    unsigned voffA[2], voffB[2];
    unsigned gofA[2][2], ngofA[2][2];
#pragma unroll
    for (int i = 0; i < 2; ++i) { int R, C; stage_rc(tid * 16 + i * 8192, R, C); const int Rb = Epi::PERM ? ((R & ~31) + perm32(R & 31)) : R;
        voffA[i] = (unsigned)(R * lda + C) * 2u; voffB[i] = (unsigned)(Rb * ldb + C) * 2u; }
    const size_t kstep = (size_t)(BK * 2);
    const size_t hstepA = Sched::GATHER ? 0 : (size_t)HALF * lda * 2, hstepB = (size_t)HALF * ldb * 2;
    const unsigned ldsw = (unsigned)wid * 1024u;
    const int aoff = lds_byte(wr * 64 + fr, fq * 8), boff = lds_byte(wc * 32 + fr, fq * 8);
#define PG8_SA(b, h) (((b) * 2 + (h)) * HTB)
#define PG8_SB(b, h) ((4 + (b) * 2 + (h)) * HTB)
#define PG8_STAGE(bufoff, gbase, voff) do { _Pragma("unroll") for (int _i = 0; _i < 2; ++_i) \
        __builtin_amdgcn_global_load_lds((const unsigned*)((const char*)(gbase) + (voff)[_i]), (LAS unsigned*)(lds + (bufoff) + ldsw + _i * 8192), 16, 0, 0); } while (0)
#define PG8_STAGE_A(bufoff, gbase, h, nx) do { if constexpr (Sched::GATHER) { if (nx) PG8_STAGE(bufoff, gbase, ngofA[h]); else PG8_STAGE(bufoff, gbase, gofA[h]); } else PG8_STAGE(bufoff, (gbase) + (h) * hstepA, voffA); } while (0)
#define PG8_LDA(dst, b, h) do { _Pragma("unroll") for (int m = 0; m < 4; ++m) _Pragma("unroll") for (int k = 0; k < 2; ++k) dst[m][k] = *(const LAS bf16x8*)(lds + PG8_SA(b, h) + aoff + m * 2048 + k * 1024); } while (0)
#define PG8_LDB(dst, b, h) do { _Pragma("unroll") for (int n = 0; n < 2; ++n) _Pragma("unroll") for (int k = 0; k < 2; ++k) dst[n][k] = *(const LAS bf16x8*)(lds + PG8_SB(b, h) + boff + n * 2048 + k * 1024); } while (0)
#define PG8_MMA(ai, bj, At, Bt) do { __builtin_amdgcn_s_setprio(1); _Pragma("unroll") for (int m = 0; m < 4; ++m) _Pragma("unroll") for (int n = 0; n < 2; ++n) _Pragma("unroll") for (int k = 0; k < 2; ++k) \
        acc[ai][bj][m][n] = __builtin_amdgcn_mfma_f32_16x16x32_bf16(Bt[n][k], At[m][k], acc[ai][bj][m][n], 0, 0, 0); __builtin_amdgcn_s_setprio(0); } while (0)
#define PG8_WAIT_V(n) asm volatile("s_waitcnt vmcnt(" #n ")" ::: "memory")
#define PG8_WAIT_L(n) asm volatile("s_waitcnt lgkmcnt(" #n ")" ::: "memory")
#define PG8_BAR __builtin_amdgcn_s_barrier()
#define PG8_SCHED __builtin_amdgcn_sched_barrier(0)
    Unit cur, nxt; int ui = 0;
    if (!S.next(0, cur)) return;
    if constexpr (Sched::GATHER) {
#pragma unroll
        for (int i = 0; i < 2; ++i) { int R, C; stage_rc(tid * 16 + i * 8192, R, C);
#pragma unroll
            for (int h = 0; h < 2; ++h) { gofA[h][i] = S.row_off(cur, h * HALF + R) + (unsigned)C * 2u; ngofA[h][i] = gofA[h][i]; } }
    }
    f32x4 acc[2][2][4][2];
#pragma unroll
    for (int a = 0; a < 2; ++a)
#pragma unroll
        for (int b = 0; b < 2; ++b)
#pragma unroll
            for (int m = 0; m < 4; ++m)
#pragma unroll
                for (int n = 0; n < 2; ++n) acc[a][b][m][n] = (f32x4){0.f, 0.f, 0.f, 0.f};
    bf16x8 At[4][2], B0[2][2], B1[2][2];
    const char* cA = cur.a; const char* cB = cur.b;
    PG8_STAGE(PG8_SB(0, 0), cB, voffB); PG8_STAGE_A(PG8_SA(0, 0), cA, 0, false); PG8_STAGE(PG8_SB(0, 1), cB + hstepB, voffB); PG8_STAGE_A(PG8_SA(0, 1), cA, 1, false);
    if (wr == 1) PG8_BAR;
    PG8_WAIT_V(4); PG8_BAR;
    PG8_STAGE(PG8_SB(1, 0), cB + kstep, voffB); PG8_STAGE_A(PG8_SA(1, 0), cA + kstep, 0, false); PG8_STAGE(PG8_SB(1, 1), cB + hstepB + kstep, voffB);
    PG8_WAIT_V(6); PG8_BAR;
    for (;;) {
        const bool has_next = S.next(ui + 1, nxt);
        const char* nA = has_next ? nxt.a : cA; const char* nB = has_next ? nxt.b : cB;
        if constexpr (Sched::GATHER) {
            if (has_next) {
#pragma unroll
                for (int i = 0; i < 2; ++i) { int R, C; stage_rc(tid * 16 + i * 8192, R, C);
#pragma unroll
                    for (int h = 0; h < 2; ++h) ngofA[h][i] = S.row_off(nxt, h * HALF + R) + (unsigned)C * 2u; }
            }
        }
        for (int t = 0; t < nt; t += 2) {
            const bool last = (t == nt - 2);
            const char* a1 = cA + (size_t)(t + 1) * kstep;
            const char* a2 = last ? nA : cA + (size_t)(t + 2) * kstep; const char* b2 = last ? nB : cB + (size_t)(t + 2) * kstep;
            const char* a3 = a2 + kstep; const char* b3 = b2 + kstep;
            PG8_LDB(B0, 0, 0); PG8_SCHED; PG8_LDA(At, 0, 0); PG8_STAGE_A(PG8_SA(1, 1), a1, 1, false);
            PG8_WAIT_L(8); PG8_BAR; PG8_WAIT_L(0); PG8_MMA(0, 0, At, B0); PG8_BAR; PG8_SCHED;
            PG8_LDB(B1, 0, 1); PG8_STAGE(PG8_SB(0, 0), b2, voffB);
            PG8_BAR; PG8_WAIT_L(0); PG8_MMA(0, 1, At, B1); PG8_BAR;
            PG8_LDA(At, 0, 1); PG8_STAGE_A(PG8_SA(0, 0), a2, 0, last);
            PG8_BAR; PG8_WAIT_L(0); PG8_MMA(1, 0, At, B0); PG8_BAR; PG8_SCHED;
            PG8_STAGE(PG8_SB(0, 1), b2 + hstepB, voffB);
            PG8_WAIT_V(6); PG8_BAR; PG8_MMA(1, 1, At, B1); PG8_BAR;
            PG8_LDB(B0, 1, 0); PG8_SCHED; PG8_LDA(At, 1, 0); PG8_STAGE_A(PG8_SA(0, 1), a2, 1, last);
            PG8_WAIT_L(8); PG8_BAR; PG8_WAIT_L(0); PG8_MMA(0, 0, At, B0); PG8_BAR; PG8_SCHED;
            PG8_LDB(B1, 1, 1); PG8_STAGE(PG8_SB(1, 0), b3, voffB);
            PG8_BAR; PG8_WAIT_L(0); PG8_MMA(0, 1, At, B1); PG8_BAR;
            PG8_LDA(At, 1, 1); PG8_STAGE_A(PG8_SA(1, 0), a3, 0, last);
            PG8_BAR; PG8_WAIT_L(0); PG8_MMA(1, 0, At, B0); PG8_BAR; PG8_SCHED;
            PG8_STAGE(PG8_SB(1, 1), b3 + hstepB, voffB);
            PG8_WAIT_V(6); PG8_BAR; PG8_MMA(1, 1, At, B1); PG8_BAR;
        }
        E(acc, cur, wr, wc, fr, fq);
        if (!has_next) break;
#pragma unroll
        for (int a = 0; a < 2; ++a)
#pragma unroll
            for (int b = 0; b < 2; ++b)
#pragma unroll
                for (int m = 0; m < 4; ++m)
#pragma unroll
                    for (int n = 0; n < 2; ++n) acc[a][b][m][n] = (f32x4){0.f, 0.f, 0.f, 0.f};
        cur = nxt; cA = nA; cB = nB; ++ui;
        if constexpr (Sched::GATHER) {
#pragma unroll
            for (int i = 0; i < 2; ++i)
#pragma unroll
                for (int h = 0; h < 2; ++h) gofA[h][i] = ngofA[h][i];
        }
    }
    PG8_WAIT_V(0);
    if (wr == 0) PG8_BAR;
    PG8_BAR;
#undef PG8_SA
#undef PG8_SB
#undef PG8_STAGE
#undef PG8_STAGE_A
#undef PG8_LDA
#undef PG8_LDB
#undef PG8_MMA
#undef PG8_WAIT_V
#undef PG8_WAIT_L
#undef PG8_BAR
#undef PG8_SCHED
}

struct DenseOrder {
    static constexpr bool GATHER = false;
    int nM, nN, nwg, G, c; const char* A; const char* Bt; size_t tstepA, tstepB;
    __device__ void init(const void* A_, const void* Bt_, int M, int N, int lda, int ldb, int G_, int c_) { A = (const char*)A_; Bt = (const char*)Bt_; nM = M / BM; nN = N / BM; nwg = nM * nN; G = G_; c = c_; tstepA = (size_t)BM * lda * 2; tstepB = (size_t)BM * ldb * 2; }
    __device__ __forceinline__ bool next(int i, Unit& u) const {
        const long L = (long)i * G + c; if (L >= nwg) return false;
        int wgid = (int)L; { const int q = nwg / 8, r = nwg % 8, xcd = wgid % 8, off = wgid / 8; wgid = (xcd < r ? xcd * (q + 1) : r * (q + 1) + (xcd - r) * q) + off; }
        const int nig = 8 * nN, gid = wgid / nig, fm = gid * 8, gsz = (nM - fm) < 8 ? (nM - fm) : 8;
        u.pm = fm + ((wgid % nig) % gsz); u.pn = (wgid % nig) / gsz; u.a = A + (size_t)u.pm * tstepA; u.b = Bt + (size_t)u.pn * tstepB; u.x0 = u.x1 = u.x2 = u.x3 = 0; return true;
    }
    __device__ __forceinline__ unsigned row_off(const Unit&, int) const { return 0u; }
};
}

struct EpiProj {
    static constexpr bool PERM = true;
    bf16_t* proj; bf16_t* cmpbuf; float* small; const float* rstd;
    __device__ __forceinline__ void operator()(const f32x4 (&acc)[2][2][4][2], const pg8::Unit& u, int wr, int wc, int fr_, int fq_) const {
        int fr = fr_, fq = fq_; asm volatile("" : "+v"(fr), "+v"(fq));
        const int pn = u.pn;
#pragma unroll
        for (int ai = 0; ai < 2; ++ai)
#pragma unroll
            for (int m = 0; m < 4; ++m) {
                const int r = u.pm * 256 + ai * 128 + wr * 64 + m * 16 + fr; const float rs = 1.0f;
                {
#pragma unroll
                    for (int bj = 0; bj < 2; ++bj) {
                        const f32x4 v0 = acc[ai][bj][m][0] * rs, v1 = acc[ai][bj][m][1] * rs;
                        u32x4 w; w.x = cvtpk(v0[0], v0[1]); w.y = cvtpk(v0[2], v0[3]); w.z = cvtpk(v1[0], v1[1]); w.w = cvtpk(v1[2], v1[3]);
                        bf16_t* d;
                        if (pn == 20 || pn == 21) { const int b = r >> 14, s = r & 16383; d = cmpbuf + ((size_t)(((pn - 20) * 2 + b) * 2 + bj) * SEQ + s) * 128 + 32 * wc + 8 * fq; }
                        else d = proj + (size_t)r * NPROJ + pn * 256 + bj * 128 + 32 * wc + 8 * fq;
                        *(u32x4*)d = w;
                    }
                }
            }
    }
};
__device__ __forceinline__ float gelu_tanh(float x) { const float u = 0.7978845608028654f * (x + 0.044715f * x * x * x); return 0.5f * x * (1.0f + tanhf(u)); }
struct EpiCmp1 {
    static constexpr bool PERM = false;
    float* hids;
    __device__ __forceinline__ void operator()(const f32x4 (&acc)[2][2][4][2], const pg8::Unit& u, int wr, int wc, int fr_, int fq_) const {
        int fr = fr_, fq = fq_; asm volatile("" : "+v"(fr), "+v"(fq));
        const int seg = u.x0, kq = u.x1;
#pragma unroll
        for (int n = 0; n < 2; ++n) {
            const int h = 32 * wc + 16 * n + 4 * fq;
#pragma unroll
            for (int ai = 0; ai < 2; ++ai)
#pragma unroll
                for (int m = 0; m < 4; ++m) { const int nr = u.pm * 256 + ai * 128 + wr * 64 + m * 16 + fr;
                    *(f32x4*)(hids + (((size_t)kq * 8 + seg) * 1024 + nr) * 128 + h) = acc[ai][0][m][n]; }
        }
    }
};
struct CmpOrder {
    static constexpr bool GATHER = false;
    const char* cmpbuf; const char* w1t; int G, c;
    __device__ __forceinline__ bool next(int i, pg8::Unit& u) const { const int L = i * G + c; if (L >= 128) return false; const int kq = L & 3, seg = L >> 4; u.pm = (L >> 2) & 3; u.pn = 0; u.x0 = seg; u.x1 = kq; u.x2 = u.x3 = 0;
        u.a = cmpbuf + (size_t)seg * SEQ * 128 * 2 + (size_t)u.pm * 256 * 2048 * 2 + (size_t)kq * 1024 * 2; u.b = w1t + (size_t)(seg >> 2) * 256 * 4096 * 2 + (size_t)kq * 1024 * 2; return true; }
    __device__ __forceinline__ unsigned row_off(const pg8::Unit&, int) const { return 0u; }
};
struct EpiOut {
    static constexpr bool PERM = true;
    const float* x; float* x1; bf16_t* x1b;
    __device__ __forceinline__ void operator()(const f32x4 (&acc)[2][2][4][2], const pg8::Unit& u, int wr, int wc, int fr_, int fq_) const {
        int fr = fr_, fq = fq_; asm volatile("" : "+v"(fr), "+v"(fq));
#pragma unroll
        for (int ai = 0; ai < 2; ++ai)
#pragma unroll
            for (int mp = 0; mp < 2; ++mp) {
                f32x4 xv[2][2][2];
#pragma unroll
                for (int mm = 0; mm < 2; ++mm) { const size_t off = (size_t)(u.pm * 256 + ai * 128 + wr * 64 + (2 * mp + mm) * 16 + fr) * DM + u.pn * 256 + wc * 32 + 8 * fq;
#pragma unroll
                    for (int bj = 0; bj < 2; ++bj)
#pragma unroll
                        for (int n = 0; n < 2; ++n) xv[mm][bj][n] = *(const f32x4*)(x + off + bj * 128 + n * 4); }
#pragma unroll
                for (int mm = 0; mm < 2; ++mm) { const int m = 2 * mp + mm; const size_t off = (size_t)(u.pm * 256 + ai * 128 + wr * 64 + m * 16 + fr) * DM + u.pn * 256 + wc * 32 + 8 * fq;
#pragma unroll
                    for (int bj = 0; bj < 2; ++bj) { const f32x4 v0 = xv[mm][bj][0] + acc[ai][bj][m][0], v1 = xv[mm][bj][1] + acc[ai][bj][m][1];
                        u32x4 w; w.x = cvtpk(v0[0], v0[1]); w.y = cvtpk(v0[2], v0[3]); w.z = cvtpk(v1[0], v1[1]); w.w = cvtpk(v1[2], v1[3]); *(u32x4*)(x1b + off + bj * 128) = w; } }
            }
    }
};
constexpr int LDS_TAB = 155648;
struct MoeOrder {
    static constexpr bool GATHER_ = true;
    const LAS int* tpre; const LAS int* cnt; const int* lists; const char* A; const char* Bt; size_t bstride_e; size_t tstepB; int npn, G, c; unsigned rowbytes; bool gather;
};
template <bool GATH> struct MoeOrderT {
    static constexpr bool GATHER = GATH;
    const LAS int* tpre; const LAS int* cnt; const int* lists; const char* A; const char* Bt; size_t bstride_e, tstepB; int npn, G, c; unsigned rowbytes;
    __device__ __forceinline__ bool next(int i, pg8::Unit& u) const {
        const int ntile = tpre[64]; int tt;
        if (G == 256) {
            const int tpx = 32 / npn, xcd = c & 7, slot = c >> 3; tt = (i * 8 + xcd) * tpx + (slot % tpx); u.pn = slot / tpx; if (tt >= ntile) return false;
        } else { const long L = (long)i * G + c; if (L >= (long)ntile * npn) return false; tt = (int)(L / npn); u.pn = (int)(L % npn); }
        int lo = 0, hi = 64;
        while (hi - lo > 1) { const int mid = (lo + hi) >> 1; if (tpre[mid] <= tt) lo = mid; else hi = mid; }
        const int e = lo, tile = tt - tpre[e]; const int ce = cnt[e];
        u.pm = tt; u.x0 = e; u.x1 = tile; u.x2 = (ce - tile * 256) < 256 ? (ce - tile * 256) : 256; u.x3 = 0;
        u.a = GATH ? A : A + (size_t)tt * 256 * rowbytes; u.b = Bt + (size_t)e * bstride_e + (size_t)u.pn * tstepB; return true;
    }
    __device__ __forceinline__ unsigned row_off(const pg8::Unit& u, int r) const {
        const int idx = (r < u.x2) ? u.x1 * 256 + r : 0; const int a = lists[(size_t)u.x0 * T + idx]; return (unsigned)(a >> 1) * rowbytes;
    }
};
struct EpiGU {
    static constexpr bool PERM = true;
    bf16_t* hid; const int* lists; const float* rstd2;
    __device__ __forceinline__ void operator()(const f32x4 (&acc)[2][2][4][2], const pg8::Unit& u, int wr, int wc, int fr_, int fq_) const {
        int fr = fr_, fq = fq_; asm volatile("" : "+v"(fr), "+v"(fq));
        int av[8]; float rsv[8];
#pragma unroll
        for (int q = 0; q < 8; ++q) { const int rr = (q >> 2) * 128 + wr * 64 + (q & 3) * 16 + fr; const int idx = (rr < u.x2) ? u.x1 * 256 + rr : 0; av[q] = lists[(size_t)u.x0 * T + idx]; }
#pragma unroll
        for (int q = 0; q < 8; ++q) rsv[q] = rstd2[av[q] >> 1];
#pragma unroll
        for (int ai = 0; ai < 2; ++ai)
#pragma unroll
            for (int m = 0; m < 4; ++m) { const int rr = ai * 128 + wr * 64 + m * 16 + fr; const float rs = rsv[ai * 4 + m];
                f32x4 g0 = acc[ai][0][m][0] * rs, g1 = acc[ai][0][m][1] * rs, u0 = acc[ai][1][m][0] * rs, u1 = acc[ai][1][m][1] * rs;
                u32x4 w; w.x = cvtpk(silu_f(g0[0]) * u0[0], silu_f(g0[1]) * u0[1]); w.y = cvtpk(silu_f(g0[2]) * u0[2], silu_f(g0[3]) * u0[3]);
                w.z = cvtpk(silu_f(g1[0]) * u1[0], silu_f(g1[1]) * u1[1]); w.w = cvtpk(silu_f(g1[2]) * u1[2], silu_f(g1[3]) * u1[3]);
                *(u32x4*)(hid + ((size_t)u.pm * 256 + rr) * DEXP + u.pn * 128 + wc * 32 + 8 * fq) = w; }
    }
};
struct EpiDown {
    static constexpr bool PERM = true;
    bf16_t* ymoe; const int* lists; const float* gatew;
    __device__ __forceinline__ void operator()(const f32x4 (&acc)[2][2][4][2], const pg8::Unit& u, int wr, int wc, int fr_, int fq_) const {
        int fr = fr_, fq = fq_; asm volatile("" : "+v"(fr), "+v"(fq));
        int av[8]; float gwv[8];
#pragma unroll
        for (int q = 0; q < 8; ++q) { const int rr = (q >> 2) * 128 + wr * 64 + (q & 3) * 16 + fr; const int idx = (rr < u.x2) ? u.x1 * 256 + rr : 0; av[q] = lists[(size_t)u.x0 * T + idx]; }
#pragma unroll
        for (int q = 0; q < 8; ++q) gwv[q] = gatew[av[q]];
#pragma unroll
        for (int ai = 0; ai < 2; ++ai)
#pragma unroll
            for (int m = 0; m < 4; ++m) { const int rr = ai * 128 + wr * 64 + m * 16 + fr; if (rr < u.x2) { const int a = av[ai * 4 + m]; const float gw = gwv[ai * 4 + m];
#pragma unroll
                for (int bj = 0; bj < 2; ++bj) { const f32x4 v0 = acc[ai][bj][m][0] * gw, v1 = acc[ai][bj][m][1] * gw;
                    u32x4 w; w.x = cvtpk(v0[0], v0[1]); w.y = cvtpk(v0[2], v0[3]); w.z = cvtpk(v1[0], v1[1]); w.w = cvtpk(v1[2], v1[3]);
                    *(u32x4*)(ymoe + (size_t)a * DM + u.pn * 256 + bj * 128 + wc * 32 + 8 * fq) = w; } } }
    }
};

struct Frame { unsigned char* lds; int tid, lane, wave, G, bid, gw, NGW; };
__device__ __forceinline__ Frame reframe(const Frame& F_) { Frame F = F_; int t = F_.tid; asm volatile("" : "+v"(t)); F.tid = t; F.lane = t & 63; F.wave = __builtin_amdgcn_readfirstlane(t >> 6); F.gw = F.bid * 8 + F.wave; return F; }

template <class SRC>
__device__ __forceinline__ void tr_load(const SRC& src, f32x4 (&v)[8], int lane) {
#pragma unroll
    for (int i = 0; i < 4; ++i) { const int kk = 16 * i + 2 * (lane >> 3); v[2 * i] = src(kk, (lane & 7) * 4); v[2 * i + 1] = src(kk + 1, (lane & 7) * 4); }
}
__device__ __forceinline__ void tr_store(const f32x4 (&v)[8], bf16_t* dst, size_t ldd, float* scr_, int lane) {
    unsigned* scr = (unsigned*)scr_;
#pragma unroll
    for (int i = 0; i < 4; ++i) { const int kp = 8 * i + (lane >> 3); unsigned* q = scr + ((lane & 7) * 4) * 36 + kp;
        q[0] = cvtpk(v[2 * i][0], v[2 * i + 1][0]); q[36] = cvtpk(v[2 * i][1], v[2 * i + 1][1]); q[72] = cvtpk(v[2 * i][2], v[2 * i + 1][2]); q[108] = cvtpk(v[2 * i][3], v[2 * i + 1][3]); }
    __builtin_amdgcn_s_waitcnt(0xc07f); asm volatile("" ::: "memory");
    const int c = lane & 7;
#pragma unroll
    for (int j = 0; j < 4; ++j) { const int n = (lane >> 3) + 8 * j; *(u32x4*)(dst + (size_t)n * ldd + 8 * c) = *(const u32x4*)(scr + n * 36 + 4 * c); }
    __builtin_amdgcn_s_waitcnt(0xc07f); asm volatile("" ::: "memory");
}
template <class SRC>
__device__ __forceinline__ void tr_item(const SRC& src, bf16_t* dst, size_t ldd, float* scr, int lane) { f32x4 v[8]; tr_load(src, v, lane); tr_store(v, dst, ldd, scr, lane); }
__device__ __forceinline__ int colmap(int n) {
    if (n < 4096) return n;
    if (n < 6656) return n + 16;
    if (n < 6672) return n - 6656 + 4096;
    if (n < 6696) return n;
    return -1;
}
__device__ __forceinline__ void p0_prologue(const Params& P, Frame& F_) { Frame F = reframe(F_);
    float* scr = (float*)(F.lds + F.wave * 8448);
    unsigned char* ws = P.ws;
    bf16_t* btin = (bf16_t*)(ws + WS_BTIN); bf16_t* btout = (bf16_t*)(ws + WS_BTOUT); bf16_t* w1t = (bf16_t*)(ws + WS_W1T);
    constexpr int I_IN = 32 * 216, I_OUT = 32 * 64, I_W1 = 2 * 64 * 8;
    for (int it = F.gw; it < I_IN + I_OUT + I_W1; it += F.NGW) {
        int r = it;
        if (r < I_IN) { const int kb = r / 216, nb = r % 216, k0 = kb * 64, n0 = nb * 32; const float* w = P.w_in; const float* g = P.norm_mix_g;
            tr_item([&](int kk, int nn) { const int c = colmap(n0 + nn); return c < 0 ? (f32x4){0.f, 0.f, 0.f, 0.f} : *(const f32x4*)(w + (size_t)(k0 + kk) * 6696 + c) * g[k0 + kk]; }, btin + (size_t)n0 * DM + k0, DM, scr, F.lane); continue; }
        r -= I_IN;
        if (r < I_OUT) { const int kb = r / 64, nb = r % 64, k0 = kb * 64, n0 = nb * 32; const float* w = P.w_out;
            tr_item([&](int kk, int nn) { return *(const f32x4*)(w + (size_t)(k0 + kk) * DM + n0 + nn); }, btout + (size_t)n0 * DM + k0, DM, scr, F.lane); continue; }
        r -= I_OUT;
        { const int tensor = r / 512, rr = r % 512, kb = rr / 8, nb = rr % 8, k0 = kb * 64, n0 = nb * 32; const float* w = tensor ? P.cmp_w1_v : P.cmp_w1_k;
            tr_item([&](int kk, int nn) { return (n0 + nn) < 128 ? *(const f32x4*)(w + (size_t)(k0 + kk) * 128 + n0 + nn) : (f32x4){0.f, 0.f, 0.f, 0.f}; }, w1t + (size_t)tensor * 256 * 4096 + (size_t)n0 * 4096 + k0, 4096, scr, F.lane); }
    }
    float* biasp = (float*)(ws + WS_RSTD1);
    for (int it = F.NGW - 1 - F.gw; it < 128; it += F.NGW) { const int tensor = it >> 6, hh = (it >> 5) & 1, kc = it & 31; const float* w = tensor ? P.cmp_w1_v : P.cmp_w1_k; const float* pos = tensor ? P.cmp_pos_v : P.cmp_pos_k;
        float a0 = 0.f, a1 = 0.f, a2 = 0.f, a3 = 0.f; const int h = hh * 64 + F.lane;
#pragma unroll 8
        for (int k = kc * 128; k < kc * 128 + 128; k += 4) { a0 += pos[k] * w[(size_t)k * 128 + h]; a1 += pos[k + 1] * w[(size_t)(k + 1) * 128 + h]; a2 += pos[k + 2] * w[(size_t)(k + 2) * 128 + h]; a3 += pos[k + 3] * w[(size_t)(k + 3) * 128 + h]; }
        biasp[(tensor * 32 + kc) * 128 + h] = (a0 + a1) + (a2 + a3); }
    { bf16_t* whi = (bf16_t*)(ws + WS_WR); bf16_t* wlo = (bf16_t*)(ws + WS_WR + 512 * 1024);
      for (int it = F.bid * 512 + F.tid; it < 80 * 256; it += F.G * 512) { const int n = it >> 8, k0 = (it & 255) * 8; unsigned hi[8], lo[8];
          const float* wsrc = n < 8 ? P.w_group + n : P.w_router + (n < 72 ? n - 8 : 0); const int wstr = n < 8 ? 8 : 64; const bool wok = n < 72;
#pragma unroll
          for (int j = 0; j < 8; ++j) { const int k = k0 + j; float v = wsrc[(size_t)k * wstr]; v = wok ? v * P.norm_ffn_g[k] : 0.f;
              hi[j] = f2bf(v); lo[j] = f2bf(v - bf2f(hi[j])); }
          u32x4 a, b; a.x = hi[0] | (hi[1] << 16); a.y = hi[2] | (hi[3] << 16); a.z = hi[4] | (hi[5] << 16); a.w = hi[6] | (hi[7] << 16);
          b.x = lo[0] | (lo[1] << 16); b.y = lo[2] | (lo[3] << 16); b.z = lo[4] | (lo[5] << 16); b.w = lo[6] | (lo[7] << 16);
          *(u32x4*)(whi + (size_t)n * DM + k0) = a; *(u32x4*)(wlo + (size_t)n * DM + k0) = b; } }
    { bf16_t* w2t = (bf16_t*)(ws + WS_WR + 896 * 1024);
      for (int it = F.bid * 512 + F.tid; it < 2 * 128 * 128; it += F.G * 512) { const int t = it >> 14, n = (it >> 7) & 127, k = it & 127; const float* w2 = t ? P.cmp_w2_v : P.cmp_w2_k; w2t[it] = (bf16_t)f2bf(w2[k * 128 + n]); } }
    bf16_t* xb = (bf16_t*)(ws + WS_R0); float* rstd1 = (float*)(ws + WS_RSTD1);
    for (int m = F.gw; m < T; m += 2 * F.NGW) {
        const int m2 = m + F.NGW; const bool has2 = m2 < T; const int m2c = has2 ? m2 : m;
        const f32x4* xr = (const f32x4*)(P.x + (size_t)m * DM) + F.lane; const f32x4* xr2 = (const f32x4*)(P.x + (size_t)m2c * DM) + F.lane; f32x4 v[8], v2[8]; float s = 0.f, s2 = 0.f;
#pragma unroll
        for (int j = 0; j < 8; ++j) v[j] = xr[64 * j];
#pragma unroll
        for (int j = 0; j < 8; ++j) v2[j] = xr2[64 * j];
#pragma unroll
        for (int j = 0; j < 8; ++j) { s += (v[j][0] * v[j][0] + v[j][1] * v[j][1]) + (v[j][2] * v[j][2] + v[j][3] * v[j][3]); s2 += (v2[j][0] * v2[j][0] + v2[j][1] * v2[j][1]) + (v2[j][2] * v2[j][2] + v2[j][3] * v2[j][3]); }
        s = wave_sum(s); s2 = wave_sum(s2); const float rs = rsqrtf(s * (1.0f / DM) + EPS), rs2 = rsqrtf(s2 * (1.0f / DM) + EPS);
        u32x2* o = (u32x2*)(xb + (size_t)m * DM) + F.lane; u32x2* o2 = (u32x2*)(xb + (size_t)m2c * DM) + F.lane;
#pragma unroll
        for (int j = 0; j < 8; ++j) { u32x2 w; w.x = cvtpk(v[j][0] * rs, v[j][1] * rs); w.y = cvtpk(v[j][2] * rs, v[j][3] * rs); o[64 * j] = w; }
        if (has2) {
#pragma unroll
            for (int j = 0; j < 8; ++j) { u32x2 w; w.x = cvtpk(v2[j][0] * rs2, v2[j][1] * rs2); w.y = cvtpk(v2[j][2] * rs2, v2[j][3] * rs2); o2[64 * j] = w; } }
    }
    { u32x4* pad = (u32x4*)(ws + WS_CMPBUF + 32 * MiB); for (int i = F.bid * 512 + F.tid; i < 4096; i += F.G * 512) pad[i] = (u32x4){0u, 0u, 0u, 0u}; }
}

__device__ __forceinline__ void cmp2_phase(const Params& P, Frame& F_) { Frame F = reframe(F_);
    if (F.G == 256) {
        unsigned char* ws = P.ws; const float* hids = (const float*)(ws + WS_HIDS); const float* bias = (const float*)(ws + WS_RSTD1); bf16_t* kc = (bf16_t*)(ws + WS_KC); const bf16_t* w2t = (const bf16_t*)(ws + WS_WR + 896 * 1024);
        unsigned char* Gl = F.lds;
        const int tid = F.tid, lane = F.lane, w = F.wave, r16 = lane & 15, gq = lane >> 4, rl = tid >> 7, e = tid & 127;
        bf16x8 bfr[2][4];
#pragma unroll
        for (int t = 0; t < 2; ++t)
#pragma unroll
            for (int ks = 0; ks < 4; ++ks) bfr[t][ks] = *(const bf16x8*)(w2t + (size_t)(t * 128 + 16 * w + r16) * 128 + 32 * ks + 8 * gq);
        const size_t sl = (size_t)8 * 1024 * 128;
        float hv[8];
#pragma unroll
        for (int it = 0; it < 8; ++it) { const int rowi = (F.bid + 256 * it) * 4 + rl; const float* hr = hids + (size_t)rowi * 128 + e; hv[it] = (hr[0] + hr[sl]) + (hr[2 * sl] + hr[3 * sl]); }
        float bs[2] = {0.f, 0.f};
#pragma unroll
        for (int t = 0; t < 2; ++t) for (int kq = 0; kq < 32; ++kq) bs[t] += bias[(t * 32 + kq) * 128 + e];
        __syncthreads();
#pragma unroll
        for (int it = 0; it < 8; ++it) { const int t = it >> 2, row16 = (it & 3) * 4 + rl; *(bf16_t*)(Gl + t * 4352 + row16 * 272 + e * 2) = (bf16_t)f2bf(gelu_tanh(hv[it] + bs[t])); }
        __syncthreads();
#pragma unroll
        for (int t = 0; t < 2; ++t) { f32x4 acc = (f32x4){0.f, 0.f, 0.f, 0.f};
#pragma unroll
            for (int ks = 0; ks < 4; ++ks) { const bf16x8 a = *(const bf16x8*)(Gl + t * 4352 + r16 * 272 + (32 * ks + 8 * gq) * 2); acc = __builtin_amdgcn_mfma_f32_16x16x32_bf16(a, bfr[t][ks], acc, 0, 0, 0); }
#pragma unroll
            for (int r = 0; r < 4; ++r) { const int row16 = 4 * gq + r, it = t * 4 + (row16 >> 2), rowi = (F.bid + 256 * it) * 4 + (row16 & 3), n = rowi & 1023;
                kc[(size_t)rowi * 128 + 16 * w + r16] = (bf16_t)(n < 1023 ? f2bf(acc[r]) : 0u); } }
        __syncthreads();
        return;
    }
    unsigned char* ws = P.ws; const float* hids = (const float*)(ws + WS_HIDS); const float* bias = (const float*)(ws + WS_RSTD1); bf16_t* kc = (bf16_t*)(ws + WS_KC);
    float* hl = (float*)F.lds;
    const int rl = F.tid >> 7, e = F.tid & 127; int cur_t = -1; float bsum = 0.f;
    for (int rg = F.bid; rg < 2048; rg += F.G) {
        const int rowi = rg * 4 + rl, seg = rowi >> 10, n = rowi & 1023; const float* w2 = (seg >> 2) ? P.cmp_w2_v : P.cmp_w2_k;
        if ((seg >> 2) != cur_t) { cur_t = seg >> 2; bsum = 0.f; for (int kc = 0; kc < 32; ++kc) bsum += bias[(cur_t * 32 + kc) * 128 + e]; }
        const float* hr = hids + (size_t)rowi * 128 + e;
        const float hv = ((hr[0] + hr[(size_t)8 * 1024 * 128]) + (hr[(size_t)2 * 8 * 1024 * 128] + hr[(size_t)3 * 8 * 1024 * 128])) + bsum;
        __syncthreads();
        hl[rl * 128 + e] = gelu_tanh(hv);
        __syncthreads();
        float a = 0.f; const float* hrow = hl + rl * 128;
#pragma unroll 8
        for (int hh = 0; hh < 128; ++hh) a += hrow[hh] * w2[hh * 128 + e];
        kc[(size_t)rowi * 128 + e] = (bf16_t)(n < 1023 ? f2bf(a) : 0u);
    }
}

__device__ __forceinline__ unsigned off_b(unsigned row, unsigned ch) { return 256u * row + 16u * (ch ^ (((row & 3u) << 2) | ((row >> 2) & 3u))); }
__device__ __forceinline__ void stage_tile(unsigned char* dst, const bf16_t* src, size_t stride, int tid) {
    const int row = tid >> 3, ch0 = (tid & 7) * 2; const u32x4* s = (const u32x4*)(src + (size_t)row * stride + ch0 * 8);
    const u32x4 a = s[0], b = s[1];
    *(u32x4*)(dst + off_b(row, ch0)) = a; *(u32x4*)(dst + off_b(row, ch0 + 1)) = b;
}
struct T2 { u32x4 a, b; };
__device__ __forceinline__ void t2_load(T2& R, const bf16_t* src, size_t stride, int tid) { const int row = tid >> 3, ch0 = (tid & 7) * 2; const u32x4* sp = (const u32x4*)(src + (size_t)row * stride + ch0 * 8); R.a = sp[0]; R.b = sp[1]; }
__device__ __forceinline__ void t2_store(const T2& R, unsigned char* dst, int tid) { const int row = tid >> 3, ch0 = (tid & 7) * 2; *(u32x4*)(dst + off_b(row, ch0)) = R.a; *(u32x4*)(dst + off_b(row, ch0 + 1)) = R.b; }
struct NsaLane { int r16, gq, kaddr[4], vaddr[8], a8[4][2], ubase, kb, kh, vb, vh; };
__device__ __forceinline__ void qk_tile(const unsigned char* Kt, const NsaLane& L, const bf16x8 (&qf)[4], f32x4 (&acc)[4]) {
#pragma unroll
    for (int rb = 0; rb < 4; ++rb) { acc[rb] = (f32x4){0.f, 0.f, 0.f, 0.f};
#pragma unroll
        for (int ks = 0; ks < 4; ++ks) { const bf16x8 a = *(const bf16x8*)(Kt + L.kaddr[ks] + rb * 4096); acc[rb] = __builtin_amdgcn_mfma_f32_16x16x32_bf16(a, qf[ks], acc[rb], 0, 0, 0); } }
}
__device__ __forceinline__ void pv_tile(const unsigned char* Vt, const NsaLane& L, const f32x4 (&p)[4], f32x4 (&o)[8]) {
#pragma unroll
    for (int ks2 = 0; ks2 < 2; ++ks2) {
        u32x4 pw; pw.x = cvtpk(p[2 * ks2][0], p[2 * ks2][1]); pw.y = cvtpk(p[2 * ks2][2], p[2 * ks2][3]); pw.z = cvtpk(p[2 * ks2 + 1][0], p[2 * ks2 + 1][1]); pw.w = cvtpk(p[2 * ks2 + 1][2], p[2 * ks2 + 1][3]);
        const bf16x8 pb = __builtin_bit_cast(bf16x8, pw);
#pragma unroll
        for (int c = 0; c < 8; ++c) {
            const s16x4 v0 = __builtin_amdgcn_ds_read_tr16_b64_v4i16((LAS s16x4*)(Vt + L.vaddr[c] + 256 * (32 * ks2)));
            const s16x4 v1 = __builtin_amdgcn_ds_read_tr16_b64_v4i16((LAS s16x4*)(Vt + L.vaddr[c] + 256 * (32 * ks2 + 16)));
            const bf16x8 va = {v0[0], v0[1], v0[2], v0[3], v1[0], v1[1], v1[2], v1[3]};
            o[c] = __builtin_amdgcn_mfma_f32_16x16x32_bf16(va, pb, o[c], 0, 0, 0);
        }
    }
}
__device__ __forceinline__ float red_gq_max(float v) { v = fmaxf(v, __shfl_xor(v, 16)); v = fmaxf(v, __shfl_xor(v, 32)); return v; }
__device__ __forceinline__ float red_gq_sum(float v) { v += __shfl_xor(v, 16); v += __shfl_xor(v, 32); return v; }
__device__ __forceinline__ void osm_step(f32x4 (&s2)[4], float& m, float& l, f32x4 (&o)[8]) {
    float tm = -INFINITY;
#pragma unroll
    for (int rb = 0; rb < 4; ++rb) tm = fmaxf(tm, fmaxf(fmaxf(s2[rb][0], s2[rb][1]), fmaxf(s2[rb][2], s2[rb][3])));
    tm = red_gq_max(tm);
    const float mn = fmaxf(m, tm), alpha = exp2f(m - mn); float ps = 0.f;
#pragma unroll
    for (int rb = 0; rb < 4; ++rb)
#pragma unroll
        for (int r = 0; r < 4; ++r) { const float p = exp2f(s2[rb][r] - mn); s2[rb][r] = p; ps += p; }
    l = l * alpha + ps; m = mn;
#pragma unroll
    for (int c = 0; c < 8; ++c) o[c] *= alpha;
}
constexpr int NSA_KV0 = 0, NSA_KV1 = 32768, NSA_IMP = 65536, NSA_SELM = 131072, NSA_UNI = 133120, NSA_LIST = 133248, NSA_GATE = 133632;
struct DmaLane { unsigned rowl, chx, chk; };
template <bool KIMG> __device__ __forceinline__ void tile_dma(const bf16_t* src, size_t stride, unsigned char* dst, const DmaLane& D, int w) {
    unsigned ln = D.rowl; asm volatile("" : "+v"(ln));
    const unsigned rowl = ln >> 4, ch = KIMG ? ((ln & 15u) ^ ((4u * ((unsigned)w & 3u) + rowl) & 15u)) : ((ln & 15u) ^ ((rowl << 2) | ((unsigned)w & 3u)));
#pragma unroll
    for (int i2 = 0; i2 < 2; ++i2) { const int row = 4 * (8 * i2 + w) + (int)rowl;
        __builtin_amdgcn_global_load_lds((const unsigned*)(src + (size_t)row * stride + ch * 8), (LAS unsigned*)(dst + (8 * i2 + w) * 1024), 16, 0, 0); }
}
#define DMA_WAIT() asm volatile("s_waitcnt vmcnt(0)" ::: "memory")
__device__ __forceinline__ void qk_tile2(const unsigned char* Kt, const NsaLane& L, const bf16x8 (&qf)[2][4], f32x4 (&acc)[2][4]) {
    int kh = L.kh; asm volatile("" : "+v"(kh)); const unsigned char* Kb = Kt + L.kb;
    bf16x8 fr[4];
#define QK_LD(f) fr[(f) & 3] = *(const bf16x8*)(Kb + ((64 * ((f) & 3)) ^ kh) + ((f) >> 2) * 4096)
    QK_LD(0); QK_LD(1); QK_LD(2);
#pragma unroll
    for (int f = 0; f < 16; ++f) { const int rb = f >> 2, ks = f & 3;
        if (f + 3 < 16) QK_LD(f + 3);
        if (ks == 0) { acc[0][rb] = (f32x4){0.f, 0.f, 0.f, 0.f}; acc[1][rb] = (f32x4){0.f, 0.f, 0.f, 0.f}; }
        acc[0][rb] = __builtin_amdgcn_mfma_f32_16x16x32_bf16(fr[f & 3], qf[0][ks], acc[0][rb], 0, 0, 0); acc[1][rb] = __builtin_amdgcn_mfma_f32_16x16x32_bf16(fr[f & 3], qf[1][ks], acc[1][rb], 0, 0, 0);
        __builtin_amdgcn_sched_barrier(0); }
#undef QK_LD
}
__device__ __forceinline__ void pv_tile2(const unsigned char* Vt, const NsaLane& L, const f32x4 (&p)[2][4], f32x4 (&o)[2][8]) {
    int vh = L.vh; asm volatile("" : "+v"(vh)); const unsigned char* Vb = Vt + L.vb;
    bf16x8 pb[2][2];
#pragma unroll
    for (int ks2 = 0; ks2 < 2; ++ks2)
#pragma unroll
        for (int j = 0; j < 2; ++j) { u32x4 pw; pw.x = cvtpk(p[j][2 * ks2][0], p[j][2 * ks2][1]); pw.y = cvtpk(p[j][2 * ks2][2], p[j][2 * ks2][3]); pw.z = cvtpk(p[j][2 * ks2 + 1][0], p[j][2 * ks2 + 1][1]); pw.w = cvtpk(p[j][2 * ks2 + 1][2], p[j][2 * ks2 + 1][3]); pb[ks2][j] = __builtin_bit_cast(bf16x8, pw); }
    s16x4 va[3][2];
#define PV_LD(f) do { const unsigned char* a_ = Vb + ((32 * ((f) & 7)) ^ vh) + 256 * (32 * ((f) >> 3)); \
        va[(f) % 3][0] = __builtin_amdgcn_ds_read_tr16_b64_v4i16((LAS s16x4*)a_); va[(f) % 3][1] = __builtin_amdgcn_ds_read_tr16_b64_v4i16((LAS s16x4*)(a_ + 256 * 16)); } while (0)
    PV_LD(0); PV_LD(1);
#pragma unroll
    for (int f = 0; f < 16; ++f) { const int c = f & 7, ks2 = f >> 3;
        if (f + 2 < 16) PV_LD(f + 2);
        const s16x4 v0 = va[f % 3][0], v1 = va[f % 3][1];
        const bf16x8 vv = {v0[0], v0[1], v0[2], v0[3], v1[0], v1[1], v1[2], v1[3]};
        o[0][c] = __builtin_amdgcn_mfma_f32_16x16x32_bf16(vv, pb[ks2][0], o[0][c], 0, 0, 0); o[1][c] = __builtin_amdgcn_mfma_f32_16x16x32_bf16(vv, pb[ks2][1], o[1][c], 0, 0, 0);
        __builtin_amdgcn_sched_barrier(0); }
#undef PV_LD
}
__device__ __forceinline__ float max16(const f32x4 (&t)[4]) {
    float tm = fmaxf(fmaxf(fmaxf(t[0][0], t[0][1]), fmaxf(t[0][2], t[0][3])), fmaxf(fmaxf(t[1][0], t[1][1]), fmaxf(t[1][2], t[1][3])));
    return fmaxf(tm, fmaxf(fmaxf(fmaxf(t[2][0], t[2][1]), fmaxf(t[2][2], t[2][3])), fmaxf(fmaxf(t[3][0], t[3][1]), fmaxf(t[3][2], t[3][3]))));
}
__device__ __forceinline__ void osm_fast2(f32x4 (&t)[2][4], float (&m)[2], float (&l)[2], f32x4 (&o)[2][8]) {
#pragma unroll
    for (int j = 0; j < 2; ++j) {
        const float tml = max16(t[j]);
        if (__any(tml > m[j] + 8.0f)) { const float tm = red_gq_max(tml); const float mn = fmaxf(m[j], tm), alpha = ex2(m[j] - mn); l[j] *= alpha; m[j] = mn;
#pragma unroll
            for (int c = 0; c < 8; ++c) o[j][c] *= alpha; }
        float ps = 0.f;
#pragma unroll
        for (int rb = 0; rb < 4; ++rb)
#pragma unroll
            for (int r = 0; r < 4; ++r) { const float p = ex2(t[j][rb][r] - m[j]); t[j][rb][r] = p; ps += p; }
        l[j] += ps;
    }
}
#ifndef NREP_CMP
#define NREP_CMP 1
#endif
#ifndef NREP_WIN
#define NREP_WIN 1
#endif
#ifndef NREP_SEL
#define NREP_SEL 1
#endif
__device__ __forceinline__ void nsa_unit(const Params& P, Frame& F_, int unit) { Frame F = reframe(F_);
    unsigned char* ws = P.ws; const bf16_t* proj = (const bf16_t*)(ws + WS_R1); const bf16_t* kcb = (const bf16_t*)(ws + WS_KC); const float* small = (const float*)(ws + WS_SMALL);
    bf16_t* ymix = (bf16_t*)(ws + WS_R0);
    unsigned char* lds = F.lds; float* imp = (float*)(lds + NSA_IMP); unsigned* selm = (unsigned*)(lds + NSA_SELM); unsigned* uni = (unsigned*)(lds + NSA_UNI); unsigned char* slist = lds + NSA_LIST;
    const int tid = F.tid, lane = F.lane, w = F.wave;
    NsaLane L; L.r16 = lane & 15; L.gq = lane >> 4;
    const int qi = L.r16 >> 2, h = L.r16 & 3;
    {
      L.kb = 256 * L.r16 + 16 * (L.gq ^ (L.r16 & 3)); L.kh = (L.r16 & 12) << 4;
      const unsigned q4 = (unsigned)L.r16 >> 2, p = L.r16 & 3u, Xv = (q4 << 2) | (unsigned)L.gq;
      L.vb = 256 * (4 * L.gq + (int)q4) + 8 * (int)(p & 1u) + 16 * (int)((p >> 1) ^ (Xv & 1u)); L.vh = (int)((Xv & 14u) << 4); }
    const int qb = unit & 255, g = (unit >> 8) & 1, b = unit >> 9;
    const int t0 = qb * 64, head = g * 4 + h;
    int tq[2]; size_t rowq[2];
#pragma unroll
    for (int j = 0; j < 2; ++j) { tq[j] = t0 + 8 * w + 4 * j + qi; rowq[j] = (size_t)b * SEQ + tq[j]; }
    const float slope2 = exp2f(-(float)(head + 1)) * LOG2E, sc2 = 0.08838834764831845f * LOG2E;
    const float lb = slope2 * (float)(4 * L.gq);
    bf16x8 qf[2][4]; float* gatel = (float*)(lds + NSA_GATE) + w * 96 + L.r16;
#pragma unroll
    for (int j = 0; j < 2; ++j) { const bf16_t* qrow = proj + rowq[j] * NPROJ + C_NQ + head * 128;
#pragma unroll
        for (int ks = 0; ks < 4; ++ks) qf[j][ks] = *(const bf16x8*)(qrow + 32 * ks + 8 * L.gq);
#pragma unroll
        for (int k = 0; k < 3; ++k) { const float gv = sigmoid_f(small[rowq[j] * 64 + 16 + head * 3 + k]); if (L.gq == 0) gatel[(j * 3 + k) * 16] = gv; } }
    for (int i = tid; i < 64 * 256; i += 512) imp[i] = 0.f;
    f32x4 o[2][8], acc[2][4];
    u32x2* finl = (u32x2*)(lds + NSA_IMP) + w * 1024 + lane;
    DmaLane D; D.rowl = (unsigned)lane; D.chx = 0u; D.chk = 0u;
    const int ntc = ((t0 + 32) >> 4) / 64 + 1;
    int nlim[2]; nlim[0] = (tq[0] - 31) >> 4; nlim[1] = (tq[1] - 31) >> 4;
    const bf16_t* kc = kcb + (size_t)(0 * 4 + b * 2 + g) * 1024 * 128; const bf16_t* vc = kcb + (size_t)(1 * 4 + b * 2 + g) * 1024 * 128;
    const float slope16 = 16.f * slope2, lbc = 16.f * lb;
    lds_barrier();
    for (int rep_c = 0; rep_c < NREP_CMP; ++rep_c) {
    float m[2] = {-1e30f, -1e30f}, l[2] = {0.f, 0.f};
    lds_barrier();
    tile_dma<true>(kc, 128, lds + NSA_KV0, D, w);
    DMA_WAIT(); lds_barrier();
    for (int tl = 0; tl < ntc; ++tl) {
        const unsigned char* Kt = lds + (tl & 1) * 32768;
        if (tl + 1 < ntc) tile_dma<true>(kc + (size_t)(tl + 1) * 64 * 128, 128, lds + ((tl + 1) & 1) * 32768, D, w);
        qk_tile2(Kt, L, qf, acc);
        const float tb = lbc + slope16 * (float)(64 * tl);
        const bool full = __all(64 * tl + 63 <= nlim[0] && 64 * tl + 63 <= nlim[1]);
#pragma unroll
        for (int j = 0; j < 2; ++j) {
            if (full) {
#pragma unroll
                for (int rb = 0; rb < 4; ++rb)
#pragma unroll
                    for (int r = 0; r < 4; ++r) acc[j][rb][r] = fmaf(acc[j][rb][r], sc2, tb + slope16 * (float)(16 * rb + r));
            } else {
#pragma unroll
                for (int rb = 0; rb < 4; ++rb)
#pragma unroll
                    for (int r = 0; r < 4; ++r) { const int n = 64 * tl + 16 * rb + 4 * L.gq + r; acc[j][rb][r] = (n <= nlim[j]) ? fmaf(acc[j][rb][r], sc2, tb + slope16 * (float)(16 * rb + r)) : -INFINITY; }
            }
            const float tml = max16(acc[j]);
            if (__any(tml > m[j] + 8.0f)) { const float mn = fmaxf(m[j], red_gq_max(tml)); l[j] *= ex2(m[j] - mn); m[j] = mn; }
            float ps = 0.f;
#pragma unroll
            for (int rb = 0; rb < 4; ++rb)
#pragma unroll
                for (int r = 0; r < 4; ++r) ps += ex2(acc[j][rb][r] - m[j]);
            l[j] += ps;
        }
        DMA_WAIT(); lds_barrier();
    }
    float lg_inv[2];
#pragma unroll
    for (int j = 0; j < 2; ++j) { const float lt = red_gq_sum(l[j]); lg_inv[j] = lt > 0.f ? -__log2f(lt) - m[j] : -INFINITY;
#pragma unroll
        for (int c = 0; c < 8; ++c) o[j][c] = (f32x4){0.f, 0.f, 0.f, 0.f}; }
    tile_dma<true>(kc, 128, lds + NSA_KV0, D, w); tile_dma<false>(vc, 128, lds + NSA_KV0 + 16384, D, w);
    DMA_WAIT(); lds_barrier();
    for (int tl = 0; tl < ntc; ++tl) {
        const unsigned char* Kt = lds + (tl & 1) * 32768;
        if (tl + 1 < ntc) { unsigned char* nb_ = lds + ((tl + 1) & 1) * 32768; tile_dma<true>(kc + (size_t)(tl + 1) * 64 * 128, 128, nb_, D, w); tile_dma<false>(vc + (size_t)(tl + 1) * 64 * 128, 128, nb_ + 16384, D, w); }
        qk_tile2(Kt, L, qf, acc);
#pragma unroll
        for (int j = 0; j < 2; ++j) {
            const float tb = lbc + slope16 * (float)(64 * tl) + lg_inv[j];
#pragma unroll
            for (int rb = 0; rb < 4; ++rb) {
#pragma unroll
                for (int r = 0; r < 4; ++r) { const int n = 64 * tl + 16 * rb + 4 * L.gq + r; acc[j][rb][r] = (n <= nlim[j]) ? ex2(fmaf(acc[j][rb][r], sc2, tb + slope16 * (float)(16 * rb + r))) : 0.f; }
                float ia = 2.f * (acc[j][rb][0] + acc[j][rb][1] + acc[j][rb][2]) + acc[j][rb][3], ib = acc[j][rb][3];
                ia = quad_sum(ia); ib = quad_sum(ib);
                const int s0 = 16 * tl + 4 * rb + L.gq;
                if (h == 0 && rep_c == NREP_CMP - 1) { float* ip = imp + (8 * w + 4 * j + qi) * 256 + s0; atomicAdd(ip, ia); if (s0 + 1 < 256) atomicAdd(ip + 1, ib); }
            }
        }
        pv_tile2(Kt + 16384, L, acc, o);
        DMA_WAIT(); lds_barrier();
    }
    }
    const bf16_t* kwin = proj + (size_t)b * SEQ * NPROJ + C_KWIN + g * 128; const bf16_t* vwin = proj + (size_t)b * SEQ * NPROJ + C_VWIN + g * 128;
    const int kt0 = (t0 - 511) > 0 ? (t0 - 511) >> 6 : 0, kt1 = (t0 + 63) >> 6, nwt = kt1 - kt0 + 1;
    for (int jq0 = 0; jq0 < 8; jq0 += 4) {
        unsigned long long comb[4][4], cand[4];
#pragma unroll
        for (int u4 = 0; u4 < 4; ++u4) { const int qq = 8 * w + jq0 + u4, t = t0 + qq, cur = t >> 6; cand[u4] = 0ull;
#pragma unroll
            for (int i = 0; i < 4; ++i) { const int s = lane + 64 * i; const float v = imp[qq * 256 + s]; const bool forced = (s == 0) || (s == cur) || (s == cur - 1); const bool valid = s <= cur;
                const unsigned key = forced ? 0x7F000000u : (valid ? __builtin_bit_cast(unsigned, v) + 1u : 0u);
                comb[u4][i] = ((unsigned long long)key << 8) | (unsigned long long)(255 - s); } }
        for (int bit = 38; bit >= 0; --bit) {
#pragma unroll
            for (int u4 = 0; u4 < 4; ++u4) { const unsigned long long trial = cand[u4] | (1ull << bit);
                const int cnt = __popcll(__ballot(comb[u4][0] >= trial)) + __popcll(__ballot(comb[u4][1] >= trial)) + __popcll(__ballot(comb[u4][2] >= trial)) + __popcll(__ballot(comb[u4][3] >= trial));
                if (cnt >= 16) cand[u4] = trial; } }
#pragma unroll
        for (int u4 = 0; u4 < 4; ++u4) { const int qq = 8 * w + jq0 + u4;
#pragma unroll
            for (int i = 0; i < 4; ++i) { const unsigned long long mk = __ballot(comb[u4][i] >= cand[u4]); if (lane == 0) { selm[qq * 8 + 2 * i] = (unsigned)mk; selm[qq * 8 + 2 * i + 1] = (unsigned)(mk >> 32); } } }
    }
    lds_barrier();
    if (tid < 8) { unsigned uu = 0u; for (int q = 0; q < 64; ++q) uu |= selm[q * 8 + tid]; uni[tid] = uu; }
    const float gt0[2] = {gatel[0], gatel[3 * 16]};
#pragma unroll
    for (int j = 0; j < 2; ++j)
#pragma unroll
        for (int c = 0; c < 8; ++c) { u32x2 fv; fv.x = cvtpk(o[j][c][0] * gt0[j], o[j][c][1] * gt0[j]); fv.y = cvtpk(o[j][c][2] * gt0[j], o[j][c][3] * gt0[j]); finl[(j * 8 + c) * 64] = fv; }
    lds_barrier();
    int nsel = 0;
    { int pre = 0;
#pragma unroll
      for (int wd = 0; wd < 8; ++wd) { const unsigned uw = uni[wd]; if (wd == (tid >> 5) && tid < 256 && ((uw >> (tid & 31)) & 1u)) slist[pre + __popc(uw & ((1u << (tid & 31)) - 1u))] = (unsigned char)tid; pre += __popc(uw); }
      nsel = pre; }
    for (int rep_w = 0; rep_w < NREP_WIN; ++rep_w) {
        float mw_[2] = {-1e30f, -1e30f}, lw[2] = {0.f, 0.f};
        lds_barrier();
        tile_dma<true>(kwin + (size_t)kt1 * 64 * NPROJ, NPROJ, lds + NSA_KV0, D, w); tile_dma<false>(vwin + (size_t)kt1 * 64 * NPROJ, NPROJ, lds + NSA_KV0 + 16384, D, w);
#pragma unroll
        for (int j = 0; j < 2; ++j)
#pragma unroll
            for (int c = 0; c < 8; ++c) o[j][c] = (f32x4){0.f, 0.f, 0.f, 0.f};
        DMA_WAIT(); lds_barrier();
        for (int it = 0; it < nwt; ++it) {
            const unsigned char* Kt = lds + (it & 1) * 32768; const int kt = kt1 - it;
            if (it + 1 < nwt) { unsigned char* nb_ = lds + ((it + 1) & 1) * 32768; tile_dma<true>(kwin + (size_t)(kt - 1) * 64 * NPROJ, NPROJ, nb_, D, w); tile_dma<false>(vwin + (size_t)(kt - 1) * 64 * NPROJ, NPROJ, nb_ + 16384, D, w); }
            qk_tile2(Kt, L, qf, acc);
            const float tb = lb + slope2 * (float)(64 * kt); const int d0[2] = {tq[0] - 64 * kt, tq[1] - 64 * kt};
            const bool full = __all(d0[0] >= 63 && d0[0] < 512 && d0[1] >= 63 && d0[1] < 512);
#pragma unroll
            for (int j = 0; j < 2; ++j) {
                if (full) {
#pragma unroll
                    for (int rb = 0; rb < 4; ++rb)
#pragma unroll
                        for (int r = 0; r < 4; ++r) acc[j][rb][r] = fmaf(acc[j][rb][r], sc2, tb + slope2 * (float)(16 * rb + r));
                } else {
#pragma unroll
                    for (int rb = 0; rb < 4; ++rb)
#pragma unroll
                        for (int r = 0; r < 4; ++r) { const int dist = d0[j] - (16 * rb + 4 * L.gq + r); acc[j][rb][r] = (dist >= 0 && dist < 512) ? fmaf(acc[j][rb][r], sc2, tb + slope2 * (float)(16 * rb + r)) : -INFINITY; }
                }
            }
            osm_fast2(acc, mw_, lw, o);
            pv_tile2(Kt + 16384, L, acc, o);
            DMA_WAIT(); lds_barrier();
        }
        if (rep_w == NREP_WIN - 1) {
#pragma unroll
        for (int j = 0; j < 2; ++j) { const float lt = red_gq_sum(lw[j]); const float il = lt > 0.f ? gatel[(j * 3 + 2) * 16] / lt : 0.f;
#pragma unroll
            for (int c = 0; c < 8; ++c) { const u32x2 fp = finl[(j * 8 + c) * 64]; const float f0 = bflo(fp.x) + o[j][c][0] * il, f1 = bfhi(fp.x) + o[j][c][1] * il, f2 = bflo(fp.y) + o[j][c][2] * il, f3 = bfhi(fp.y) + o[j][c][3] * il;
                u32x2 fv; fv.x = cvtpk(f0, f1); fv.y = cvtpk(f2, f3); finl[(j * 8 + c) * 64] = fv; } } }
    }
    for (int rep_s = 0; rep_s < NREP_SEL; ++rep_s) {
        float ms[2] = {-1e30f, -1e30f}, ls[2] = {0.f, 0.f};
        lds_barrier();
#pragma unroll
        for (int j = 0; j < 2; ++j)
#pragma unroll
            for (int c = 0; c < 8; ++c) o[j][c] = (f32x4){0.f, 0.f, 0.f, 0.f};
        const bf16_t* ksel = proj + (size_t)b * SEQ * NPROJ + C_KSEL + g * 128; const bf16_t* vsel = proj + (size_t)b * SEQ * NPROJ + C_VSEL + g * 128;
        { const int s0_ = slist[nsel - 1]; tile_dma<true>(ksel + (size_t)s0_ * 64 * NPROJ, NPROJ, lds + NSA_KV0, D, w); tile_dma<false>(vsel + (size_t)s0_ * 64 * NPROJ, NPROJ, lds + NSA_KV0 + 16384, D, w); }
        DMA_WAIT(); lds_barrier();
        for (int it = 0; it < nsel; ++it) {
            const unsigned char* Kt = lds + (it & 1) * 32768; const int sblk = slist[nsel - 1 - it];
            if (it + 1 < nsel) { const int sn = slist[nsel - 2 - it]; unsigned char* nb_ = lds + ((it + 1) & 1) * 32768; tile_dma<true>(ksel + (size_t)sn * 64 * NPROJ, NPROJ, nb_, D, w); tile_dma<false>(vsel + (size_t)sn * 64 * NPROJ, NPROJ, nb_ + 16384, D, w); }
            bool mine[2];
#pragma unroll
            for (int j = 0; j < 2; ++j) mine[j] = (selm[(8 * w + 4 * j + qi) * 8 + (sblk >> 5)] >> (sblk & 31)) & 1u;
            if (__any(mine[0] || mine[1])) {
                qk_tile2(Kt, L, qf, acc);
                const float tb = lb + slope2 * (float)(64 * sblk); const int d0[2] = {tq[0] - 64 * sblk, tq[1] - 64 * sblk};
                const bool full = __all(mine[0] && mine[1] && d0[0] >= 63 && d0[1] >= 63);
#pragma unroll
                for (int j = 0; j < 2; ++j) {
                    if (full) {
#pragma unroll
                        for (int rb = 0; rb < 4; ++rb)
#pragma unroll
                            for (int r = 0; r < 4; ++r) acc[j][rb][r] = fmaf(acc[j][rb][r], sc2, tb + slope2 * (float)(16 * rb + r));
                    } else {
#pragma unroll
                        for (int rb = 0; rb < 4; ++rb)
#pragma unroll
                            for (int r = 0; r < 4; ++r) { const int dist = d0[j] - (16 * rb + 4 * L.gq + r); acc[j][rb][r] = (mine[j] && dist >= 0) ? fmaf(acc[j][rb][r], sc2, tb + slope2 * (float)(16 * rb + r)) : -INFINITY; }
                    }
                }
                osm_fast2(acc, ms, ls, o);
                pv_tile2(Kt + 16384, L, acc, o);
            }
            DMA_WAIT(); lds_barrier();
        }
        if (rep_s == NREP_SEL - 1) {
#pragma unroll
        for (int j = 0; j < 2; ++j) { const float lt = red_gq_sum(ls[j]); const float il = lt > 0.f ? gatel[(j * 3 + 1) * 16] / lt : 0.f;
            f32x4 fin[8]; float ss = 0.f;
#pragma unroll
            for (int c = 0; c < 8; ++c) { const u32x2 fp = finl[(j * 8 + c) * 64]; fin[c][0] = bflo(fp.x) + o[j][c][0] * il; fin[c][1] = bfhi(fp.x) + o[j][c][1] * il; fin[c][2] = bflo(fp.y) + o[j][c][2] * il; fin[c][3] = bfhi(fp.y) + o[j][c][3] * il;
                ss += (fin[c][0] * fin[c][0] + fin[c][1] * fin[c][1]) + (fin[c][2] * fin[c][2] + fin[c][3] * fin[c][3]); }
            ss = red_gq_sum(ss);
            const float rn = rsqrtf(ss * (1.0f / 128.f) + EPS);
            bf16_t* yo = ymix + ((size_t)b * SEQ + (t0 + 8 * w + 4 * j + qi)) * DM + 1024 + head * 128;
#pragma unroll
            for (int c = 0; c < 8; ++c) { const int d = 16 * c + 4 * L.gq; const f32x4 gg = *(const f32x4*)(P.nsa_norm_g + d);
                u32x2 wv; wv.x = cvtpk(fin[c][0] * rn * gg[0], fin[c][1] * rn * gg[1]); wv.y = cvtpk(fin[c][2] * rn * gg[2], fin[c][3] * rn * gg[3]); *(u32x2*)(yo + d) = wv; } } }
    }
}
__device__ __forceinline__ bf16x8 afrag8(const unsigned char* img, const NsaLane& L, int mb, int ks) {
    const u32x2 lo = *(const u32x2*)(img + L.a8[ks][0] + mb * 4096), hi = *(const u32x2*)(img + L.a8[ks][1] + mb * 4096);
    const u32x4 v = {lo.x, lo.y, hi.x, hi.y}; return __builtin_bit_cast(bf16x8, v);
}
__device__ __forceinline__ int perm32k(int c) { return (c & ~31) | (((c >> 2) & 3) << 3) | (((c >> 4) & 1) << 2) | (c & 3); }
__device__ __forceinline__ bf16x8 afrag16(const unsigned char* img, const NsaLane& L, int mb, int ks) { return *(const bf16x8*)(img + L.kaddr[ks] + mb * 4096); }
__device__ __forceinline__ void dn_lane_init(NsaLane& L, int lane, int w) {
    L.r16 = lane & 15; L.gq = lane >> 4;
    const unsigned Xk = ((L.r16 & 3u) << 2) | ((unsigned)L.r16 >> 2);
#pragma unroll
    for (int ks = 0; ks < 4; ++ks) { L.kaddr[ks] = 256 * L.r16 + 16 * (int)(((unsigned)(4 * ks + L.gq)) ^ Xk);
#pragma unroll
        for (int hf = 0; hf < 2; ++hf) L.a8[ks][hf] = 256 * L.r16 + 16 * (int)(((unsigned)(4 * ks + 2 * hf + (L.gq >> 1))) ^ Xk) + 8 * (L.gq & 1); }
    const unsigned q4 = (unsigned)L.r16 >> 2, p = L.r16 & 3u, Xv = (q4 << 2) | (unsigned)L.gq;
#pragma unroll
    for (int c = 0; c < 8; ++c) L.vaddr[c] = 256 * (4 * L.gq + (int)q4) + 16 * (int)(((unsigned)(2 * c) + (p >> 1)) ^ Xv) + 8 * (int)(p & 1u);
    L.ubase = 256 * (4 * L.gq + (int)q4) + 16 * (int)(((unsigned)(2 * w) + (p >> 1)) ^ Xv) + 8 * (int)(p & 1u);
}
__device__ __forceinline__ f32x4 tr_c4(const unsigned char* img, const NsaLane& L, int mb) {
    const s16x4 t = __builtin_amdgcn_ds_read_tr16_b64_v4i16((LAS s16x4*)(img + L.ubase + mb * 4096));
    return (f32x4){bf2f((unsigned short)t[0]), bf2f((unsigned short)t[1]), bf2f((unsigned short)t[2]), bf2f((unsigned short)t[3])};
}
__device__ __forceinline__ void pack_tiles(const f32x4* X, int ntile2, bf16x8* out) {
    for (int k = 0; k < ntile2; ++k) { u32x4 v; v.x = cvtpk(X[2 * k][0], X[2 * k][1]); v.y = cvtpk(X[2 * k][2], X[2 * k][3]); v.z = cvtpk(X[2 * k + 1][0], X[2 * k + 1][1]); v.w = cvtpk(X[2 * k + 1][2], X[2 * k + 1][3]); out[k] = __builtin_bit_cast(bf16x8, v); }
}
template <bool HAS_U, bool HAS_OUT>
__device__ __forceinline__ void dn_step(const unsigned char* Wimg, const unsigned char* Kimg, const unsigned char* Uimg, const unsigned char* Qimg, const unsigned char* QKimg,
                                        const float* gct, const NsaLane& L, f32x4 (&S)[8], f32x4 (&o)[4]) {
    bf16x8 sf[4];
#pragma unroll
    for (int k = 0; k < 4; ++k) { u32x4 v; v.x = cvtpk(S[2 * k][0], S[2 * k][1]); v.y = cvtpk(S[2 * k][2], S[2 * k][3]); v.z = cvtpk(S[2 * k + 1][0], S[2 * k + 1][1]); v.w = cvtpk(S[2 * k + 1][2], S[2 * k + 1][3]); sf[k] = __builtin_bit_cast(bf16x8, v); }
    f32x4 wsv[4], o1[4];
#pragma unroll
    for (int mb = 0; mb < 4; ++mb) { wsv[mb] = (f32x4){0.f, 0.f, 0.f, 0.f}; o1[mb] = (f32x4){0.f, 0.f, 0.f, 0.f};
#pragma unroll
        for (int ks = 0; ks < 4; ++ks) { wsv[mb] = __builtin_amdgcn_mfma_f32_16x16x32_bf16(afrag16(Wimg, L, mb, ks), sf[ks], wsv[mb], 0, 0, 0);
            if (HAS_OUT) o1[mb] = __builtin_amdgcn_mfma_f32_16x16x32_bf16(afrag16(Qimg, L, mb, ks), sf[ks], o1[mb], 0, 0, 0); }
        if (mb & 1) asm volatile("" ::: "memory"); }
    f32x4 vn[4], vs[4];
#pragma unroll
    for (int mb = 0; mb < 4; ++mb) { f32x4 uu = (f32x4){0.f, 0.f, 0.f, 0.f}; if (HAS_U) uu = tr_c4(Uimg, L, mb); vn[mb] = uu - wsv[mb];
        vs[mb] = vn[mb] * *(const f32x4*)(gct + 64 + 16 * mb + 4 * L.gq); }
    const float dl = gct[191];
#pragma unroll
    for (int c = 0; c < 8; ++c) S[c] *= dl;
    pv_tile(Kimg, L, vs, S);
    if (HAS_OUT) {
        bf16x8 vf[2];
#pragma unroll
        for (int k = 0; k < 2; ++k) { u32x4 v; v.x = cvtpk(vn[2 * k][0], vn[2 * k][1]); v.y = cvtpk(vn[2 * k][2], vn[2 * k][3]); v.z = cvtpk(vn[2 * k + 1][0], vn[2 * k + 1][1]); v.w = cvtpk(vn[2 * k + 1][2], vn[2 * k + 1][3]); vf[k] = __builtin_bit_cast(bf16x8, v); }
#pragma unroll
        for (int mb = 0; mb < 4; ++mb) { f32x4 o2 = (f32x4){0.f, 0.f, 0.f, 0.f};
#pragma unroll
            for (int k2 = 0; k2 < 2; ++k2) o2 = __builtin_amdgcn_mfma_f32_16x16x32_bf16(afrag16(QKimg, L, mb, k2), vf[k2], o2, 0, 0, 0);
            o[mb] = *(const f32x4*)(gct + 128 + 16 * mb + 4 * L.gq) * o1[mb] + o2; }
    }
}
constexpr int DP_K = 0, DP_Q = 16384, DP_V = 32768, DP_LOFF = 49152, DP_LD = 65536, DP_T = 69632, DP_TAB = 71680, DP_RAW = 73728;
__device__ __forceinline__ void dn_prep_unit(const Params& P, Frame& F_, int unit) { Frame F = reframe(F_);
    unsigned char* ws = P.ws; const bf16_t* proj = (const bf16_t*)(ws + WS_R1); const float* small = (const float*)(ws + WS_SMALL);
    bf16_t* qn = (bf16_t*)(ws + WS_QN); bf16_t* kn = (bf16_t*)(ws + WS_KN); bf16_t* ub = (bf16_t*)(ws + WS_VN); bf16_t* wb = (bf16_t*)(ws + WS_WN); bf16_t* qkb = (bf16_t*)(ws + WS_QK); float* gcb = (float*)(ws + WS_GDEC);
    unsigned char* lds = F.lds; unsigned char* Kimg = lds + DP_K; unsigned char* Qimg = lds + DP_Q; unsigned char* Vimg = lds + DP_V; unsigned char* Loff = lds + DP_LOFF; float* Ld = (float*)(lds + DP_LD); unsigned char* Timg = lds + DP_T;
    float* gt = (float*)(lds + DP_TAB); float* bt = gt + 64; float* gct = gt + 128; unsigned char* raw = lds + DP_RAW;
    const int tid = F.tid, lane = F.lane, w = F.wave;
    const int chain = unit >> 8, cch = unit & 255, b = chain >> 3, h = chain & 7, t0 = cch * 64; const size_t row0 = (size_t)b * SEQ + t0;
    { u32x4 rv[7];
#pragma unroll
      for (int k = 0; k < 7; ++k) { const int i = tid + 512 * k, ic = i < 67 * 48 ? i : 67 * 48 - 1; const int rr = ic / 48, cc = ic % 48, s = cc >> 4, c16 = cc & 15; const int tr = (t0 + rr - 3) >= 0 ? rr - 3 : -t0;
          rv[k] = *(const u32x4*)(proj + (row0 + tr) * NPROJ + s * 1024 + h * 128 + c16 * 8); }
#pragma unroll
      for (int k = 0; k < 7; ++k) { const int i = tid + 512 * k; if (i < 67 * 48) { const int rr = i / 48, cc = i % 48; const bool ok = (t0 + rr - 3) >= 0;
          *(u32x4*)(raw + rr * 768 + cc * 16) = ok ? rv[k] : (u32x4){0u, 0u, 0u, 0u}; } } }
    float cw[3][4][2];
#pragma unroll
    for (int s = 0; s < 3; ++s)
#pragma unroll
        for (int i = 0; i < 4; ++i) { cw[s][i][0] = P.conv_w[i * 3072 + s * 1024 + h * 128 + 2 * lane]; cw[s][i][1] = P.conv_w[i * 3072 + s * 1024 + h * 128 + 2 * lane + 1]; }
    const float Ah = -__expf(P.a_log[h]), dtb = P.dt_bias[h];
    const size_t grow = row0 + 8 * w + (lane & 7); const float sb1 = small[grow * 64 + h], sa1 = small[grow * 64 + 8 + h];
    lds_barrier();
#pragma unroll
    for (int ii = 0; ii < 8; ++ii) {
        const int i = 8 * w + ii; const size_t row = row0 + i;
        float o[3][2];
#pragma unroll
        for (int s = 0; s < 3; ++s) { float a0 = 0.f, a1 = 0.f;
#pragma unroll
            for (int j = 0; j < 4; ++j) { const unsigned wv = *(const unsigned*)(raw + (i + j) * 768 + s * 256 + 4 * lane); a0 += cw[s][j][0] * bflo(wv); a1 += cw[s][j][1] * bfhi(wv); }
            o[s][0] = silu_f(a0); o[s][1] = silu_f(a1); }
        const float sq = wave_sum(o[0][0] * o[0][0] + o[0][1] * o[0][1]), sk = wave_sum(o[1][0] * o[1][0] + o[1][1] * o[1][1]);
        const float rq = rsqrtf(sq + EPS) * 0.08838834764831845f, rk = rsqrtf(sk + EPS);
        const unsigned qw = cvtpk(o[0][0] * rq, o[0][1] * rq), kw = cvtpk(o[1][0] * rk, o[1][1] * rk), vw = cvtpk(o[2][0], o[2][1]);
        const size_t oo = row * 1024 + h * 128 + 2 * lane;
        *(unsigned*)(qn + row * 1024 + h * 128 + perm32k(2 * lane)) = qw; *(unsigned*)(kn + oo) = kw;
        const unsigned io = off_b(i, lane >> 2) + (lane & 3) * 4;
        *(unsigned*)(Kimg + io) = kw; *(unsigned*)(Qimg + io) = qw; *(unsigned*)(Vimg + io) = vw;
    }
    { const float bb = sigmoid_f(sb1); const float aa = sa1 + dtb; const float gi = Ah * (aa > 20.f ? aa : log1pf(__expf(aa)));
      if (lane < 8) { gt[8 * w + lane] = gi; bt[8 * w + lane] = bb; } }
    lds_barrier();
    { const float g = wave_scan(gt[lane]);
      gct[lane] = g;
      if (w == 0) { const float g63 = __builtin_bit_cast(float, __builtin_amdgcn_readlane(__builtin_bit_cast(int, g), 63)); gcb[(row0 + lane) * 8 + h] = __expf(g); ((float*)(ws + WS_BETA))[(row0 + lane) * 8 + h] = __expf(g63 - g); } }
    NsaLane L; dn_lane_init(L, lane, w);
#define DN_GTILE(which, tI_) do { const int mb = ((tI_) >> 2) & 3, nb = (tI_) & 3; f32x4 acc = (f32x4){0.f, 0.f, 0.f, 0.f}; \
        if (mb >= nb) { const unsigned char* Aimg = (which) ? Qimg : Kimg; \
            _Pragma("unroll") for (int ks = 0; ks < 4; ++ks) { const bf16x8 a = *(const bf16x8*)(Aimg + L.kaddr[ks] + mb * 4096), bq = *(const bf16x8*)(Kimg + L.kaddr[ks] + nb * 4096); acc = __builtin_amdgcn_mfma_f32_16x16x32_bf16(a, bq, acc, 0, 0, 0); } } \
        const int j = 16 * nb + L.r16; const float gj = gct[j]; \
        _Pragma("unroll") for (int r = 0; r < 4; ++r) { const int i = 16 * mb + 4 * L.gq + r; const float dec = __expf(gct[i] - gj); \
            if ((which) == 0) { const float lv = (i > j) ? bt[i] * dec * acc[r] : 0.f; \
                *(bf16_t*)(Loff + off_b(i, j >> 3) + (j & 7) * 2) = (bf16_t)f2bf(mb > nb ? lv : 0.f); \
                if (mb == nb) Ld[mb * 256 + (4 * L.gq + r) * 16 + L.r16] = lv; } \
            else qkb[(size_t)unit * 4096 + i * 64 + perm32k(j)] = (bf16_t)f2bf((i >= j) ? dec * acc[r] : 0.f); } } while (0)
    DN_GTILE(0, 2 * w); DN_GTILE(0, 2 * w + 1);
    lds_barrier();
    if (w > 0) { for (int tI = w - 1; tI < 16; tI += 7) DN_GTILE(1, tI); }
    if (w == 0) { const int blk = lane >> 4, c = lane & 15; const float* Lb = Ld + blk * 256; asm volatile("" : "+v"(Lb));
        float Tc[16];
#pragma unroll
        for (int i = 0; i < 16; ++i) { float a = (i == c) ? 1.0f : 0.f;
#pragma unroll
            for (int j4 = 0; j4 < (i + 3) / 4; ++j4) { const f32x4 l4 = *(const f32x4*)(Lb + i * 16 + 4 * j4);
#pragma unroll
                for (int jj = 0; jj < 4; ++jj) if (4 * j4 + jj < i) a -= l4[jj] * Tc[4 * j4 + jj]; }
            Tc[i] = a; *(bf16_t*)(Timg + blk * 512 + i * 32 + c * 2) = (bf16_t)f2bf(a); }
    }
#undef DN_GTILE
    lds_barrier();
    {
        const bool isw = w >= 4; const unsigned char* Simg = isw ? Kimg : Vimg; bf16_t* dstb = (isw ? wb : ub) + row0 * 1024 + h * 128;
        const unsigned q4 = (unsigned)L.r16 >> 2, p = L.r16 & 3u, Xv = (q4 << 2) | (unsigned)L.gq;
        int ub_[2];
#pragma unroll
        for (int cbi = 0; cbi < 2; ++cbi) { const int cb = 2 * (w & 3) + cbi; ub_[cbi] = 256 * (4 * L.gq + (int)q4) + 16 * (int)(((unsigned)(2 * cb) + (p >> 1)) ^ Xv) + 8 * (int)(p & 1u); }
        f32x4 X[2][4];
#pragma unroll
        for (int cbi = 0; cbi < 2; ++cbi)
#pragma unroll
            for (int bb = 0; bb < 4; ++bb) X[cbi][bb] = (f32x4){0.f, 0.f, 0.f, 0.f};
#pragma unroll
        for (int bb = 0; bb < 4; ++bb) {
            const f32x4 bt4 = *(const f32x4*)(bt + 16 * bb + 4 * L.gq), gc4 = *(const f32x4*)(gct + 16 * bb + 4 * L.gq);
            const u32x2 tl = *(const u32x2*)(Timg + bb * 512 + L.r16 * 32 + L.gq * 8);
            const u32x4 ta = {tl.x, tl.y, 0u, 0u};
            f32x4 Y[2];
#pragma unroll
            for (int cbi = 0; cbi < 2; ++cbi) {
                const s16x4 tv = __builtin_amdgcn_ds_read_tr16_b64_v4i16((LAS s16x4*)(Simg + ub_[cbi] + bb * 4096));
#pragma unroll
                for (int r = 0; r < 4; ++r) Y[cbi][r] = bf2f((unsigned short)tv[r]) * bt4[r] * (isw ? __expf(gc4[r]) : 1.0f);
            }
            if (bb > 0) {
#pragma unroll
                for (int cbi = 0; cbi < 2; ++cbi) { f32x4 upd = (f32x4){0.f, 0.f, 0.f, 0.f};
#pragma unroll
                    for (int ks = 0; ks < 2; ++ks) if (2 * ks < bb) { u32x4 xv; xv.x = cvtpk(X[cbi][2 * ks][0], X[cbi][2 * ks][1]); xv.y = cvtpk(X[cbi][2 * ks][2], X[cbi][2 * ks][3]); xv.z = cvtpk(X[cbi][2 * ks + 1][0], X[cbi][2 * ks + 1][1]); xv.w = cvtpk(X[cbi][2 * ks + 1][2], X[cbi][2 * ks + 1][3]);
                        upd = __builtin_amdgcn_mfma_f32_16x16x32_bf16(afrag8(Loff, L, bb, ks), __builtin_bit_cast(bf16x8, xv), upd, 0, 0, 0); }
                    Y[cbi] = Y[cbi] - upd; }
            }
#pragma unroll
            for (int cbi = 0; cbi < 2; ++cbi) { const int cb = 2 * (w & 3) + cbi;
                const u32x4 yb = {cvtpk(Y[cbi][0], Y[cbi][1]), cvtpk(Y[cbi][2], Y[cbi][3]), 0u, 0u};
                X[cbi][bb] = __builtin_amdgcn_mfma_f32_16x16x32_bf16(__builtin_bit_cast(bf16x8, ta), __builtin_bit_cast(bf16x8, yb), (f32x4){0.f, 0.f, 0.f, 0.f}, 0, 0, 0);
#pragma unroll
                for (int r = 0; r < 4; ++r) dstb[(size_t)(16 * bb + 4 * L.gq + r) * 1024 + (isw ? perm32k(16 * cb + L.r16) : 16 * cb + L.r16)] = (bf16_t)f2bf(X[cbi][bb][r]); }
        }
    }
    lds_barrier();
}
constexpr int DQ_K = 0, DQ_Q = 16384, DQ_V = 32768, DQ_R = 49152, DQ_LD = DQ_R + 16384, DQ_T = DQ_R + 20480, DQ_TAB = DQ_R + 22528, DQ_HALF = 73728;
__device__ __forceinline__ void dn_prep_pair(const Params& P, Frame& F_, int c, int k) { Frame F = reframe(F_);
    unsigned char* ws = P.ws; const bf16_t* proj = (const bf16_t*)(ws + WS_R1); const float* small = (const float*)(ws + WS_SMALL);
    bf16_t* qn = (bf16_t*)(ws + WS_QN); bf16_t* kn = (bf16_t*)(ws + WS_KN); bf16_t* ub = (bf16_t*)(ws + WS_VN); bf16_t* wb = (bf16_t*)(ws + WS_WN); bf16_t* qkb = (bf16_t*)(ws + WS_QK); float* gcb = (float*)(ws + WS_GDEC);
    const int tid = F.tid, lane = F.lane, w = F.wave, hf = w >> 2, hw = w & 3, htid = tid & 255;
    unsigned char* lds = F.lds + hf * DQ_HALF; unsigned char* Kimg = lds + DQ_K; unsigned char* Qimg = lds + DQ_Q; unsigned char* Vimg = lds + DQ_V; unsigned char* Loff = lds + DQ_R; float* Ld = (float*)(lds + DQ_LD); unsigned char* Timg = lds + DQ_T;
    float* gt = (float*)(lds + DQ_TAB); float* bt = gt + 64; float* gct = gt + 128; unsigned char* raw = lds + DQ_R;
    const int chain = hf * 8 + k, b = hf, h = k, unit = chain * 256 + c, t0 = c * 64; const size_t row0 = (size_t)b * SEQ + t0;
    u32x4 rv[3][5];
#pragma unroll
    for (int s = 0; s < 3; ++s)
#pragma unroll
        for (int kk = 0; kk < 5; ++kk) { const int i = htid + 256 * kk, ic = i < 67 * 16 ? i : 67 * 16 - 1; const int rr = ic >> 4, c16 = ic & 15; const int tr = (t0 + rr - 3) >= 0 ? rr - 3 : -t0;
            rv[s][kk] = *(const u32x4*)(proj + (row0 + tr) * NPROJ + s * 1024 + h * 128 + c16 * 8); }
    float cw[3][4][2];
#pragma unroll
    for (int s = 0; s < 3; ++s)
#pragma unroll
        for (int i = 0; i < 4; ++i) { const float2 c2 = *(const float2*)(P.conv_w + i * 3072 + s * 1024 + h * 128 + 2 * lane); cw[s][i][0] = c2.x; cw[s][i][1] = c2.y; }
    const float Ah = -__expf(P.a_log[h]), dtb = P.dt_bias[h];
    const size_t grow = row0 + 16 * hw + (lane & 15); const float sb1 = small[grow * 64 + h], sa1 = small[grow * 64 + 8 + h];
#pragma unroll
    for (int s = 0; s < 3; ++s) {
#pragma unroll
        for (int kk = 0; kk < 5; ++kk) { const int i = htid + 256 * kk; if (i < 67 * 16) { const bool ok = (t0 + (i >> 4) - 3) >= 0; *(u32x4*)(raw + 16 * i) = ok ? rv[s][kk] : (u32x4){0u, 0u, 0u, 0u}; } }
        lds_barrier();
        unsigned char* img = s == 0 ? Qimg : (s == 1 ? Kimg : Vimg);
        float o0[16], o1[16], sm[16];
#pragma unroll
        for (int ii = 0; ii < 16; ++ii) { const int i = 16 * hw + ii;
            float a0 = 0.f, a1 = 0.f;
#pragma unroll
            for (int j = 0; j < 4; ++j) { const unsigned wv = *(const unsigned*)(raw + (i + j) * 256 + 4 * lane); a0 += cw[s][j][0] * bflo(wv); a1 += cw[s][j][1] * bfhi(wv); }
            o0[ii] = silu_f(a0); o1[ii] = silu_f(a1); sm[ii] = o0[ii] * o0[ii] + o1[ii] * o1[ii]; }
        if (s < 2) {
#pragma unroll
            for (int ii = 0; ii < 16; ++ii) sm[ii] = wave_sum(sm[ii]); }
#pragma unroll
        for (int ii = 0; ii < 16; ++ii) { const int i = 16 * hw + ii; const size_t row = row0 + i;
            unsigned pk;
            if (s < 2) { const float r = __builtin_amdgcn_rsqf(sm[ii] + EPS) * (s == 0 ? 0.08838834764831845f : 1.0f); pk = cvtpk(o0[ii] * r, o1[ii] * r);
                if (s == 0) *(unsigned*)(qn + row * 1024 + h * 128 + perm32k(2 * lane)) = pk; else *(unsigned*)(kn + row * 1024 + h * 128 + 2 * lane) = pk; }
            else pk = cvtpk(o0[ii], o1[ii]);
            *(unsigned*)(img + off_b(i, lane >> 2) + (lane & 3) * 4) = pk;
        }
        if (s == 2) { const float bb = sigmoid_f(sb1); const float aa = sa1 + dtb; const float gi = Ah * (aa > 20.f ? aa : log1pf(__expf(aa)));
            if (lane < 16) { gt[16 * hw + lane] = gi; bt[16 * hw + lane] = bb; } }
        lds_barrier();
    }
    { const float g = wave_scan(gt[lane]);
      gct[lane] = g;
      if (hw == 0) { const float g63 = __builtin_bit_cast(float, __builtin_amdgcn_readlane(__builtin_bit_cast(int, g), 63)); gcb[(row0 + lane) * 8 + h] = __expf(g); ((float*)(ws + WS_BETA))[(row0 + lane) * 8 + h] = __expf(g63 - g); } }
    NsaLane L; dn_lane_init(L, lane, hw);
#define DN_GTILE(which, tI_) do { const int mb = ((tI_) >> 2) & 3, nb = (tI_) & 3; f32x4 acc = (f32x4){0.f, 0.f, 0.f, 0.f}; \
        const f32x4 gi4 = *(const f32x4*)(gct + 16 * mb + 4 * L.gq), bi4 = *(const f32x4*)(bt + 16 * mb + 4 * L.gq); const int j = 16 * nb + L.r16; const float gj = gct[j];        \
        if (mb >= nb) { const unsigned char* Aimg = (which) ? Qimg : Kimg; \
            _Pragma("unroll") for (int ks = 0; ks < 4; ++ks) { const bf16x8 a = *(const bf16x8*)(Aimg + L.kaddr[ks] + mb * 4096), bq = *(const bf16x8*)(Kimg + L.kaddr[ks] + nb * 4096); acc = __builtin_amdgcn_mfma_f32_16x16x32_bf16(a, bq, acc, 0, 0, 0); } } \
        _Pragma("unroll") for (int r = 0; r < 4; ++r) { const int i = 16 * mb + 4 * L.gq + r; const float dec = __expf(gi4[r] - gj); \
            if ((which) == 0) { const float lv = (i > j) ? bi4[r] * dec * acc[r] : 0.f; \
                *(bf16_t*)(Loff + off_b(i, j >> 3) + (j & 7) * 2) = (bf16_t)f2bf(mb > nb ? lv : 0.f); \
                if (mb == nb) Ld[mb * 256 + (4 * L.gq + r) * 16 + L.r16] = lv; } \
            else qkb[(size_t)unit * 4096 + i * 64 + perm32k(j)] = (bf16_t)f2bf((i >= j) ? dec * acc[r] : 0.f); } } while (0)
    for (int q = 0; q < 4; ++q) DN_GTILE(0, 4 * hw + q);
    lds_barrier();
    if (hw > 0) { for (int tI = hw - 1; tI < 16; tI += 3) DN_GTILE(1, tI); }
    if (hw == 0) { int blk = lane >> 4; const int cc = lane & 15; asm volatile("" : "+v"(blk));
        const LAS float* Lb = (const LAS float*)(LAS unsigned char*)Ld + blk * 256;
        float Tc[16];
        f32x4 Lr[16][4];
#pragma unroll
        for (int i = 1; i < 16; ++i)
#pragma unroll
            for (int j4 = 0; j4 < (i + 3) / 4; ++j4) Lr[i][j4] = *(const LAS f32x4*)(Lb + i * 16 + 4 * j4);
#pragma unroll
        for (int i = 0; i < 16; ++i) { float a = (i == cc) ? 1.0f : 0.f;
#pragma unroll
            for (int j4 = 0; j4 < (i + 3) / 4; ++j4) { const f32x4 l4 = Lr[i][j4];
#pragma unroll
                for (int jj = 0; jj < 4; ++jj) if (4 * j4 + jj < i) a -= l4[jj] * Tc[4 * j4 + jj]; }
            Tc[i] = a; *(bf16_t*)(Timg + blk * 512 + i * 32 + cc * 2) = (bf16_t)f2bf(a); }
    }
#undef DN_GTILE
    lds_barrier();
    {
        const bool isw = hw >= 2; const unsigned char* Simg = isw ? Kimg : Vimg; bf16_t* dstb = (isw ? wb : ub) + row0 * 1024 + h * 128;
        const unsigned q4 = (unsigned)L.r16 >> 2, p = L.r16 & 3u, Xv = (q4 << 2) | (unsigned)L.gq;
        int ub_[4];
#pragma unroll
        for (int cbi = 0; cbi < 4; ++cbi) { const int cb = 4 * (hw & 1) + cbi; ub_[cbi] = 256 * (4 * L.gq + (int)q4) + 16 * (int)(((unsigned)(2 * cb) + (p >> 1)) ^ Xv) + 8 * (int)(p & 1u); }
        f32x4 X[4][4];
#pragma unroll
        for (int cbi = 0; cbi < 4; ++cbi)
#pragma unroll
            for (int bb = 0; bb < 4; ++bb) X[cbi][bb] = (f32x4){0.f, 0.f, 0.f, 0.f};
#pragma unroll
        for (int bb = 0; bb < 4; ++bb) {
            const f32x4 bt4 = *(const f32x4*)(bt + 16 * bb + 4 * L.gq), gc4 = *(const f32x4*)(gct + 16 * bb + 4 * L.gq);
            const u32x2 tl = *(const u32x2*)(Timg + bb * 512 + L.r16 * 32 + L.gq * 8);
            const u32x4 ta = {tl.x, tl.y, 0u, 0u};
            f32x4 Y[4];
#pragma unroll
            for (int cbi = 0; cbi < 4; ++cbi) {
                const s16x4 tv = __builtin_amdgcn_ds_read_tr16_b64_v4i16((LAS s16x4*)(Simg + ub_[cbi] + bb * 4096));
#pragma unroll
                for (int r = 0; r < 4; ++r) Y[cbi][r] = bf2f((unsigned short)tv[r]) * bt4[r] * (isw ? __expf(gc4[r]) : 1.0f);
            }
            if (bb > 0) {
#pragma unroll
                for (int cbi = 0; cbi < 4; ++cbi) { f32x4 upd = (f32x4){0.f, 0.f, 0.f, 0.f};
#pragma unroll
                    for (int ks = 0; ks < 2; ++ks) if (2 * ks < bb) { u32x4 xv; xv.x = cvtpk(X[cbi][2 * ks][0], X[cbi][2 * ks][1]); xv.y = cvtpk(X[cbi][2 * ks][2], X[cbi][2 * ks][3]); xv.z = cvtpk(X[cbi][2 * ks + 1][0], X[cbi][2 * ks + 1][1]); xv.w = cvtpk(X[cbi][2 * ks + 1][2], X[cbi][2 * ks + 1][3]);
                        upd = __builtin_amdgcn_mfma_f32_16x16x32_bf16(afrag8(Loff, L, bb, ks), __builtin_bit_cast(bf16x8, xv), upd, 0, 0, 0); }
                    Y[cbi] = Y[cbi] - upd; }
            }
#pragma unroll
            for (int cbi = 0; cbi < 4; ++cbi) { const int cb = 4 * (hw & 1) + cbi;
                const u32x4 yb = {cvtpk(Y[cbi][0], Y[cbi][1]), cvtpk(Y[cbi][2], Y[cbi][3]), 0u, 0u};
                X[cbi][bb] = __builtin_amdgcn_mfma_f32_16x16x32_bf16(__builtin_bit_cast(bf16x8, ta), __builtin_bit_cast(bf16x8, yb), (f32x4){0.f, 0.f, 0.f, 0.f}, 0, 0, 0);
                { const unsigned p01 = cvtpk(X[cbi][bb][0], X[cbi][bb][1]), p23 = cvtpk(X[cbi][bb][2], X[cbi][bb][3]);
                  bf16_t* d0 = dstb + (size_t)(16 * bb + 4 * L.gq) * 1024 + (isw ? perm32k(16 * cb + L.r16) : 16 * cb + L.r16);
                  d0[0] = (bf16_t)p01; d0[1024] = (bf16_t)(p01 >> 16); d0[2048] = (bf16_t)p23; d0[3072] = (bf16_t)(p23 >> 16); } }
        }
    }
    lds_barrier();
}
__device__ __forceinline__ void small_gemm_chunk(const Params& P, Frame& F_, int c) { Frame F = reframe(F_);
    unsigned char* ws = P.ws; const bf16_t* xb = (const bf16_t*)(ws + WS_R0); const bf16_t* bt = (const bf16_t*)(ws + WS_BTIN) + (size_t)6656 * DM; float* small = (float*)(ws + WS_SMALL);
    unsigned char* lds = F.lds;
    const int tid = F.tid, lane = F.lane, w = F.wave, r16 = lane & 15, gq = lane >> 4; const size_t row0 = (size_t)(w >> 2) * SEQ + 64 * c + 16 * (w & 3);
    const bf16_t* xr = xb + (row0 + r16) * DM + 8 * gq;
    f32x4 acc[3];
#pragma unroll
    for (int nb = 0; nb < 3; ++nb) acc[nb] = (f32x4){0.f, 0.f, 0.f, 0.f};
    for (int kq = 0; kq < 4; ++kq) {
        u32x4 wv[6]; bf16x8 a[16];
#pragma unroll
        for (int i = 0; i < 6; ++i) { const int ci = tid + 512 * i, rr = ci >> 6, cc = ci & 63; wv[i] = *(const u32x4*)(bt + (size_t)rr * DM + kq * 512 + cc * 8); }
#pragma unroll
        for (int k = 0; k < 16; ++k) a[k] = *(const bf16x8*)(xr + 32 * (kq * 16 + k));
        __syncthreads();
#pragma unroll
        for (int i = 0; i < 6; ++i) { const int ci = tid + 512 * i, rr = ci >> 6, cc = ci & 63; *(u32x4*)(lds + rr * 1040 + cc * 16) = wv[i]; }
        __syncthreads();
#pragma unroll
        for (int k = 0; k < 16; ++k)
#pragma unroll
            for (int nb = 0; nb < 3; ++nb) { const bf16x8 bq = *(const bf16x8*)(lds + (16 * nb + r16) * 1040 + (4 * k + gq) * 16); acc[nb] = __builtin_amdgcn_mfma_f32_16x16x32_bf16(a[k], bq, acc[nb], 0, 0, 0); }
    }
#pragma unroll
    for (int nb = 0; nb < 3; ++nb)
#pragma unroll
        for (int r = 0; r < 4; ++r) small[(row0 + 4 * gq + r) * 64 + 16 * nb + r16] = acc[nb][r];
}
constexpr int DS_W = 0, DS_K = 16384, DS_U = 32768, DS_Q = 49152, DS_QK = 65536, DS_Z = 81920, DS_TAB = 98304;
constexpr int NSEG = 16, CPS = 16;
__device__ __forceinline__ void dn_passA_unit(const Params& P, Frame& F_, int unit) { Frame F = reframe(F_);
    unsigned char* ws = P.ws; const bf16_t* kn = (const bf16_t*)(ws + WS_KN); const bf16_t* ub = (const bf16_t*)(ws + WS_VN); const bf16_t* wb = (const bf16_t*)(ws + WS_WN); const float* gcb = (const float*)(ws + WS_GDEC); float* mn = (float*)(ws + WS_MN);
    unsigned char* lds = F.lds; float* gct = (float*)(lds + DS_TAB);
    const int tid = F.tid, lane = F.lane, w = F.wave; const int part = unit & 1, cs = unit >> 1, chain = cs / 15, seg = cs % 15, b = chain >> 3, h = chain & 7;
    NsaLane L; dn_lane_init(L, lane, w);
    f32x4 S[8], dummy[4];
#pragma unroll
    for (int c = 0; c < 8; ++c)
#pragma unroll
        for (int r = 0; r < 4; ++r) S[c][r] = (part && c == w && 4 * L.gq + r == L.r16) ? 1.0f : 0.f;
    T2 rW, rK, rU; float rg = 0.f; const float* ekb = (const float*)(ws + WS_BETA);
    { const size_t row0 = (size_t)b * SEQ + (size_t)(seg * CPS) * 64; const size_t go = row0 * 1024 + h * 128;
      t2_load(rW, wb + go, 1024, tid); t2_load(rK, kn + go, 1024, tid); if (!part) t2_load(rU, ub + go, 1024, tid); if (tid < 128) rg = (tid < 64 ? ekb : gcb)[(row0 + (tid & 63)) * 8 + h]; }
    for (int cc = 0; cc < CPS; ++cc) {
        lds_barrier();
        t2_store(rW, lds + DS_W, tid); t2_store(rK, lds + DS_K, tid); if (!part) t2_store(rU, lds + DS_U, tid); if (tid < 128) gct[64 + tid] = rg;
        if (cc + 1 < CPS) { const size_t row0 = (size_t)b * SEQ + (size_t)(seg * CPS + cc + 1) * 64; const size_t go = row0 * 1024 + h * 128;
            t2_load(rW, wb + go, 1024, tid); t2_load(rK, kn + go, 1024, tid); if (!part) t2_load(rU, ub + go, 1024, tid); if (tid < 128) rg = (tid < 64 ? ekb : gcb)[(row0 + (tid & 63)) * 8 + h]; }
        lds_barrier();
        if (!part) dn_step<true, false>(lds + DS_W, lds + DS_K, lds + DS_U, lds + DS_Q, lds + DS_QK, gct, L, S, dummy);
        else dn_step<false, false>(lds + DS_W, lds + DS_K, lds + DS_U, lds + DS_Q, lds + DS_QK, gct, L, S, dummy);
    }
    float* no = mn + ((size_t)(chain * NSEG + seg) * 2 + part) * 16384;
#pragma unroll
    for (int c = 0; c < 8; ++c)
#pragma unroll
        for (int r = 0; r < 4; ++r) no[(16 * c + 4 * L.gq + r) * 128 + 16 * w + L.r16] = S[c][r];
}
__device__ __forceinline__ void dn_passB_unit(const Params& P, Frame& F_, int chain) { Frame F = reframe(F_);
    unsigned char* ws = P.ws; const float* mn = (const float*)(ws + WS_MN); float* sst = (float*)(ws + WS_SST);
    unsigned char* lds = F.lds; const int tid = F.tid, lane = F.lane, w = F.wave;
    NsaLane L; dn_lane_init(L, lane, w);
    f32x4 S[8];
#pragma unroll
    for (int c = 0; c < 8; ++c) S[c] = (f32x4){0.f, 0.f, 0.f, 0.f};
    for (int seg = 0; seg < NSEG - 1; ++seg) {
        const float* nB = mn + ((size_t)(chain * NSEG + seg) * 2 + 0) * 16384; const float* nA = nB + 16384;
        lds_barrier();
#pragma unroll
        for (int k = 0; k < 4; ++k) { const int idx = tid + 512 * k, row = idx >> 4, ch = idx & 15; const f32x4 a = *(const f32x4*)(nA + row * 128 + ch * 8), bq = *(const f32x4*)(nA + row * 128 + ch * 8 + 4);
            u32x4 v; v.x = cvtpk(a[0], a[1]); v.y = cvtpk(a[2], a[3]); v.z = cvtpk(bq[0], bq[1]); v.w = cvtpk(bq[2], bq[3]); *(u32x4*)(lds + off_b(row, ch)) = v; }
        lds_barrier();
        bf16x8 sf[4];
#pragma unroll
        for (int k = 0; k < 4; ++k) { u32x4 v; v.x = cvtpk(S[2 * k][0], S[2 * k][1]); v.y = cvtpk(S[2 * k][2], S[2 * k][3]); v.z = cvtpk(S[2 * k + 1][0], S[2 * k + 1][1]); v.w = cvtpk(S[2 * k + 1][2], S[2 * k + 1][3]); sf[k] = __builtin_bit_cast(bf16x8, v); }
        float* so = sst + ((size_t)chain * NSEG + seg + 1) * 16384;
        f32x4 nv[8];
#pragma unroll
        for (int mb = 0; mb < 8; ++mb)
#pragma unroll
            for (int r = 0; r < 4; ++r) nv[mb][r] = nB[(16 * mb + 4 * L.gq + r) * 128 + 16 * w + L.r16];
#pragma unroll
        for (int mb = 0; mb < 8; ++mb) { f32x4 acc = nv[mb];
#pragma unroll
            for (int ks = 0; ks < 4; ++ks) acc = __builtin_amdgcn_mfma_f32_16x16x32_bf16(afrag8(lds, L, mb, ks), sf[ks], acc, 0, 0, 0);
            S[mb] = acc;
#pragma unroll
            for (int r = 0; r < 4; ++r) so[(16 * mb + 4 * L.gq + r) * 128 + 16 * w + L.r16] = acc[r]; }
    }
}
__device__ __forceinline__ void dn_passC_unit(const Params& P, Frame& F_, int unit) { Frame F = reframe(F_);
    unsigned char* ws = P.ws; const bf16_t* proj = (const bf16_t*)(ws + WS_R1); const bf16_t* qn = (const bf16_t*)(ws + WS_QN); const bf16_t* kn = (const bf16_t*)(ws + WS_KN); const bf16_t* ub = (const bf16_t*)(ws + WS_VN); const bf16_t* wb = (const bf16_t*)(ws + WS_WN);
    const bf16_t* qkb = (const bf16_t*)(ws + WS_QK); const float* gcb = (const float*)(ws + WS_GDEC); const float* sst = (const float*)(ws + WS_SST); bf16_t* ymix = (bf16_t*)(ws + WS_R0);
    unsigned char* lds = F.lds; float* gct = (float*)(lds + DS_TAB); float* part = gct + 256; float* rnt = part + 512;
    const int tid = F.tid, lane = F.lane, w = F.wave; const int chain = unit >> 4, seg = unit & 15, b = chain >> 3, h = chain & 7;
    NsaLane L; dn_lane_init(L, lane, w);
    f32x4 S[8], o[4];
    { const float* si = sst + ((size_t)chain * NSEG + seg) * 16384;
#pragma unroll
      for (int c = 0; c < 8; ++c)
#pragma unroll
          for (int r = 0; r < 4; ++r) { const float sv = si[(16 * c + 4 * L.gq + r) * 128 + 16 * w + L.r16]; S[c][r] = seg ? sv : 0.f; } }
    const float gnorm = P.dn_norm_g[16 * w + L.r16];
    T2 rW, rK, rU, rQ, rZ; u32x4 rQK; float rg = 0.f; const float* ekb = (const float*)(ws + WS_BETA);
#define DN_C_LOAD(chunk_) do { const size_t row0_ = (size_t)b * SEQ + (size_t)(chunk_) * 64; const size_t go_ = row0_ * 1024 + h * 128; \
        t2_load(rW, wb + go_, 1024, tid); t2_load(rK, kn + go_, 1024, tid); t2_load(rU, ub + go_, 1024, tid); t2_load(rQ, qn + go_, 1024, tid); \
        t2_load(rZ, proj + row0_ * NPROJ + C_Z + h * 128, NPROJ, tid); \
        rQK = *(const u32x4*)(qkb + (size_t)(chain * 256 + (chunk_)) * 4096 + (tid >> 3) * 64 + (tid & 7) * 8); \
        if (tid < 128) rg = (tid < 64 ? ekb : gcb)[(row0_ + (tid & 63)) * 8 + h]; } while (0)
    DN_C_LOAD(seg * CPS);
    for (int cc = 0; cc < CPS; ++cc) {
        const int chunk = seg * CPS + cc; const size_t row0 = (size_t)b * SEQ + (size_t)chunk * 64;
        lds_barrier();
        t2_store(rW, lds + DS_W, tid); t2_store(rK, lds + DS_K, tid); t2_store(rU, lds + DS_U, tid); t2_store(rQ, lds + DS_Q, tid); t2_store(rZ, lds + DS_Z, tid);
        *(u32x4*)(lds + DS_QK + off_b(tid >> 3, tid & 7)) = rQK; if (tid < 128) gct[64 + tid] = rg;
        if (cc + 1 < CPS) DN_C_LOAD(chunk + 1);
        lds_barrier();
        dn_step<true, true>(lds + DS_W, lds + DS_K, lds + DS_U, lds + DS_Q, lds + DS_QK, gct, L, S, o);
        float rs_[4][4];
#pragma unroll
        for (int mb = 0; mb < 4; ++mb)
#pragma unroll
            for (int r = 0; r < 4; ++r) rs_[mb][r] = row16_sum(o[mb][r] * o[mb][r]);
#pragma unroll
        for (int mb = 0; mb < 4; ++mb)
#pragma unroll
            for (int r = 0; r < 4; ++r) { if (L.r16 == 0) part[(16 * mb + 4 * L.gq + r) * 8 + w] = rs_[mb][r]; }
        lds_barrier();
        if (tid < 64) { float s = 0.f;
#pragma unroll
            for (int k = 0; k < 8; ++k) s += part[tid * 8 + k];
            rnt[tid] = rsqrtf(s * (1.0f / 128.f) + EPS); }
        lds_barrier();
#pragma unroll
        for (int mb = 0; mb < 4; ++mb) { const f32x4 rn4 = *(const f32x4*)(rnt + 16 * mb + 4 * L.gq); const f32x4 z4 = tr_c4(lds + DS_Z, L, mb);
#pragma unroll
            for (int r = 0; r < 4; ++r) ymix[(row0 + 16 * mb + 4 * L.gq + r) * DM + h * 128 + 16 * w + L.r16] = (bf16_t)f2bf(o[mb][r] * rn4[r] * gnorm * silu_f(z4[r])); }
    }
}

__device__ __forceinline__ void router_phase(const Params& P, Frame& F_) { Frame F = reframe(F_);
    unsigned char* ws = P.ws; const bf16_t* x1b = (const bf16_t*)(ws + WS_X1B); const bf16_t* whi = (const bf16_t*)(ws + WS_WR); const bf16_t* wlo = (const bf16_t*)(ws + WS_WR + 512 * 1024);
    float* rstd2 = (float*)(ws + WS_RSTD2); int* lists = (int*)(ws + WS_LISTS); float* gatew = (float*)(ws + WS_GATEW); unsigned* cnt = (unsigned*)(ws + WS_CTL) + CW_CNT;
    float* lg = (float*)(F.lds + 86016 + F.wave * (16 * 80 * 4));
    unsigned char* lds = F.lds; const int tid = F.tid;
    const int lane = F.lane, r16 = lane & 15, gq = lane >> 4;
    for (int tb = F.bid; tb < T / 128; tb += F.G) {
        const int task = tb * 8 + F.wave;
        const int row = task * 16 + r16; const bf16_t* xr = x1b + (size_t)row * DM + 8 * gq;
        f32x4 acc[5];
#pragma unroll
        for (int nb = 0; nb < 5; ++nb) acc[nb] = (f32x4){0.f, 0.f, 0.f, 0.f};
        float ssq = 0.f;
        for (int e8 = 0; e8 < 8; ++e8) {
            u32x4 wv[10], xa[8];
#pragma unroll
            for (int i = 0; i < 10; ++i) { const int ci = tid + 512 * i, rr = ci >> 5, cc = ci & 31; wv[i] = *(const u32x4*)((rr < 80 ? whi + (size_t)rr * DM : wlo + (size_t)(rr - 80) * DM) + e8 * 256 + cc * 8); }
#pragma unroll
            for (int k = 0; k < 8; ++k) xa[k] = *(const u32x4*)(xr + 32 * (e8 * 8 + k));
            __syncthreads();
#pragma unroll
            for (int i = 0; i < 10; ++i) { const int ci = tid + 512 * i, rr = ci >> 5, cc = ci & 31; *(u32x4*)(lds + rr * 528 + cc * 16) = wv[i]; }
            __syncthreads();
#pragma unroll
            for (int k = 0; k < 8; ++k) { const u32x4 xw = xa[k];
                { const float a0 = bflo(xw.x), a1 = bfhi(xw.x), a2 = bflo(xw.y), a3 = bfhi(xw.y), a4 = bflo(xw.z), a5 = bfhi(xw.z), a6 = bflo(xw.w), a7 = bfhi(xw.w);
                  ssq += (a0 * a0 + a1 * a1) + (a2 * a2 + a3 * a3) + (a4 * a4 + a5 * a5) + (a6 * a6 + a7 * a7); }
                const bf16x8 xh = __builtin_bit_cast(bf16x8, xw);
#pragma unroll
                for (int nb = 0; nb < 5; ++nb) { const bf16x8 bh = *(const bf16x8*)(lds + (16 * nb + r16) * 528 + (4 * k + gq) * 16), bl = *(const bf16x8*)(lds + (80 + 16 * nb + r16) * 528 + (4 * k + gq) * 16);
                    acc[nb] = __builtin_amdgcn_mfma_f32_16x16x32_bf16(bh, xh, acc[nb], 0, 0, 0);
                    acc[nb] = __builtin_amdgcn_mfma_f32_16x16x32_bf16(bl, xh, acc[nb], 0, 0, 0); } }
        }
        ssq = red_gq_sum(ssq); const float rs = rsqrtf(ssq * (1.0f / DM) + EPS);
#pragma unroll
        for (int nb = 0; nb < 5; ++nb)
#pragma unroll
            for (int r = 0; r < 4; ++r) lg[r16 * 80 + 16 * nb + 4 * gq + r] = acc[nb][r] * rs;
        __builtin_amdgcn_s_waitcnt(0xc07f); asm volatile("" ::: "memory");
        if (lane < 16) {
            const float* L = lg + lane * 80; const int tok = task * 16 + lane;
            float mx = L[0]; for (int j = 1; j < 8; ++j) mx = fmaxf(mx, L[j]);
            float se = 0.f; for (int j = 0; j < 8; ++j) se += __expf(L[j] - mx);
            int gs = 0; float bv = L[0] + P.b_group[0]; for (int j = 1; j < 8; ++j) { const float v = L[j] + P.b_group[j]; if (v > bv) { bv = v; gs = j; } }
            const float pg = __expf(L[gs] - mx) / se;
            const float* el = L + 8 + 8 * gs; const float* br = P.b_router + 8 * gs;
            int i1 = 0; float s1 = el[0] + br[0]; for (int j = 1; j < 8; ++j) { const float v = el[j] + br[j]; if (v > s1) { s1 = v; i1 = j; } }
            int i2 = -1; float s2 = -INFINITY; for (int j = 0; j < 8; ++j) { if (j == i1) continue; const float v = el[j] + br[j]; if (v > s2) { s2 = v; i2 = j; } }
            const float e1 = el[i1], e2 = el[i2], em = fmaxf(e1, e2), x1e = __expf(e1 - em), x2e = __expf(e2 - em), inv = 1.0f / (x1e + x2e);
            const int ex1 = gs * 8 + i1, ex2 = gs * 8 + i2;
            const unsigned p1 = atomicAdd(cnt + ex1, 1u), p2 = atomicAdd(cnt + ex2, 1u);
            lists[(size_t)ex1 * T + p1] = tok * 2; lists[(size_t)ex2 * T + p2] = tok * 2 + 1;
            gatew[tok * 2] = pg * x1e * inv; gatew[tok * 2 + 1] = pg * x2e * inv; rstd2[tok] = rs;
        }
        __builtin_amdgcn_s_waitcnt(0xc07f); asm volatile("" ::: "memory");
    }
}
__device__ __forceinline__ void convert_phase(const Params& P, Frame& F_) { Frame F = reframe(F_);
    unsigned char* ws = P.ws;
    float* scr = (float*)(F.lds + F.wave * 8448);
    bf16_t* btgu = (bf16_t*)(ws + WS_BTGU); bf16_t* btd = (bf16_t*)(ws + WS_BTD); const float* gf = P.norm_ffn_g;
    constexpr int I_GU = 64 * 2 * 32 * 16, I_D = 64 * 8 * 64, NI = I_GU + I_D, NB_ = 2;
#define CONV_LOAD(vq, dq, lq, it_) do { const int it = (it_); dq = nullptr; lq = 0; \
        if (it < I_GU) { const int nb = it & 15, kb = (it >> 4) & 31, which = (it >> 9) & 1, e = it >> 10; const int k0 = kb * 64, f0 = nb * 32; \
            const float* w = (which ? P.w_up : P.w_gate) + (size_t)e * DM * DEXP; \
            tr_load([&](int kk, int nn) { return *(const f32x4*)(w + (size_t)(k0 + kk) * DEXP + f0 + nn) * gf[k0 + kk]; }, vq, F.lane); \
            dq = btgu + ((size_t)e * 1024 + 256 * (f0 >> 7) + which * 128 + (f0 & 127)) * DM + k0; lq = DM; \
        } else if (it < NI) { const int r = it - I_GU, nb = r & 63, kb = (r >> 6) & 7, e = r >> 9; const int k0 = kb * 64, n0 = nb * 32; const float* w = P.w_down + (size_t)e * DEXP * DM; \
            tr_load([&](int kk, int nn) { return *(const f32x4*)(w + (size_t)(k0 + kk) * DM + n0 + nn); }, vq, F.lane); \
            dq = btd + ((size_t)e * DM + n0) * DEXP + k0; lq = DEXP; } } while (0)
    f32x4 va[NB_][8], vb[NB_][8]; bf16_t* da[NB_]; bf16_t* db[NB_]; size_t la[NB_], lb[NB_];
#pragma unroll
    for (int q = 0; q < NB_; ++q) CONV_LOAD(va[q], da[q], la[q], F.gw + q * F.NGW);
    for (int it0 = F.gw; it0 < NI; it0 += 2 * NB_ * F.NGW) {
#pragma unroll
        for (int q = 0; q < NB_; ++q) CONV_LOAD(vb[q], db[q], lb[q], it0 + (NB_ + q) * F.NGW);
#pragma unroll
        for (int q = 0; q < NB_; ++q) if (da[q]) tr_store(va[q], da[q], la[q], scr, F.lane);
#pragma unroll
        for (int q = 0; q < NB_; ++q) CONV_LOAD(va[q], da[q], la[q], it0 + (2 * NB_ + q) * F.NGW);
#pragma unroll
        for (int q = 0; q < NB_; ++q) if (db[q]) tr_store(vb[q], db[q], lb[q], scr, F.lane);
    }
#undef CONV_LOAD
}
__device__ __forceinline__ void moe_tables(const Params& P, Frame& F_) { Frame F = reframe(F_);
    LAS int* tab = (LAS int*)((LAS unsigned char*)F.lds + LDS_TAB); const unsigned* cnt = (const unsigned*)(P.ws + WS_CTL) + CW_CNT;
    if (F.tid < 64) { const int c = (int)cnt[F.tid]; const int ntl = (c + 255) >> 8; int incl = ntl;
#pragma unroll
        for (int o = 1; o < 64; o <<= 1) { const int t = __shfl_up(incl, o); if (F.lane >= o) incl += t; }
        tab[F.tid] = incl - ntl; tab[65 + F.tid] = c; if (F.tid == 63) tab[64] = incl; }
    __syncthreads();
}
__device__ __forceinline__ void final_phase(const Params& P, Frame& F_) { Frame F = reframe(F_);
    const bf16_t* ymoe = (const bf16_t*)(P.ws + WS_YMOE); float* out = P.out; const int lane = F.lane;
    const bf16_t* x1b = (const bf16_t*)(P.ws + WS_X1B);
    for (int m = F.gw; m < T; m += F.NGW) { f32x4* xr = (f32x4*)(out + (size_t)m * DM) + lane; const u32x2* x0 = (const u32x2*)(x1b + (size_t)m * DM) + lane; const u32x2* y0 = (const u32x2*)(ymoe + (size_t)(2 * m) * DM) + lane; const u32x2* y1 = (const u32x2*)(ymoe + (size_t)(2 * m + 1) * DM) + lane;
        f32x4 v[8]; float s = 0.f;
#pragma unroll
        for (int j = 0; j < 8; ++j) { const u32x2 xx = x0[64 * j], a = y0[64 * j], b = y1[64 * j];
            v[j][0] = bflo(xx.x) + (bflo(a.x) + bflo(b.x)); v[j][1] = bfhi(xx.x) + (bfhi(a.x) + bfhi(b.x)); v[j][2] = bflo(xx.y) + (bflo(a.y) + bflo(b.y)); v[j][3] = bfhi(xx.y) + (bfhi(a.y) + bfhi(b.y));
            s += (v[j][0] * v[j][0] + v[j][1] * v[j][1]) + (v[j][2] * v[j][2] + v[j][3] * v[j][3]); }
        s = wave_sum(s); const float rn = rsqrtf(s * (1.0f / DM) + EPS);
#pragma unroll
        for (int j = 0; j < 8; ++j) { const f32x4 gg = ((const f32x4*)P.norm_final_g)[lane + 64 * j]; xr[64 * j] = v[j] * rn * gg; } }
}

constexpr int LDS_MISC = LDS_TAB + 1024;
constexpr int LDS_BYTES = LDS_TAB + 2048;
constexpr int NPHASE = 11;
__global__ void __launch_bounds__(512, 2) fwd(Params P) {
    extern __shared__ __attribute__((aligned(16))) unsigned char lds[];
    Frame F; F.lds = lds; F.tid = threadIdx.x; F.lane = F.tid & 63; F.wave = __builtin_amdgcn_readfirstlane(F.tid >> 6); F.G = gridDim.x; F.bid = blockIdx.x; F.gw = F.bid * 8 + F.wave; F.NGW = F.G * 8;
    LAS unsigned char* ldsl = (LAS unsigned char*)lds;
    unsigned char* ws = P.ws;
    if (F.tid < 4) ((LAS unsigned*)(ldsl + LDS_MISC))[F.tid] = 0u;
    __syncthreads();
    const int lo = P.ph_lo, hi = P.ph_hi;
    const bool multi = (hi - lo) > 1;
    XcdBarrier bar; bar.bar = (unsigned*)(ws + WS_CTL) + CW_BAR; bar.x = 0; bar.st = nullptr;
    if (multi) bar = xcd_barrier_post((unsigned*)(ws + WS_CTL) + CW_BAR, (volatile LAS unsigned*)(ldsl + LDS_MISC));
#ifndef REPEAT_MASK
#define REPEAT_MASK 0
#endif
#define REP(k) for (int rep_ = 0; rep_ < (((REPEAT_MASK) >> (k)) & 1) + 1; ++rep_)
#define IN(k) (lo <= (k) && (k) < hi)
#define SEAM(k) do { if (IN(k) && IN((k) + 1)) xcd_barrier(bar); } while (0)
    if (IN(0)) REP(0) { p0_prologue(P, F); }
    SEAM(0);
    if (IN(1)) REP(1) {
        pg8::DenseOrder S; S.init(ws + WS_R0, ws + WS_BTIN, T, NPROJ, DM, DM, F.G, F.bid);
        EpiProj E{(bf16_t*)(ws + WS_R1), (bf16_t*)(ws + WS_CMPBUF), (float*)(ws + WS_SMALL), (const float*)(ws + WS_RSTD1)};
        pg8::gemm_phase<EpiProj, pg8::DenseOrder>(ldsl, DM, DM, DM, S, E);
    }
    SEAM(1);
    if (IN(2)) REP(2) {
        for (int c = F.bid; c < 256; c += F.G) {
            small_gemm_chunk(P, F, c);
            asm volatile("s_waitcnt vmcnt(0)" ::: "memory"); __syncthreads();
            { const int dly = (int)(F.bid & 3u);
              for (int q = 0; q < dly; ++q) __builtin_amdgcn_s_sleep(127); }
            for (int k = 0; k < 8; ++k) dn_prep_pair(P, F, c, k);
        }
        __syncthreads();
        CmpOrder S{(const char*)(ws + WS_CMPBUF), (const char*)(ws + WS_W1T), F.G, F.bid};
        EpiCmp1 E{(float*)(ws + WS_HIDS)};
        pg8::gemm_phase<EpiCmp1, CmpOrder>(ldsl, 1024, 2048, 4096, S, E);
    }
    SEAM(2);
    if (IN(3)) REP(3) { cmp2_phase(P, F); for (int u = F.bid; u < 480; u += F.G) dn_passA_unit(P, F, u); }
    SEAM(3);
    if (IN(4)) REP(4) {
        if (F.bid < 16) { dn_passB_unit(P, F, F.bid);
            asm volatile("s_waitcnt vmcnt(0)" ::: "memory"); __syncthreads();
            if (F.tid == 0) { __builtin_amdgcn_fence(__ATOMIC_RELEASE, "agent"); asm volatile("s_waitcnt vmcnt(0)" ::: "memory"); (void)xb_add((unsigned*)(ws + WS_CTL) + CW_PBDONE, 1u); } }
        __syncthreads();
        { unsigned* qctr = (unsigned*)(ws + WS_CTL) + CW_NSAQ + 64 * rep_; LAS unsigned* qs = (LAS unsigned*)(ldsl + LDS_MISC + 16);
          for (;;) {
              __syncthreads();
              if (F.tid == 0) *qs = atomicAdd(qctr, 1u);
              __syncthreads();
              const unsigned q = *qs; if (q >= 1024u) break;
              nsa_unit(P, F, (int)(((q & 3u) << 8) | (255u - (q >> 2))));
          } }
        if (IN(5)) {
            if (F.tid == 0) { unsigned* pb = (unsigned*)(ws + WS_CTL) + CW_PBDONE; XB_SPIN(xb_ld(pb) < 16u, bar.bar); __builtin_amdgcn_fence(__ATOMIC_ACQUIRE, "agent"); asm volatile("s_waitcnt vmcnt(0)" ::: "memory"); }
            __syncthreads();
            for (int u = F.bid; u < 256; u += F.G) dn_passC_unit(P, F, u);
        }
    }
    if (!(IN(4) && IN(5))) SEAM(4);
    if (IN(5) && !IN(4)) REP(5) { for (int u = F.bid; u < 256; u += F.G) dn_passC_unit(P, F, u); }
    SEAM(5);
    if (IN(6)) REP(6) {
        const int NG = (F.G == 256) ? 171 : F.G;
        if (F.bid >= NG || NG == F.G) { Frame Fc = F; if (NG < F.G) { Fc.bid = F.bid - NG; Fc.G = F.G - NG; Fc.NGW = Fc.G * 8; } convert_phase(P, Fc); }
        if (F.bid < NG) {
        pg8::DenseOrder S; S.init(ws + WS_R0, ws + WS_BTOUT, T, DM, DM, DM, NG, F.bid);
        EpiOut E{P.x, P.out, (bf16_t*)(ws + WS_X1B)};
        pg8::gemm_phase<EpiOut, pg8::DenseOrder>(ldsl, DM, DM, DM, S, E);
        }
    }
    SEAM(6);
    if (IN(7)) { router_phase(P, F); }
    SEAM(7);
    if (IN(8)) REP(8) {
        moe_tables(P, F);
        MoeOrderT<true> S{(const LAS int*)(ldsl + LDS_TAB), (const LAS int*)(ldsl + LDS_TAB + 65 * 4), (const int*)(ws + WS_LISTS), (const char*)(ws + WS_X1B), (const char*)(ws + WS_BTGU), (size_t)1024 * DM * 2, (size_t)256 * DM * 2, 4, F.G, F.bid, (unsigned)(DM * 2)};
        EpiGU E{(bf16_t*)(ws + WS_R0), (const int*)(ws + WS_LISTS), (const float*)(ws + WS_RSTD2)};
        pg8::gemm_phase<EpiGU, MoeOrderT<true>>(ldsl, DM, DM, DM, S, E);
    }
    SEAM(8);
    if (IN(9)) REP(9) {
        moe_tables(P, F);
        MoeOrderT<false> S{(const LAS int*)(ldsl + LDS_TAB), (const LAS int*)(ldsl + LDS_TAB + 65 * 4), (const int*)(ws + WS_LISTS), (const char*)(ws + WS_R0), (const char*)(ws + WS_BTD), (size_t)DM * DEXP * 2, (size_t)256 * DEXP * 2, 8, F.G, F.bid, (unsigned)(DEXP * 2)};
        EpiDown E{(bf16_t*)(ws + WS_YMOE), (const int*)(ws + WS_LISTS), (const float*)(ws + WS_GATEW)};
        pg8::gemm_phase<EpiDown, MoeOrderT<false>>(ldsl, DEXP, DEXP, DEXP, S, E);
    }
    SEAM(9);
    if (IN(10)) REP(10) { final_phase(P, F); }
#undef IN
#undef SEAM
}

extern "C" void kernel_launch(void* const* d_in, const int* in_sizes, int n_in, void* d_out, int out_size, void* d_ws, size_t ws_size, hipStream_t stream) {
    static int grid = 0;
    if (grid == 0) {
        if (n_in != 24 || in_sizes[0] != T * DM || out_size != T * DM || ws_size < WS_END) { fprintf(stderr, "kernel_launch: unexpected shapes (n_in %d, ws %zu)\n", n_in, ws_size); grid = -1; return; }
        int dev = 0, cus = 0;
        if (hipGetDevice(&dev) != hipSuccess || hipDeviceGetAttribute(&cus, hipDeviceAttributeMultiprocessorCount, dev) != hipSuccess) { grid = -1; return; }
        if (hipFuncSetAttribute((const void*)fwd, hipFuncAttributeMaxDynamicSharedMemorySize, LDS_BYTES) != hipSuccess) { fprintf(stderr, "kernel_launch: hipFuncSetAttribute failed\n"); grid = -1; return; }
        int per_cu = 0;
        if (hipOccupancyMaxActiveBlocksPerMultiprocessor(&per_cu, (const void*)fwd, 512, LDS_BYTES) != hipSuccess || per_cu < 1) fprintf(stderr, "kernel_launch: occupancy query says %d\n", per_cu);
        (void)hipGetLastError();
        grid = cus;
    }
    if (grid < 0) return;
    (void)hipMemsetAsync((char*)d_ws + WS_CTL, 0, CTL_BYTES, stream);
    Params p{};
    const float** pp = (const float**)&p;
    for (int i = 0; i < 24; ++i) pp[i] = (const float*)d_in[i];
    p.out = (float*)d_out; p.ws = (unsigned char*)d_ws;
#define ONE_LAUNCH 1
#ifndef ONE_LAUNCH
    for (int ph = 0; ph < NPHASE; ++ph) { p.ph_lo = ph; p.ph_hi = ph + 1; hipLaunchKernelGGL(fwd, dim3(grid), dim3(512), LDS_BYTES, stream, p); }
#else
    p.ph_lo = 0; p.ph_hi = NPHASE; hipLaunchKernelGGL(fwd, dim3(grid), dim3(512), LDS_BYTES, stream, p);
#endif
}
```

```cpp
#include <hip/hip_runtime.h>
#include <cstdio>
#include <cstdint>

#define LAS __attribute__((address_space(3)))
typedef unsigned short bf16_t;
typedef short bf16x8 __attribute__((ext_vector_type(8)));
typedef short s16x4 __attribute__((ext_vector_type(4)));
typedef float f32x4 __attribute__((ext_vector_type(4)));
typedef float f32x2 __attribute__((ext_vector_type(2)));
typedef unsigned u32x4 __attribute__((ext_vector_type(4)));
typedef unsigned u32x2 __attribute__((ext_vector_type(2)));

constexpr int NB = 2, SEQ = 16384, T = NB * SEQ, DM = 2048;
constexpr int NPROJ = 6656;
constexpr int C_Q = 0, C_K = 1024, C_V = 2048, C_Z = 3072, C_NQ = 4096, C_KCMP = 5120, C_VCMP = 5376, C_KSEL = 5632, C_VSEL = 5888, C_KWIN = 6144, C_VWIN = 6400, C_SMALL = 6656;
constexpr int NEXP = 64, DEXP = 512;
constexpr float EPS = 1e-6f;
constexpr float LOG2E = 1.4426950408889634f;

constexpr size_t MiB = 1u << 20;
constexpr size_t WS_CTL = 0, CTL_BYTES = 1 * MiB;
constexpr size_t WS_BTIN = 1 * MiB, WS_BTOUT = 28 * MiB, WS_W1T = 36 * MiB, WS_WR = 40 * MiB, WS_CMPBUF = 41 * MiB, WS_HIDC = 74 * MiB, WS_KC = 78 * MiB;
constexpr size_t WS_SMALL = 80 * MiB, WS_RSTD1 = 88 * MiB, WS_RSTD2 = 88 * MiB + 131072, WS_BETA = 89 * MiB, WS_GDEC = 90 * MiB;
constexpr size_t WS_R0 = 100 * MiB, WS_R1 = 228 * MiB, WS_R2 = 660 * MiB, WS_WN = 852 * MiB, WS_QK = 916 * MiB, WS_MN = 948 * MiB, WS_SST = 980 * MiB, WS_HIDS = 996 * MiB, WS_END = 1012 * MiB;
constexpr size_t WS_BTGU = WS_R1, WS_BTD = WS_R1 + 256 * MiB, WS_YMOE = WS_R1;
constexpr size_t WS_QN = WS_R2, WS_KN = WS_R2 + 64 * MiB, WS_VN = WS_R2 + 128 * MiB;
constexpr size_t WS_X1B = WS_R2, WS_LISTS = WS_R2 + 128 * MiB, WS_GATEW = WS_R2 + 136 * MiB;
constexpr int CW_BAR = 4096, CW_CNT = 8192, CW_BIAS = 8448, CW_NSAQ = 8704, CW_PBDONE = 9216;

__device__ __forceinline__ unsigned f2bf(float f) { unsigned u = __builtin_bit_cast(unsigned, f); return (u + 0x7fffu + ((u >> 16) & 1u)) >> 16; }
__device__ __forceinline__ unsigned pk2(float lo, float hi) { return f2bf(lo) | (f2bf(hi) << 16); }
typedef __bf16 bf16x2_t __attribute__((ext_vector_type(2)));
__device__ __forceinline__ unsigned cvtpk(float lo, float hi) { const f32x2 v = {lo, hi}; const bf16x2_t r = __builtin_convertvector(v, bf16x2_t); return __builtin_bit_cast(unsigned, r); }
__device__ __forceinline__ float ex2(float x) { return __builtin_amdgcn_exp2f(x); }
__device__ __forceinline__ float bf2f(unsigned b) { return __builtin_bit_cast(float, b << 16); }
__device__ __forceinline__ float bflo(unsigned w) { return __builtin_bit_cast(float, w << 16); }
__device__ __forceinline__ float bfhi(unsigned w) { return __builtin_bit_cast(float, w & 0xffff0000u); }
template <int CTRL> __device__ __forceinline__ float dpp_f(float v) { return __builtin_bit_cast(float, __builtin_amdgcn_update_dpp(0, __builtin_bit_cast(int, v), CTRL, 0xF, 0xF, true)); }
__device__ __forceinline__ float row16_sum(float v) { v += dpp_f<0xB1>(v); v += dpp_f<0x4E>(v); v += dpp_f<0x141>(v); v += dpp_f<0x140>(v); return v; }
__device__ __forceinline__ float quad_sum(float v) { v += dpp_f<0xB1>(v); v += dpp_f<0x4E>(v); return v; }
template <int CTRL, int RM> __device__ __forceinline__ float dpp_rm(float v) { return __builtin_bit_cast(float, __builtin_amdgcn_update_dpp(0, __builtin_bit_cast(int, v), CTRL, RM, 0xF, false)); }
__device__ __forceinline__ float wave_sum(float v) { v = row16_sum(v); v += dpp_rm<0x142, 0xA>(v); v += dpp_rm<0x143, 0xC>(v); return __builtin_bit_cast(float, __builtin_amdgcn_readlane(__builtin_bit_cast(int, v), 63)); }
__device__ __forceinline__ float wave_scan(float v) { v += dpp_f<0x111>(v); v += dpp_f<0x112>(v); v += dpp_f<0x114>(v); v += dpp_f<0x118>(v); v += dpp_rm<0x142, 0xA>(v); v += dpp_rm<0x143, 0xC>(v); return v; }
__device__ __forceinline__ void lds_barrier() { asm volatile("s_waitcnt lgkmcnt(0)" ::: "memory"); __builtin_amdgcn_s_barrier(); asm volatile("" ::: "memory"); }
__device__ __forceinline__ float silu_f(float x) { return x * __builtin_amdgcn_rcpf(1.0f + __expf(-x)); }
__device__ __forceinline__ float sigmoid_f(float x) { return __builtin_amdgcn_rcpf(1.0f + __expf(-x)); }

#define XB_TMO      128
#define XB_XCNT(j)  (256  + 64 * (j))
#define XB_XSUB(j)  (1280 + 64 * (j))
#define XB_XGEN(j)  (2304 + 64 * (j))
#define XB_TOP      3328
#define XB_TOPGEN   3392
#define XCD_BAR_WORDS 3456
#define XB_SPIN_CAP (1u << 24)
__device__ __forceinline__ unsigned xb_ld(unsigned* p)              { return __hip_atomic_load(p, __ATOMIC_RELAXED, __HIP_MEMORY_SCOPE_AGENT); }
__device__ __forceinline__ unsigned xb_add(unsigned* p, unsigned v) { return __hip_atomic_fetch_add(p, v, __ATOMIC_RELAXED, __HIP_MEMORY_SCOPE_AGENT); }
__device__ __forceinline__ unsigned xb_xcc_id() { return (unsigned)__builtin_amdgcn_s_getreg((3 << 11) | 20) & 0xFu; }
#define XB_SPIN(cond, bar) do { unsigned _sp = 0; while (cond) { __builtin_amdgcn_s_sleep(1); \
    if ((++_sp & 255u) == 0u) { if (xb_ld(&(bar)[XB_TMO])) break; if (_sp > XB_SPIN_CAP) { atomicAdd(&(bar)[XB_TMO], 1u); break; } } } } while (0)
struct XcdBarrier { unsigned* bar; unsigned x; volatile LAS unsigned* st; };
__device__ __forceinline__ XcdBarrier xcd_barrier_post(unsigned* bar, volatile LAS unsigned* st) {
    XcdBarrier b; b.bar = bar; b.x = xb_xcc_id(); b.st = st;
    if (threadIdx.x == 0) (void)xb_add(&bar[XB_XCNT(b.x)], 1u);
    return b;
}
__device__ __forceinline__ void xcd_barrier_complete(unsigned* bar, unsigned x, unsigned& nloc, unsigned& nx) {
    const unsigned G = gridDim.x * gridDim.y * gridDim.z;
    unsigned sum, cnt, mine, sp = 0u;
    for (;;) {
        sum = 0u; cnt = 0u; mine = 0u;
#pragma unroll
        for (unsigned j = 0; j < 16; ++j) { const unsigned c = xb_ld(&bar[XB_XCNT(j)]); sum += c; cnt += (c > 0u) ? 1u : 0u; mine = (j == x) ? c : mine; }
        if (sum == G) break;
        __builtin_amdgcn_s_sleep(1);
        if ((++sp & 255u) == 0u) { if (xb_ld(&bar[XB_TMO])) break; if (sp > XB_SPIN_CAP) { atomicAdd(&bar[XB_TMO], 1u); break; } }
    }
    nloc = mine > 0u ? mine : 1u; nx = cnt > 0u ? cnt : 1u;
}
__device__ __forceinline__ void xcd_barrier(const XcdBarrier& b) {
    asm volatile("s_waitcnt vmcnt(0)" ::: "memory");
    __syncthreads();
    if (threadIdx.x == 0) {
        unsigned* bar = b.bar;
        __builtin_amdgcn_s_waitcnt(0);
        unsigned nloc = b.st[0], nx = b.st[1];
        if (nloc == 0u) { xcd_barrier_complete(bar, b.x, nloc, nx); b.st[0] = nloc; b.st[1] = nx; }
        const unsigned old = xb_add(&bar[XB_XSUB(b.x)], 1u);
        const unsigned gen = old / nloc;
        if (old + 1u == (gen + 1u) * nloc) {
            __builtin_amdgcn_fence(__ATOMIC_RELEASE, "agent");
            asm volatile("s_waitcnt vmcnt(0)" ::: "memory");
            const unsigned og = xb_add(&bar[XB_TOP], 1u);
            const unsigned tg = og / nx;
            if (og + 1u == (tg + 1u) * nx) xb_add(&bar[XB_TOPGEN], 1u);
            else XB_SPIN(xb_ld(&bar[XB_TOPGEN]) == tg, bar);
            __builtin_amdgcn_fence(__ATOMIC_ACQUIRE, "agent");
            xb_add(&bar[XB_XGEN(b.x)], 1u);
            asm volatile("s_waitcnt vmcnt(0)" ::: "memory");
        } else {
            XB_SPIN(xb_ld(&bar[XB_XGEN(b.x)]) == gen, bar);
            __builtin_amdgcn_fence(__ATOMIC_ACQUIRE, "agent");
            asm volatile("s_waitcnt vmcnt(0)" ::: "memory");
        }
    }
    __syncthreads();
}

struct Params {
    const float *x, *norm_mix_g, *w_in, *conv_w, *dt_bias, *a_log, *dn_norm_g;
    const float *cmp_pos_k, *cmp_w1_k, *cmp_w2_k, *cmp_pos_v, *cmp_w1_v, *cmp_w2_v, *nsa_norm_g;
    const float *w_out, *norm_ffn_g, *w_group, *b_group, *w_router, *b_router;
    const float *w_gate, *w_up, *w_down, *norm_final_g;
    float* out; unsigned char* ws; int ph_lo, ph_hi;
};

namespace pg8 {
constexpr int BM = 256, BK = 64, HALF = 128, HTB = HALF * BK * 2, STAGE_BYTES = 8 * HTB;
__device__ __forceinline__ int lds_byte(int r, int c) { const int st = (r >> 4) * 2 + (c >> 5), rr = r & 15, cc = c & 31, ob = rr * 64 + cc * 2; return st * 1024 + (ob ^ (((ob >> 9) & 1) << 5)); }
__device__ __forceinline__ void stage_rc(int b, int& R, int& C) { const int st = b / 1024, sb = b % 1024, swz = sb ^ (((sb >> 9) & 1) << 5); R = (st >> 1) * 16 + swz / 64; C = (st & 1) * 32 + (swz % 64) / 2; }
__device__ __forceinline__ int perm32(int rho) { const int n = rho >> 4, i = rho & 15; return 8 * (i >> 2) + 4 * n + (i & 3); }
struct Unit { int pm, pn; const char* a; const char* b; int x0, x1, x2, x3; };
__device__ __forceinline__ unsigned cvt_pk_bf16(float lo, float hi) { unsigned r; asm volatile("v_cvt_pk_bf16_f32 %0, %1, %2" : "=v"(r) : "v"(lo), "v"(hi)); return r; }

template <class Epi, class Sched>
__device__ __forceinline__ void gemm_phase(LAS unsigned char* lds, const int K, const int lda, const int ldb, const Sched& S, const Epi& E) {
    int tid = threadIdx.x; asm volatile("" : "+v"(tid));
    const int wid = __builtin_amdgcn_readfirstlane(tid >> 6), lane = tid & 63, wr = wid >> 2, wc = wid & 3, fr = lane & 15, fq = lane >> 4;
    const int nt = K / BK;
    unsigned voffA[2], voffB[2];
    unsigned gofA[2][2], ngofA[2][2];
#pragma unroll
    for (int i = 0; i < 2; ++i) { int R, C; stage_rc(tid * 16 + i * 8192, R, C); const int Rb = Epi::PERM ? ((R & ~31) + perm32(R & 31)) : R;
        voffA[i] = (unsigned)(R * lda + C) * 2u; voffB[i] = (unsigned)(Rb * ldb + C) * 2u; }
    const size_t kstep = (size_t)(BK * 2);
    const size_t hstepA = Sched::GATHER ? 0 : (size_t)HALF * lda * 2, hstepB = (size_t)HALF * ldb * 2;
    const unsigned ldsw = (unsigned)wid * 1024u;
    const int aoff = lds_byte(wr * 64 + fr, fq * 8), boff = lds_byte(wc * 32 + fr, fq * 8);
#define PG8_SA(b, h) (((b) * 2 + (h)) * HTB)
#define PG8_SB(b, h) ((4 + (b) * 2 + (h)) * HTB)
#define PG8_STAGE(bufoff, gbase, voff) do { _Pragma("unroll") for (int _i = 0; _i < 2; ++_i) \
        __builtin_amdgcn_global_load_lds((const unsigned*)((const char*)(gbase) + (voff)[_i]), (LAS unsigned*)(lds + (bufoff) + ldsw + _i * 8192), 16, 0, 0); } while (0)
#define PG8_STAGE_A(bufoff, gbase, h, nx) do { if constexpr (Sched::GATHER) { if (nx) PG8_STAGE(bufoff, gbase, ngofA[h]); else PG8_STAGE(bufoff, gbase, gofA[h]); } else PG8_STAGE(bufoff, (gbase) + (h) * hstepA, voffA); } while (0)
#define PG8_LDA(dst, b, h) do { _Pragma("unroll") for (int m = 0; m < 4; ++m) _Pragma("unroll") for (int k = 0; k < 2; ++k) dst[m][k] = *(const LAS bf16x8*)(lds + PG8_SA(b, h) + aoff + m * 2048 + k * 1024); } while (0)
#define PG8_LDB(dst, b, h) do { _Pragma("unroll") for (int n = 0; n < 2; ++n) _Pragma("unroll") for (int k = 0; k < 2; ++k) dst[n][k] = *(const LAS bf16x8*)(lds + PG8_SB(b, h) + boff + n * 2048 + k * 1024); } while (0)
#define PG8_MMA(ai, bj, At, Bt) do { __builtin_amdgcn_s_setprio(1); _Pragma("unroll") for (int m = 0; m < 4; ++m) _Pragma("unroll") for (int n = 0; n < 2; ++n) _Pragma("unroll") for (int k = 0; k < 2; ++k) \
        acc[ai][bj][m][n] = __builtin_amdgcn_mfma_f32_16x16x32_bf16(Bt[n][k], At[m][k], acc[ai][bj][m][n], 0, 0, 0); __builtin_amdgcn_s_setprio(0); } while (0)
#define PG8_WAIT_V(n) asm volatile("s_waitcnt vmcnt(" #n ")" ::: "memory")
#define PG8_WAIT_L(n) asm volatile("s_waitcnt lgkmcnt(" #n ")" ::: "memory")
#define PG8_BAR __builtin_amdgcn_s_barrier()
#define PG8_SCHED __builtin_amdgcn_sched_barrier(0)
    Unit cur, nxt; int ui = 0;
    if (!S.next(0, cur)) return;
    if constexpr (Sched::GATHER) {
#pragma unroll
        for (int i = 0; i < 2; ++i) { int R, C; stage_rc(tid * 16 + i * 8192, R, C);
#pragma unroll
            for (int h = 0; h < 2; ++h) { gofA[h][i] = S.row_off(cur, h * HALF + R) + (unsigned)C * 2u; ngofA[h][i] = gofA[h][i]; } }
    }
    f32x4 acc[2][2][4][2];
#pragma unroll
    for (int a = 0; a < 2; ++a)
#pragma unroll
        for (int b = 0; b < 2; ++b)
#pragma unroll
            for (int m = 0; m < 4; ++m)
#pragma unroll
                for (int n = 0; n < 2; ++n) acc[a][b][m][n] = (f32x4){0.f, 0.f, 0.f, 0.f};
    bf16x8 At[4][2], B0[2][2], B1[2][2];
    const char* cA = cur.a; const char* cB = cur.b;
    PG8_STAGE(PG8_SB(0, 0), cB, voffB); PG8_STAGE_A(PG8_SA(0, 0), cA, 0, false); PG8_STAGE(PG8_SB(0, 1), cB + hstepB, voffB); PG8_STAGE_A(PG8_SA(0, 1), cA, 1, false);
    if (wr == 1) PG8_BAR;
    PG8_WAIT_V(4); PG8_BAR;
    PG8_STAGE(PG8_SB(1, 0), cB + kstep, voffB); PG8_STAGE_A(PG8_SA(1, 0), cA + kstep, 0, false); PG8_STAGE(PG8_SB(1, 1), cB + hstepB + kstep, voffB);
    PG8_WAIT_V(6); PG8_BAR;
    for (;;) {
        const bool has_next = S.next(ui + 1, nxt);
        const char* nA = has_next ? nxt.a : cA; const char* nB = has_next ? nxt.b : cB;
        if constexpr (Sched::GATHER) {
            if (has_next) {
#pragma unroll
                for (int i = 0; i < 2; ++i) { int R, C; stage_rc(tid * 16 + i * 8192, R, C);
#pragma unroll
                    for (int h = 0; h < 2; ++h) ngofA[h][i] = S.row_off(nxt, h * HALF + R) + (unsigned)C * 2u; }
            }
        }
        for (int t = 0; t < nt; t += 2) {
            const bool last = (t == nt - 2);
            const char* a1 = cA + (size_t)(t + 1) * kstep;
            const char* a2 = last ? nA : cA + (size_t)(t + 2) * kstep; const char* b2 = last ? nB : cB + (size_t)(t + 2) * kstep;
            const char* a3 = a2 + kstep; const char* b3 = b2 + kstep;
            PG8_LDB(B0, 0, 0); PG8_SCHED; PG8_LDA(At, 0, 0); PG8_STAGE_A(PG8_SA(1, 1), a1, 1, false);
            PG8_WAIT_L(8); PG8_BAR; PG8_WAIT_L(0); PG8_MMA(0, 0, At, B0); PG8_BAR; PG8_SCHED;
            PG8_LDB(B1, 0, 1); PG8_STAGE(PG8_SB(0, 0), b2, voffB);
            PG8_BAR; PG8_WAIT_L(0); PG8_MMA(0, 1, At, B1); PG8_BAR;
            PG8_LDA(At, 0, 1); PG8_STAGE_A(PG8_SA(0, 0), a2, 0, last);
            PG8_BAR; PG8_WAIT_L(0); PG8_MMA(1, 0, At, B0); PG8_BAR; PG8_SCHED;
            PG8_STAGE(PG8_SB(0, 1), b2 + hstepB, voffB);
            PG8_WAIT_V(6); PG8_BAR; PG8_MMA(1, 1, At, B1); PG8_BAR;
            PG8_LDB(B0, 1, 0); PG8_SCHED; PG8_LDA(At, 1, 0); PG8_STAGE_A(PG8_SA(0, 1), a2, 1, last);
            PG8_WAIT_L(8); PG8_BAR; PG8_WAIT_L(0); PG8_MMA(0, 0, At, B0); PG8_BAR; PG8_SCHED;
            PG8_LDB(B1, 1, 1); PG8_STAGE(PG8_SB(1, 0), b3, voffB);
            PG8_BAR; PG8_WAIT_L(0); PG8_MMA(0, 1, At, B1); PG8_BAR;
            PG8_LDA(At, 1, 1); PG8_STAGE_A(PG8_SA(1, 0), a3, 0, last);
            PG8_BAR; PG8_WAIT_L(0); PG8_MMA(1, 0, At, B0); PG8_BAR; PG8_SCHED;
            PG8_STAGE(PG8_SB(1, 1), b3 + hstepB, voffB);
            PG8_WAIT_V(6); PG8_BAR; PG8_MMA(1, 1, At, B1); PG8_BAR;
        }
        E(acc, cur, wr, wc, fr, fq);
        if (!has_next) break;
#pragma unroll
        for (int a = 0; a < 2; ++a)
#pragma unroll
            for (int b = 0; b < 2; ++b)
#pragma unroll
                for (int m = 0; m < 4; ++m)
#pragma unroll
                    for (int n = 0; n < 2; ++n) acc[a][b][m][n] = (f32x4){0.f, 0.f, 0.f, 0.f};
        cur = nxt; cA = nA; cB = nB; ++ui;
        if constexpr (Sched::GATHER) {
#pragma unroll
            for (int i = 0; i < 2; ++i)
#pragma unroll
                for (int h = 0; h < 2; ++h) gofA[h][i] = ngofA[h][i];
        }
    }
    PG8_WAIT_V(0);
    if (wr == 0) PG8_BAR;
    PG8_BAR;
#undef PG8_SA
#undef PG8_SB
#undef PG8_STAGE
#undef PG8_STAGE_A
#undef PG8_LDA
#undef PG8_LDB
#undef PG8_MMA
#undef PG8_WAIT_V
#undef PG8_WAIT_L
#undef PG8_BAR
#undef PG8_SCHED
}

struct DenseOrder {
    static constexpr bool GATHER = false;
    int nM, nN, nwg, G, c; const char* A; const char* Bt; size_t tstepA, tstepB;
    __device__ void init(const void* A_, const void* Bt_, int M, int N, int lda, int ldb, int G_, int c_) { A = (const char*)A_; Bt = (const char*)Bt_; nM = M / BM; nN = N / BM; nwg = nM * nN; G = G_; c = c_; tstepA = (size_t)BM * lda * 2; tstepB = (size_t)BM * ldb * 2; }
    __device__ __forceinline__ bool next(int i, Unit& u) const {
        const long L = (long)i * G + c; if (L >= nwg) return false;
        int wgid = (int)L; { const int q = nwg / 8, r = nwg % 8, xcd = wgid % 8, off = wgid / 8; wgid = (xcd < r ? xcd * (q + 1) : r * (q + 1) + (xcd - r) * q) + off; }
        const int nig = 8 * nN, gid = wgid / nig, fm = gid * 8, gsz = (nM - fm) < 8 ? (nM - fm) : 8;
        u.pm = fm + ((wgid % nig) % gsz); u.pn = (wgid % nig) / gsz; u.a = A + (size_t)u.pm * tstepA; u.b = Bt + (size_t)u.pn * tstepB; u.x0 = u.x1 = u.x2 = u.x3 = 0; return true;
    }
    __device__ __forceinline__ unsigned row_off(const Unit&, int) const { return 0u; }
};
}

struct EpiProj {
    static constexpr bool PERM = true;
    bf16_t* proj; bf16_t* cmpbuf; float* small; const float* rstd;
    __device__ __forceinline__ void operator()(const f32x4 (&acc)[2][2][4][2], const pg8::Unit& u, int wr, int wc, int fr_, int fq_) const {
        int fr = fr_, fq = fq_; asm volatile("" : "+v"(fr), "+v"(fq));
        const int pn = u.pn;
#pragma unroll
        for (int ai = 0; ai < 2; ++ai)
#pragma unroll
            for (int m = 0; m < 4; ++m) {
                const int r = u.pm * 256 + ai * 128 + wr * 64 + m * 16 + fr; const float rs = 1.0f;
                {
#pragma unroll
                    for (int bj = 0; bj < 2; ++bj) {
                        const f32x4 v0 = acc[ai][bj][m][0] * rs, v1 = acc[ai][bj][m][1] * rs;
                        u32x4 w; w.x = cvtpk(v0[0], v0[1]); w.y = cvtpk(v0[2], v0[3]); w.z = cvtpk(v1[0], v1[1]); w.w = cvtpk(v1[2], v1[3]);
                        bf16_t* d;
                        if (pn == 20 || pn == 21) { const int b = r >> 14, s = r & 16383; d = cmpbuf + ((size_t)(((pn - 20) * 2 + b) * 2 + bj) * SEQ + s) * 128 + 32 * wc + 8 * fq; }
                        else d = proj + (size_t)r * NPROJ + pn * 256 + bj * 128 + 32 * wc + 8 * fq;
                        *(u32x4*)d = w;
                    }
                }
            }
    }
};
__device__ __forceinline__ float gelu_tanh(float x) { const float u = 0.7978845608028654f * (x + 0.044715f * x * x * x); return 0.5f * x * (1.0f + tanhf(u)); }
struct EpiCmp1 {
    static constexpr bool PERM = false;
    float* hids;
    __device__ __forceinline__ void operator()(const f32x4 (&acc)[2][2][4][2], const pg8::Unit& u, int wr, int wc, int fr_, int fq_) const {
        int fr = fr_, fq = fq_; asm volatile("" : "+v"(fr), "+v"(fq));
        const int seg = u.x0, kq = u.x1;
#pragma unroll
        for (int n = 0; n < 2; ++n) {
            const int h = 32 * wc + 16 * n + 4 * fq;
#pragma unroll
            for (int ai = 0; ai < 2; ++ai)
#pragma unroll
                for (int m = 0; m < 4; ++m) { const int nr = u.pm * 256 + ai * 128 + wr * 64 + m * 16 + fr;
                    *(f32x4*)(hids + (((size_t)kq * 8 + seg) * 1024 + nr) * 128 + h) = acc[ai][0][m][n]; }
        }
    }
};
struct CmpOrder {
    static constexpr bool GATHER = false;
    const char* cmpbuf; const char* w1t; int G, c;
    __device__ __forceinline__ bool next(int i, pg8::Unit& u) const { const int L = i * G + c; if (L >= 128) return false; const int kq = L & 3, seg = L >> 4; u.pm = (L >> 2) & 3; u.pn = 0; u.x0 = seg; u.x1 = kq; u.x2 = u.x3 = 0;
        u.a = cmpbuf + (size_t)seg * SEQ * 128 * 2 + (size_t)u.pm * 256 * 2048 * 2 + (size_t)kq * 1024 * 2; u.b = w1t + (size_t)(seg >> 2) * 256 * 4096 * 2 + (size_t)kq * 1024 * 2; return true; }
    __device__ __forceinline__ unsigned row_off(const pg8::Unit&, int) const { return 0u; }
};
struct EpiOut {
    static constexpr bool PERM = true;
    const float* x; float* x1; bf16_t* x1b;
    __device__ __forceinline__ void operator()(const f32x4 (&acc)[2][2][4][2], const pg8::Unit& u, int wr, int wc, int fr_, int fq_) const {
        int fr = fr_, fq = fq_; asm volatile("" : "+v"(fr), "+v"(fq));
#pragma unroll
        for (int ai = 0; ai < 2; ++ai)
#pragma unroll
            for (int mp = 0; mp < 2; ++mp) {
                f32x4 xv[2][2][2];
#pragma unroll
                for (int mm = 0; mm < 2; ++mm) { const size_t off = (size_t)(u.pm * 256 + ai * 128 + wr * 64 + (2 * mp + mm) * 16 + fr) * DM + u.pn * 256 + wc * 32 + 8 * fq;
#pragma unroll
                    for (int bj = 0; bj < 2; ++bj)
#pragma unroll
                        for (int n = 0; n < 2; ++n) xv[mm][bj][n] = *(const f32x4*)(x + off + bj * 128 + n * 4); }
#pragma unroll
                for (int mm = 0; mm < 2; ++mm) { const int m = 2 * mp + mm; const size_t off = (size_t)(u.pm * 256 + ai * 128 + wr * 64 + m * 16 + fr) * DM + u.pn * 256 + wc * 32 + 8 * fq;
#pragma unroll
                    for (int bj = 0; bj < 2; ++bj) { const f32x4 v0 = xv[mm][bj][0] + acc[ai][bj][m][0], v1 = xv[mm][bj][1] + acc[ai][bj][m][1];
                        u32x4 w; w.x = cvtpk(v0[0], v0[1]); w.y = cvtpk(v0[2], v0[3]); w.z = cvtpk(v1[0], v1[1]); w.w = cvtpk(v1[2], v1[3]); *(u32x4*)(x1b + off + bj * 128) = w; } }
            }
    }
};
constexpr int LDS_TAB = 155648;
struct MoeOrder {
    static constexpr bool GATHER_ = true;
    const LAS int* tpre; const LAS int* cnt; const int* lists; const char* A; const char* Bt; size_t bstride_e; size_t tstepB; int npn, G, c; unsigned rowbytes; bool gather;
};
template <bool GATH> struct MoeOrderT {
    static constexpr bool GATHER = GATH;
    const LAS int* tpre; const LAS int* cnt; const int* lists; const char* A; const char* Bt; size_t bstride_e, tstepB; int npn, G, c; unsigned rowbytes;
    __device__ __forceinline__ bool next(int i, pg8::Unit& u) const {
        const int ntile = tpre[64]; int tt;
        if (G == 256) {
            const int tpx = 32 / npn, xcd = c & 7, slot = c >> 3; tt = (i * 8 + xcd) * tpx + (slot % tpx); u.pn = slot / tpx; if (tt >= ntile) return false;
        } else { const long L = (long)i * G + c; if (L >= (long)ntile * npn) return false; tt = (int)(L / npn); u.pn = (int)(L % npn); }
        int lo = 0, hi = 64;
        while (hi - lo > 1) { const int mid = (lo + hi) >> 1; if (tpre[mid] <= tt) lo = mid; else hi = mid; }
        const int e = lo, tile = tt - tpre[e]; const int ce = cnt[e];
        u.pm = tt; u.x0 = e; u.x1 = tile; u.x2 = (ce - tile * 256) < 256 ? (ce - tile * 256) : 256; u.x3 = 0;
        u.a = GATH ? A : A + (size_t)tt * 256 * rowbytes; u.b = Bt + (size_t)e * bstride_e + (size_t)u.pn * tstepB; return true;
    }
    __device__ __forceinline__ unsigned row_off(const pg8::Unit& u, int r) const {
        const int idx = (r < u.x2) ? u.x1 * 256 + r : 0; const int a = lists[(size_t)u.x0 * T + idx]; return (unsigned)(a >> 1) * rowbytes;
    }
};
struct EpiGU {
    static constexpr bool PERM = true;
    bf16_t* hid; const int* lists; const float* rstd2;
    __device__ __forceinline__ void operator()(const f32x4 (&acc)[2][2][4][2], const pg8::Unit& u, int wr, int wc, int fr_, int fq_) const {
        int fr = fr_, fq = fq_; asm volatile("" : "+v"(fr), "+v"(fq));
        int av[8]; float rsv[8];
#pragma unroll
        for (int q = 0; q < 8; ++q) { const int rr = (q >> 2) * 128 + wr * 64 + (q & 3) * 16 + fr; const int idx = (rr < u.x2) ? u.x1 * 256 + rr : 0; av[q] = lists[(size_t)u.x0 * T + idx]; }
#pragma unroll
        for (int q = 0; q < 8; ++q) rsv[q] = rstd2[av[q] >> 1];
#pragma unroll
        for (int ai = 0; ai < 2; ++ai)
#pragma unroll
            for (int m = 0; m < 4; ++m) { const int rr = ai * 128 + wr * 64 + m * 16 + fr; const float rs = rsv[ai * 4 + m];
                f32x4 g0 = acc[ai][0][m][0] * rs, g1 = acc[ai][0][m][1] * rs, u0 = acc[ai][1][m][0] * rs, u1 = acc[ai][1][m][1] * rs;
                u32x4 w; w.x = cvtpk(silu_f(g0[0]) * u0[0], silu_f(g0[1]) * u0[1]); w.y = cvtpk(silu_f(g0[2]) * u0[2], silu_f(g0[3]) * u0[3]);
                w.z = cvtpk(silu_f(g1[0]) * u1[0], silu_f(g1[1]) * u1[1]); w.w = cvtpk(silu_f(g1[2]) * u1[2], silu_f(g1[3]) * u1[3]);
                *(u32x4*)(hid + ((size_t)u.pm * 256 + rr) * DEXP + u.pn * 128 + wc * 32 + 8 * fq) = w; }
    }
};
struct EpiDown {
    static constexpr bool PERM = true;
    bf16_t* ymoe; const int* lists; const float* gatew;
    __device__ __forceinline__ void operator()(const f32x4 (&acc)[2][2][4][2], const pg8::Unit& u, int wr, int wc, int fr_, int fq_) const {
        int fr = fr_, fq = fq_; asm volatile("" : "+v"(fr), "+v"(fq));
        int av[8]; float gwv[8];
#pragma unroll
        for (int q = 0; q < 8; ++q) { const int rr = (q >> 2) * 128 + wr * 64 + (q & 3) * 16 + fr; const int idx = (rr < u.x2) ? u.x1 * 256 + rr : 0; av[q] = lists[(size_t)u.x0 * T + idx]; }
#pragma unroll
        for (int q = 0; q < 8; ++q) gwv[q] = gatew[av[q]];
#pragma unroll
        for (int ai = 0; ai < 2; ++ai)
#pragma unroll
            for (int m = 0; m < 4; ++m) { const int rr = ai * 128 + wr * 64 + m * 16 + fr; if (rr < u.x2) { const int a = av[ai * 4 + m]; const float gw = gwv[ai * 4 + m];
#pragma unroll
                for (int bj = 0; bj < 2; ++bj) { const f32x4 v0 = acc[ai][bj][m][0] * gw, v1 = acc[ai][bj][m][1] * gw;
                    u32x4 w; w.x = cvtpk(v0[0], v0[1]); w.y = cvtpk(v0[2], v0[3]); w.z = cvtpk(v1[0], v1[1]); w.w = cvtpk(v1[2], v1[3]);
                    *(u32x4*)(ymoe + (size_t)a * DM + u.pn * 256 + bj * 128 + wc * 32 + 8 * fq) = w; } } }
    }
};

struct Frame { unsigned char* lds; int tid, lane, wave, G, bid, gw, NGW; };
__device__ __forceinline__ Frame reframe(const Frame& F_) { Frame F = F_; int t = F_.tid; asm volatile("" : "+v"(t)); F.tid = t; F.lane = t & 63; F.wave = __builtin_amdgcn_readfirstlane(t >> 6); F.gw = F.bid * 8 + F.wave; return F; }

template <class SRC>
__device__ __forceinline__ void tr_load(const SRC& src, f32x4 (&v)[8], int lane) {
#pragma unroll
    for (int i = 0; i < 4; ++i) { const int kk = 16 * i + 2 * (lane >> 3); v[2 * i] = src(kk, (lane & 7) * 4); v[2 * i + 1] = src(kk + 1, (lane & 7) * 4); }
}
__device__ __forceinline__ void tr_store(const f32x4 (&v)[8], bf16_t* dst, size_t ldd, float* scr_, int lane) {
    unsigned* scr = (unsigned*)scr_;
#pragma unroll
    for (int i = 0; i < 4; ++i) { const int kp = 8 * i + (lane >> 3); unsigned* q = scr + ((lane & 7) * 4) * 36 + kp;
        q[0] = cvtpk(v[2 * i][0], v[2 * i + 1][0]); q[36] = cvtpk(v[2 * i][1], v[2 * i + 1][1]); q[72] = cvtpk(v[2 * i][2], v[2 * i + 1][2]); q[108] = cvtpk(v[2 * i][3], v[2 * i + 1][3]); }
    __builtin_amdgcn_s_waitcnt(0xc07f); asm volatile("" ::: "memory");
    const int c = lane & 7;
#pragma unroll
    for (int j = 0; j < 4; ++j) { const int n = (lane >> 3) + 8 * j; *(u32x4*)(dst + (size_t)n * ldd + 8 * c) = *(const u32x4*)(scr + n * 36 + 4 * c); }
    __builtin_amdgcn_s_waitcnt(0xc07f); asm volatile("" ::: "memory");
}
template <class SRC>
__device__ __forceinline__ void tr_item(const SRC& src, bf16_t* dst, size_t ldd, float* scr, int lane) { f32x4 v[8]; tr_load(src, v, lane); tr_store(v, dst, ldd, scr, lane); }
__device__ __forceinline__ int colmap(int n) {
    if (n < 4096) return n;
    if (n < 6656) return n + 16;
    if (n < 6672) return n - 6656 + 4096;
    if (n < 6696) return n;
    return -1;
}
__device__ __forceinline__ void p0_prologue(const Params& P, Frame& F_) { Frame F = reframe(F_);
    float* scr = (float*)(F.lds + F.wave * 8448);
    unsigned char* ws = P.ws;
    bf16_t* btin = (bf16_t*)(ws + WS_BTIN); bf16_t* btout = (bf16_t*)(ws + WS_BTOUT); bf16_t* w1t = (bf16_t*)(ws + WS_W1T);
    constexpr int I_IN = 32 * 216, I_OUT = 32 * 64, I_W1 = 2 * 64 * 8;
    for (int it = F.gw; it < I_IN + I_OUT + I_W1; it += F.NGW) {
        int r = it;
        if (r < I_IN) { const int kb = r / 216, nb = r % 216, k0 = kb * 64, n0 = nb * 32; const float* w = P.w_in; const float* g = P.norm_mix_g;
            tr_item([&](int kk, int nn) { const int c = colmap(n0 + nn); return c < 0 ? (f32x4){0.f, 0.f, 0.f, 0.f} : *(const f32x4*)(w + (size_t)(k0 + kk) * 6696 + c) * g[k0 + kk]; }, btin + (size_t)n0 * DM + k0, DM, scr, F.lane); continue; }
        r -= I_IN;
        if (r < I_OUT) { const int kb = r / 64, nb = r % 64, k0 = kb * 64, n0 = nb * 32; const float* w = P.w_out;
            tr_item([&](int kk, int nn) { return *(const f32x4*)(w + (size_t)(k0 + kk) * DM + n0 + nn); }, btout + (size_t)n0 * DM + k0, DM, scr, F.lane); continue; }
        r -= I_OUT;
        { const int tensor = r / 512, rr = r % 512, kb = rr / 8, nb = rr % 8, k0 = kb * 64, n0 = nb * 32; const float* w = tensor ? P.cmp_w1_v : P.cmp_w1_k;
            tr_item([&](int kk, int nn) { return (n0 + nn) < 128 ? *(const f32x4*)(w + (size_t)(k0 + kk) * 128 + n0 + nn) : (f32x4){0.f, 0.f, 0.f, 0.f}; }, w1t + (size_t)tensor * 256 * 4096 + (size_t)n0 * 4096 + k0, 4096, scr, F.lane); }
    }
    float* biasp = (float*)(ws + WS_RSTD1);
    for (int it = F.NGW - 1 - F.gw; it < 128; it += F.NGW) { const int tensor = it >> 6, hh = (it >> 5) & 1, kc = it & 31; const float* w = tensor ? P.cmp_w1_v : P.cmp_w1_k; const float* pos = tensor ? P.cmp_pos_v : P.cmp_pos_k;
        float a0 = 0.f, a1 = 0.f, a2 = 0.f, a3 = 0.f; const int h = hh * 64 + F.lane;
#pragma unroll 8
        for (int k = kc * 128; k < kc * 128 + 128; k += 4) { a0 += pos[k] * w[(size_t)k * 128 + h]; a1 += pos[k + 1] * w[(size_t)(k + 1) * 128 + h]; a2 += pos[k + 2] * w[(size_t)(k + 2) * 128 + h]; a3 += pos[k + 3] * w[(size_t)(k + 3) * 128 + h]; }
        biasp[(tensor * 32 + kc) * 128 + h] = (a0 + a1) + (a2 + a3); }
    { bf16_t* whi = (bf16_t*)(ws + WS_WR); bf16_t* wlo = (bf16_t*)(ws + WS_WR + 512 * 1024);
      for (int it = F.bid * 512 + F.tid; it < 80 * 256; it += F.G * 512) { const int n = it >> 8, k0 = (it & 255) * 8; unsigned hi[8], lo[8];
          const float* wsrc = n < 8 ? P.w_group + n : P.w_router + (n < 72 ? n - 8 : 0); const int wstr = n < 8 ? 8 : 64; const bool wok = n < 72;
#pragma unroll
          for (int j = 0; j < 8; ++j) { const int k = k0 + j; float v = wsrc[(size_t)k * wstr]; v = wok ? v * P.norm_ffn_g[k] : 0.f;
              hi[j] = f2bf(v); lo[j] = f2bf(v - bf2f(hi[j])); }
          u32x4 a, b; a.x = hi[0] | (hi[1] << 16); a.y = hi[2] | (hi[3] << 16); a.z = hi[4] | (hi[5] << 16); a.w = hi[6] | (hi[7] << 16);
          b.x = lo[0] | (lo[1] << 16); b.y = lo[2] | (lo[3] << 16); b.z = lo[4] | (lo[5] << 16); b.w = lo[6] | (lo[7] << 16);
          *(u32x4*)(whi + (size_t)n * DM + k0) = a; *(u32x4*)(wlo + (size_t)n * DM + k0) = b; } }
    { bf16_t* w2t = (bf16_t*)(ws + WS_WR + 896 * 1024);
      for (int it = F.bid * 512 + F.tid; it < 2 * 128 * 128; it += F.G * 512) { const int t = it >> 14, n = (it >> 7) & 127, k = it & 127; const float* w2 = t ? P.cmp_w2_v : P.cmp_w2_k; w2t[it] = (bf16_t)f2bf(w2[k * 128 + n]); } }
    bf16_t* xb = (bf16_t*)(ws + WS_R0); float* rstd1 = (float*)(ws + WS_RSTD1);
    for (int m = F.gw; m < T; m += 2 * F.NGW) {
        const int m2 = m + F.NGW; const bool has2 = m2 < T; const int m2c = has2 ? m2 : m;
        const f32x4* xr = (const f32x4*)(P.x + (size_t)m * DM) + F.lane; const f32x4* xr2 = (const f32x4*)(P.x + (size_t)m2c * DM) + F.lane; f32x4 v[8], v2[8]; float s = 0.f, s2 = 0.f;
#pragma unroll
        for (int j = 0; j < 8; ++j) v[j] = xr[64 * j];
#pragma unroll
        for (int j = 0; j < 8; ++j) v2[j] = xr2[64 * j];
#pragma unroll
        for (int j = 0; j < 8; ++j) { s += (v[j][0] * v[j][0] + v[j][1] * v[j][1]) + (v[j][2] * v[j][2] + v[j][3] * v[j][3]); s2 += (v2[j][0] * v2[j][0] + v2[j][1] * v2[j][1]) + (v2[j][2] * v2[j][2] + v2[j][3] * v2[j][3]); }
        s = wave_sum(s); s2 = wave_sum(s2); const float rs = rsqrtf(s * (1.0f / DM) + EPS), rs2 = rsqrtf(s2 * (1.0f / DM) + EPS);
        u32x2* o = (u32x2*)(xb + (size_t)m * DM) + F.lane; u32x2* o2 = (u32x2*)(xb + (size_t)m2c * DM) + F.lane;
#pragma unroll
        for (int j = 0; j < 8; ++j) { u32x2 w; w.x = cvtpk(v[j][0] * rs, v[j][1] * rs); w.y = cvtpk(v[j][2] * rs, v[j][3] * rs); o[64 * j] = w; }
        if (has2) {
#pragma unroll
            for (int j = 0; j < 8; ++j) { u32x2 w; w.x = cvtpk(v2[j][0] * rs2, v2[j][1] * rs2); w.y = cvtpk(v2[j][2] * rs2, v2[j][3] * rs2); o2[64 * j] = w; } }
    }
    { u32x4* pad = (u32x4*)(ws + WS_CMPBUF + 32 * MiB); for (int i = F.bid * 512 + F.tid; i < 4096; i += F.G * 512) pad[i] = (u32x4){0u, 0u, 0u, 0u}; }
}

__device__ __forceinline__ void cmp2_phase(const Params& P, Frame& F_) { Frame F = reframe(F_);
    if (F.G == 256) {
        unsigned char* ws = P.ws; const float* hids = (const float*)(ws + WS_HIDS); const float* bias = (const float*)(ws + WS_RSTD1); bf16_t* kc = (bf16_t*)(ws + WS_KC); const bf16_t* w2t = (const bf16_t*)(ws + WS_WR + 896 * 1024);
        unsigned char* Gl = F.lds;
        const int tid = F.tid, lane = F.lane, w = F.wave, r16 = lane & 15, gq = lane >> 4, rl = tid >> 7, e = tid & 127;
        bf16x8 bfr[2][4];
#pragma unroll
        for (int t = 0; t < 2; ++t)
#pragma unroll
            for (int ks = 0; ks < 4; ++ks) bfr[t][ks] = *(const bf16x8*)(w2t + (size_t)(t * 128 + 16 * w + r16) * 128 + 32 * ks + 8 * gq);
        const size_t sl = (size_t)8 * 1024 * 128;
        float hv[8];
#pragma unroll
        for (int it = 0; it < 8; ++it) { const int rowi = (F.bid + 256 * it) * 4 + rl; const float* hr = hids + (size_t)rowi * 128 + e; hv[it] = (hr[0] + hr[sl]) + (hr[2 * sl] + hr[3 * sl]); }
        float bs[2] = {0.f, 0.f};
#pragma unroll
        for (int t = 0; t < 2; ++t) for (int kq = 0; kq < 32; ++kq) bs[t] += bias[(t * 32 + kq) * 128 + e];
        __syncthreads();
#pragma unroll
        for (int it = 0; it < 8; ++it) { const int t = it >> 2, row16 = (it & 3) * 4 + rl; *(bf16_t*)(Gl + t * 4352 + row16 * 272 + e * 2) = (bf16_t)f2bf(gelu_tanh(hv[it] + bs[t])); }
        __syncthreads();
#pragma unroll
        for (int t = 0; t < 2; ++t) { f32x4 acc = (f32x4){0.f, 0.f, 0.f, 0.f};
#pragma unroll
            for (int ks = 0; ks < 4; ++ks) { const bf16x8 a = *(const bf16x8*)(Gl + t * 4352 + r16 * 272 + (32 * ks + 8 * gq) * 2); acc = __builtin_amdgcn_mfma_f32_16x16x32_bf16(a, bfr[t][ks], acc, 0, 0, 0); }
#pragma unroll
            for (int r = 0; r < 4; ++r) { const int row16 = 4 * gq + r, it = t * 4 + (row16 >> 2), rowi = (F.bid + 256 * it) * 4 + (row16 & 3), n = rowi & 1023;
                kc[(size_t)rowi * 128 + 16 * w + r16] = (bf16_t)(n < 1023 ? f2bf(acc[r]) : 0u); } }
        __syncthreads();
        return;
    }
    unsigned char* ws = P.ws; const float* hids = (const float*)(ws + WS_HIDS); const float* bias = (const float*)(ws + WS_RSTD1); bf16_t* kc = (bf16_t*)(ws + WS_KC);
    float* hl = (float*)F.lds;
    const int rl = F.tid >> 7, e = F.tid & 127; int cur_t = -1; float bsum = 0.f;
    for (int rg = F.bid; rg < 2048; rg += F.G) {
        const int rowi = rg * 4 + rl, seg = rowi >> 10, n = rowi & 1023; const float* w2 = (seg >> 2) ? P.cmp_w2_v : P.cmp_w2_k;
        if ((seg >> 2) != cur_t) { cur_t = seg >> 2; bsum = 0.f; for (int kc = 0; kc < 32; ++kc) bsum += bias[(cur_t * 32 + kc) * 128 + e]; }
        const float* hr = hids + (size_t)rowi * 128 + e;
        const float hv = ((hr[0] + hr[(size_t)8 * 1024 * 128]) + (hr[(size_t)2 * 8 * 1024 * 128] + hr[(size_t)3 * 8 * 1024 * 128])) + bsum;
        __syncthreads();
        hl[rl * 128 + e] = gelu_tanh(hv);
        __syncthreads();
        float a = 0.f; const float* hrow = hl + rl * 128;
#pragma unroll 8
        for (int hh = 0; hh < 128; ++hh) a += hrow[hh] * w2[hh * 128 + e];
        kc[(size_t)rowi * 128 + e] = (bf16_t)(n < 1023 ? f2bf(a) : 0u);
    }
}

__device__ __forceinline__ unsigned off_b(unsigned row, unsigned ch) { return 256u * row + 16u * (ch ^ (((row & 3u) << 2) | ((row >> 2) & 3u))); }
__device__ __forceinline__ void stage_tile(unsigned char* dst, const bf16_t* src, size_t stride, int tid) {
    const int row = tid >> 3, ch0 = (tid & 7) * 2; const u32x4* s = (const u32x4*)(src + (size_t)row * stride + ch0 * 8);
    const u32x4 a = s[0], b = s[1];
    *(u32x4*)(dst + off_b(row, ch0)) = a; *(u32x4*)(dst + off_b(row, ch0 + 1)) = b;
}
struct T2 { u32x4 a, b; };
__device__ __forceinline__ void t2_load(T2& R, const bf16_t* src, size_t stride, int tid) { const int row = tid >> 3, ch0 = (tid & 7) * 2; const u32x4* sp = (const u32x4*)(src + (size_t)row * stride + ch0 * 8); R.a = sp[0]; R.b = sp[1]; }
__device__ __forceinline__ void t2_store(const T2& R, unsigned char* dst, int tid) { const int row = tid >> 3, ch0 = (tid & 7) * 2; *(u32x4*)(dst + off_b(row, ch0)) = R.a; *(u32x4*)(dst + off_b(row, ch0 + 1)) = R.b; }
struct NsaLane { int r16, gq, kaddr[4], vaddr[8], a8[4][2], ubase, kb, kh, vb, vh; };
__device__ __forceinline__ void qk_tile(const unsigned char* Kt, const NsaLane& L, const bf16x8 (&qf)[4], f32x4 (&acc)[4]) {
#pragma unroll
    for (int rb = 0; rb < 4; ++rb) { acc[rb] = (f32x4){0.f, 0.f, 0.f, 0.f};
#pragma unroll
        for (int ks = 0; ks < 4; ++ks) { const bf16x8 a = *(const bf16x8*)(Kt + L.kaddr[ks] + rb * 4096); acc[rb] = __builtin_amdgcn_mfma_f32_16x16x32_bf16(a, qf[ks], acc[rb], 0, 0, 0); } }
}
__device__ __forceinline__ void pv_tile(const unsigned char* Vt, const NsaLane& L, const f32x4 (&p)[4], f32x4 (&o)[8]) {
#pragma unroll
    for (int ks2 = 0; ks2 < 2; ++ks2) {
        u32x4 pw; pw.x = cvtpk(p[2 * ks2][0], p[2 * ks2][1]); pw.y = cvtpk(p[2 * ks2][2], p[2 * ks2][3]); pw.z = cvtpk(p[2 * ks2 + 1][0], p[2 * ks2 + 1][1]); pw.w = cvtpk(p[2 * ks2 + 1][2], p[2 * ks2 + 1][3]);
        const bf16x8 pb = __builtin_bit_cast(bf16x8, pw);
#pragma unroll
        for (int c = 0; c < 8; ++c) {
            const s16x4 v0 = __builtin_amdgcn_ds_read_tr16_b64_v4i16((LAS s16x4*)(Vt + L.vaddr[c] + 256 * (32 * ks2)));
            const s16x4 v1 = __builtin_amdgcn_ds_read_tr16_b64_v4i16((LAS s16x4*)(Vt + L.vaddr[c] + 256 * (32 * ks2 + 16)));
            const bf16x8 va = {v0[0], v0[1], v0[2], v0[3], v1[0], v1[1], v1[2], v1[3]};
            o[c] = __builtin_amdgcn_mfma_f32_16x16x32_bf16(va, pb, o[c], 0, 0, 0);
        }
    }
}
__device__ __forceinline__ float red_gq_max(float v) { v = fmaxf(v, __shfl_xor(v, 16)); v = fmaxf(v, __shfl_xor(v, 32)); return v; }
__device__ __forceinline__ float red_gq_sum(float v) { v += __shfl_xor(v, 16); v += __shfl_xor(v, 32); return v; }
__device__ __forceinline__ void osm_step(f32x4 (&s2)[4], float& m, float& l, f32x4 (&o)[8]) {
    float tm = -INFINITY;
#pragma unroll
    for (int rb = 0; rb < 4; ++rb) tm = fmaxf(tm, fmaxf(fmaxf(s2[rb][0], s2[rb][1]), fmaxf(s2[rb][2], s2[rb][3])));
    tm = red_gq_max(tm);
    const float mn = fmaxf(m, tm), alpha = exp2f(m - mn); float ps = 0.f;
#pragma unroll
    for (int rb = 0; rb < 4; ++rb)
#pragma unroll
        for (int r = 0; r < 4; ++r) { const float p = exp2f(s2[rb][r] - mn); s2[rb][r] = p; ps += p; }
    l = l * alpha + ps; m = mn;
#pragma unroll
    for (int c = 0; c < 8; ++c) o[c] *= alpha;
}
constexpr int NSA_KV0 = 0, NSA_KV1 = 32768, NSA_IMP = 65536, NSA_SELM = 131072, NSA_UNI = 133120, NSA_LIST = 133248, NSA_GATE = 133632;
struct DmaLane { unsigned rowl, chx, chk; };
template <bool KIMG> __device__ __forceinline__ void tile_dma(const bf16_t* src, size_t stride, unsigned char* dst, const DmaLane& D, int w) {
    unsigned ln = D.rowl; asm volatile("" : "+v"(ln));
    const unsigned rowl = ln >> 4, ch = KIMG ? ((ln & 15u) ^ ((4u * ((unsigned)w & 3u) + rowl) & 15u)) : ((ln & 15u) ^ ((rowl << 2) | ((unsigned)w & 3u)));
#pragma unroll
    for (int i2 = 0; i2 < 2; ++i2) { const int row = 4 * (8 * i2 + w) + (int)rowl;
        __builtin_amdgcn_global_load_lds((const unsigned*)(src + (size_t)row * stride + ch * 8), (LAS unsigned*)(dst + (8 * i2 + w) * 1024), 16, 0, 0); }
}
#define DMA_WAIT() asm volatile("s_waitcnt vmcnt(0)" ::: "memory")
__device__ __forceinline__ void qk_tile2(const unsigned char* Kt, const NsaLane& L, const bf16x8 (&qf)[2][4], f32x4 (&acc)[2][4]) {
    int kh = L.kh; asm volatile("" : "+v"(kh)); const unsigned char* Kb = Kt + L.kb;
    bf16x8 fr[4];
#define QK_LD(f) fr[(f) & 3] = *(const bf16x8*)(Kb + ((64 * ((f) & 3)) ^ kh) + ((f) >> 2) * 4096)
    QK_LD(0); QK_LD(1); QK_LD(2);
#pragma unroll
    for (int f = 0; f < 16; ++f) { const int rb = f >> 2, ks = f & 3;
        if (f + 3 < 16) QK_LD(f + 3);
        if (ks == 0) { acc[0][rb] = (f32x4){0.f, 0.f, 0.f, 0.f}; acc[1][rb] = (f32x4){0.f, 0.f, 0.f, 0.f}; }
        acc[0][rb] = __builtin_amdgcn_mfma_f32_16x16x32_bf16(fr[f & 3], qf[0][ks], acc[0][rb], 0, 0, 0); acc[1][rb] = __builtin_amdgcn_mfma_f32_16x16x32_bf16(fr[f & 3], qf[1][ks], acc[1][rb], 0, 0, 0);
        __builtin_amdgcn_sched_barrier(0); }
#undef QK_LD
}
__device__ __forceinline__ void pv_tile2(const unsigned char* Vt, const NsaLane& L, const f32x4 (&p)[2][4], f32x4 (&o)[2][8]) {
    int vh = L.vh; asm volatile("" : "+v"(vh)); const unsigned char* Vb = Vt + L.vb;
    bf16x8 pb[2][2];
#pragma unroll
    for (int ks2 = 0; ks2 < 2; ++ks2)
#pragma unroll
        for (int j = 0; j < 2; ++j) { u32x4 pw; pw.x = cvtpk(p[j][2 * ks2][0], p[j][2 * ks2][1]); pw.y = cvtpk(p[j][2 * ks2][2], p[j][2 * ks2][3]); pw.z = cvtpk(p[j][2 * ks2 + 1][0], p[j][2 * ks2 + 1][1]); pw.w = cvtpk(p[j][2 * ks2 + 1][2], p[j][2 * ks2 + 1][3]); pb[ks2][j] = __builtin_bit_cast(bf16x8, pw); }
    s16x4 va[3][2];
#define PV_LD(f) do { const unsigned char* a_ = Vb + ((32 * ((f) & 7)) ^ vh) + 256 * (32 * ((f) >> 3)); \
        va[(f) % 3][0] = __builtin_amdgcn_ds_read_tr16_b64_v4i16((LAS s16x4*)a_); va[(f) % 3][1] = __builtin_amdgcn_ds_read_tr16_b64_v4i16((LAS s16x4*)(a_ + 256 * 16)); } while (0)
    PV_LD(0); PV_LD(1);
#pragma unroll
    for (int f = 0; f < 16; ++f) { const int c = f & 7, ks2 = f >> 3;
        if (f + 2 < 16) PV_LD(f + 2);
        const s16x4 v0 = va[f % 3][0], v1 = va[f % 3][1];
        const bf16x8 vv = {v0[0], v0[1], v0[2], v0[3], v1[0], v1[1], v1[2], v1[3]};
        o[0][c] = __builtin_amdgcn_mfma_f32_16x16x32_bf16(vv, pb[ks2][0], o[0][c], 0, 0, 0); o[1][c] = __builtin_amdgcn_mfma_f32_16x16x32_bf16(vv, pb[ks2][1], o[1][c], 0, 0, 0);
        __builtin_amdgcn_sched_barrier(0); }
#undef PV_LD
}
__device__ __forceinline__ float max16(const f32x4 (&t)[4]) {
    float tm = fmaxf(fmaxf(fmaxf(t[0][0], t[0][1]), fmaxf(t[0][2], t[0][3])), fmaxf(fmaxf(t[1][0], t[1][1]), fmaxf(t[1][2], t[1][3])));
    return fmaxf(tm, fmaxf(fmaxf(fmaxf(t[2][0], t[2][1]), fmaxf(t[2][2], t[2][3])), fmaxf(fmaxf(t[3][0], t[3][1]), fmaxf(t[3][2], t[3][3]))));
}
__device__ __forceinline__ void osm_fast2(f32x4 (&t)[2][4], float (&m)[2], float (&l)[2], f32x4 (&o)[2][8]) {
#pragma unroll
    for (int j = 0; j < 2; ++j) {
        const float tml = max16(t[j]);
        if (__any(tml > m[j] + 8.0f)) { const float tm = red_gq_max(tml); const float mn = fmaxf(m[j], tm), alpha = ex2(m[j] - mn); l[j] *= alpha; m[j] = mn;
#pragma unroll
            for (int c = 0; c < 8; ++c) o[j][c] *= alpha; }
        float ps = 0.f;
#pragma unroll
        for (int rb = 0; rb < 4; ++rb)
#pragma unroll
            for (int r = 0; r < 4; ++r) { const float p = ex2(t[j][rb][r] - m[j]); t[j][rb][r] = p; ps += p; }
        l[j] += ps;
    }
}
#ifndef NREP_CMP
#define NREP_CMP 1
#endif
#ifndef NREP_WIN
#define NREP_WIN 1
#endif
#ifndef NREP_SEL
#define NREP_SEL 1
#endif
__device__ __forceinline__ void nsa_unit(const Params& P, Frame& F_, int unit) { Frame F = reframe(F_);
    unsigned char* ws = P.ws; const bf16_t* proj = (const bf16_t*)(ws + WS_R1); const bf16_t* kcb = (const bf16_t*)(ws + WS_KC); const float* small = (const float*)(ws + WS_SMALL);
    bf16_t* ymix = (bf16_t*)(ws + WS_R0);
    unsigned char* lds = F.lds; float* imp = (float*)(lds + NSA_IMP); unsigned* selm = (unsigned*)(lds + NSA_SELM); unsigned* uni = (unsigned*)(lds + NSA_UNI); unsigned char* slist = lds + NSA_LIST;
    const int tid = F.tid, lane = F.lane, w = F.wave;
    NsaLane L; L.r16 = lane & 15; L.gq = lane >> 4;
    const int qi = L.r16 >> 2, h = L.r16 & 3;
    {
      L.kb = 256 * L.r16 + 16 * (L.gq ^ (L.r16 & 3)); L.kh = (L.r16 & 12) << 4;
      const unsigned q4 = (unsigned)L.r16 >> 2, p = L.r16 & 3u, Xv = (q4 << 2) | (unsigned)L.gq;
      L.vb = 256 * (4 * L.gq + (int)q4) + 8 * (int)(p & 1u) + 16 * (int)((p >> 1) ^ (Xv & 1u)); L.vh = (int)((Xv & 14u) << 4); }
    const int qb = unit & 255, g = (unit >> 8) & 1, b = unit >> 9;
    const int t0 = qb * 64, head = g * 4 + h;
    int tq[2]; size_t rowq[2];
#pragma unroll
    for (int j = 0; j < 2; ++j) { tq[j] = t0 + 8 * w + 4 * j + qi; rowq[j] = (size_t)b * SEQ + tq[j]; }
    const float slope2 = exp2f(-(float)(head + 1)) * LOG2E, sc2 = 0.08838834764831845f * LOG2E;
    const float lb = slope2 * (float)(4 * L.gq);
    bf16x8 qf[2][4]; float* gatel = (float*)(lds + NSA_GATE) + w * 96 + L.r16;
#pragma unroll
    for (int j = 0; j < 2; ++j) { const bf16_t* qrow = proj + rowq[j] * NPROJ + C_NQ + head * 128;
#pragma unroll
        for (int ks = 0; ks < 4; ++ks) qf[j][ks] = *(const bf16x8*)(qrow + 32 * ks + 8 * L.gq);
#pragma unroll
        for (int k = 0; k < 3; ++k) { const float gv = sigmoid_f(small[rowq[j] * 64 + 16 + head * 3 + k]); if (L.gq == 0) gatel[(j * 3 + k) * 16] = gv; } }
    for (int i = tid; i < 64 * 256; i += 512) imp[i] = 0.f;
    f32x4 o[2][8], acc[2][4];
    u32x2* finl = (u32x2*)(lds + NSA_IMP) + w * 1024 + lane;
    DmaLane D; D.rowl = (unsigned)lane; D.chx = 0u; D.chk = 0u;
    const int ntc = ((t0 + 32) >> 4) / 64 + 1;
    int nlim[2]; nlim[0] = (tq[0] - 31) >> 4; nlim[1] = (tq[1] - 31) >> 4;
    const bf16_t* kc = kcb + (size_t)(0 * 4 + b * 2 + g) * 1024 * 128; const bf16_t* vc = kcb + (size_t)(1 * 4 + b * 2 + g) * 1024 * 128;
    const float slope16 = 16.f * slope2, lbc = 16.f * lb;
    lds_barrier();
    for (int rep_c = 0; rep_c < NREP_CMP; ++rep_c) {
    float m[2] = {-1e30f, -1e30f}, l[2] = {0.f, 0.f};
    lds_barrier();
    tile_dma<true>(kc, 128, lds + NSA_KV0, D, w);
    DMA_WAIT(); lds_barrier();
    for (int tl = 0; tl < ntc; ++tl) {
        const unsigned char* Kt = lds + (tl & 1) * 32768;
        if (tl + 1 < ntc) tile_dma<true>(kc + (size_t)(tl + 1) * 64 * 128, 128, lds + ((tl + 1) & 1) * 32768, D, w);
        qk_tile2(Kt, L, qf, acc);
        const float tb = lbc + slope16 * (float)(64 * tl);
        const bool full = __all(64 * tl + 63 <= nlim[0] && 64 * tl + 63 <= nlim[1]);
#pragma unroll
        for (int j = 0; j < 2; ++j) {
            if (full) {
#pragma unroll
                for (int rb = 0; rb < 4; ++rb)
#pragma unroll
                    for (int r = 0; r < 4; ++r) acc[j][rb][r] = fmaf(acc[j][rb][r], sc2, tb + slope16 * (float)(16 * rb + r));
            } else {
#pragma unroll
                for (int rb = 0; rb < 4; ++rb)
#pragma unroll
                    for (int r = 0; r < 4; ++r) { const int n = 64 * tl + 16 * rb + 4 * L.gq + r; acc[j][rb][r] = (n <= nlim[j]) ? fmaf(acc[j][rb][r], sc2, tb + slope16 * (float)(16 * rb + r)) : -INFINITY; }
            }
            const float tml = max16(acc[j]);
            if (__any(tml > m[j] + 8.0f)) { const float mn = fmaxf(m[j], red_gq_max(tml)); l[j] *= ex2(m[j] - mn); m[j] = mn; }
            float ps = 0.f;
#pragma unroll
            for (int rb = 0; rb < 4; ++rb)
#pragma unroll
                for (int r = 0; r < 4; ++r) ps += ex2(acc[j][rb][r] - m[j]);
            l[j] += ps;
        }
        DMA_WAIT(); lds_barrier();
    }
    float lg_inv[2];
#pragma unroll
    for (int j = 0; j < 2; ++j) { const float lt = red_gq_sum(l[j]); lg_inv[j] = lt > 0.f ? -__log2f(lt) - m[j] : -INFINITY;
#pragma unroll
        for (int c = 0; c < 8; ++c) o[j][c] = (f32x4){0.f, 0.f, 0.f, 0.f}; }
    tile_dma<true>(kc, 128, lds + NSA_KV0, D, w); tile_dma<false>(vc, 128, lds + NSA_KV0 + 16384, D, w);
    DMA_WAIT(); lds_barrier();
    for (int tl = 0; tl < ntc; ++tl) {
        const unsigned char* Kt = lds + (tl & 1) * 32768;
        if (tl + 1 < ntc) { unsigned char* nb_ = lds + ((tl + 1) & 1) * 32768; tile_dma<true>(kc + (size_t)(tl + 1) * 64 * 128, 128, nb_, D, w); tile_dma<false>(vc + (size_t)(tl + 1) * 64 * 128, 128, nb_ + 16384, D, w); }
        qk_tile2(Kt, L, qf, acc);
#pragma unroll
        for (int j = 0; j < 2; ++j) {
            const float tb = lbc + slope16 * (float)(64 * tl) + lg_inv[j];
#pragma unroll
            for (int rb = 0; rb < 4; ++rb) {
#pragma unroll
                for (int r = 0; r < 4; ++r) { const int n = 64 * tl + 16 * rb + 4 * L.gq + r; acc[j][rb][r] = (n <= nlim[j]) ? ex2(fmaf(acc[j][rb][r], sc2, tb + slope16 * (float)(16 * rb + r))) : 0.f; }
                float ia = 2.f * (acc[j][rb][0] + acc[j][rb][1] + acc[j][rb][2]) + acc[j][rb][3], ib = acc[j][rb][3];
                ia = quad_sum(ia); ib = quad_sum(ib);
                const int s0 = 16 * tl + 4 * rb + L.gq;
                if (h == 0 && rep_c == NREP_CMP - 1) { float* ip = imp + (8 * w + 4 * j + qi) * 256 + s0; atomicAdd(ip, ia); if (s0 + 1 < 256) atomicAdd(ip + 1, ib); }
            }
        }
        pv_tile2(Kt + 16384, L, acc, o);
        DMA_WAIT(); lds_barrier();
    }
    }
    const bf16_t* kwin = proj + (size_t)b * SEQ * NPROJ + C_KWIN + g * 128; const bf16_t* vwin = proj + (size_t)b * SEQ * NPROJ + C_VWIN + g * 128;
    const int kt0 = (t0 - 511) > 0 ? (t0 - 511) >> 6 : 0, kt1 = (t0 + 63) >> 6, nwt = kt1 - kt0 + 1;
    {
        unsigned key[8][4], Tq[8];
#pragma unroll
        for (int u = 0; u < 8; ++u) { const int qq = 8 * w + u, t = t0 + qq, cur = t >> 6; Tq[u] = 0u;
#pragma unroll
            for (int i = 0; i < 4; ++i) { const int s = lane + 64 * i; const float v = imp[qq * 256 + s]; const bool forced = (s == 0) || (s == cur) || (s == cur - 1); const bool valid = s <= cur;
                key[u][i] = forced ? 0x7F000000u : (valid ? __builtin_bit_cast(unsigned, v) + 1u : 0u); } }
        for (int bit = 30; bit >= 0; --bit) {
#pragma unroll
            for (int u0 = 0; u0 < 8; u0 += 2) {
                unsigned long long m[2][4]; unsigned trial[2];
#pragma unroll
                for (int uu = 0; uu < 2; ++uu) { trial[uu] = Tq[u0 + uu] | (1u << bit);
#pragma unroll
                    for (int i = 0; i < 4; ++i) asm("v_cmp_ge_u32_e64 %0, %1, %2" : "=s"(m[uu][i]) : "v"(key[u0 + uu][i]), "s"(trial[uu])); }
#pragma unroll
                for (int uu = 0; uu < 2; ++uu) { const int cnt = __popcll(m[uu][0]) + __popcll(m[uu][1]) + __popcll(m[uu][2]) + __popcll(m[uu][3]); if (cnt >= 16) Tq[u0 + uu] = trial[uu]; }
            }
        }
#pragma unroll
        for (int u = 0; u < 8; ++u) { const int qq = 8 * w + u; const unsigned Tu = Tq[u];
            unsigned long long gt[4], eq[4]; int ngt = 0;
#pragma unroll
            for (int i = 0; i < 4; ++i) { gt[i] = __ballot(key[u][i] > Tu); eq[i] = __ballot(key[u][i] == Tu); ngt += __popcll(gt[i]); }
            int rem = Tu > 0u ? 16 - ngt : 0;
#pragma unroll
            for (int i = 0; i < 4; ++i) { const int cq = __popcll(eq[i]); const int take = rem < cq ? rem : cq; rem -= take;
                const int rank = (int)__builtin_amdgcn_mbcnt_hi((unsigned)(eq[i] >> 32), __builtin_amdgcn_mbcnt_lo((unsigned)eq[i], 0u));
                const unsigned long long mk = gt[i] | __ballot(key[u][i] == Tu && rank < take);
                if (lane == 0) { selm[qq * 8 + 2 * i] = (unsigned)mk; selm[qq * 8 + 2 * i + 1] = (unsigned)(mk >> 32); } } }
    }
    lds_barrier();
    if (tid < 8) { unsigned uu = 0u; for (int q = 0; q < 64; ++q) uu |= selm[q * 8 + tid]; uni[tid] = uu; }
    const float gt0[2] = {gatel[0], gatel[3 * 16]};
#pragma unroll
    for (int j = 0; j < 2; ++j)
#pragma unroll
        for (int c = 0; c < 8; ++c) { u32x2 fv; fv.x = cvtpk(o[j][c][0] * gt0[j], o[j][c][1] * gt0[j]); fv.y = cvtpk(o[j][c][2] * gt0[j], o[j][c][3] * gt0[j]); finl[(j * 8 + c) * 64] = fv; }
    lds_barrier();
    int nsel = 0;
    { int pre = 0;
#pragma unroll
      for (int wd = 0; wd < 8; ++wd) { const unsigned uw = uni[wd]; if (wd == (tid >> 5) && tid < 256 && ((uw >> (tid & 31)) & 1u)) slist[pre + __popc(uw & ((1u << (tid & 31)) - 1u))] = (unsigned char)tid; pre += __popc(uw); }
      nsel = pre; }
    for (int rep_w = 0; rep_w < NREP_WIN; ++rep_w) {
        float mw_[2] = {-1e30f, -1e30f}, lw[2] = {0.f, 0.f};
        lds_barrier();
        tile_dma<true>(kwin + (size_t)kt1 * 64 * NPROJ, NPROJ, lds + NSA_KV0, D, w); tile_dma<false>(vwin + (size_t)kt1 * 64 * NPROJ, NPROJ, lds + NSA_KV0 + 16384, D, w);
#pragma unroll
        for (int j = 0; j < 2; ++j)
#pragma unroll
            for (int c = 0; c < 8; ++c) o[j][c] = (f32x4){0.f, 0.f, 0.f, 0.f};
        DMA_WAIT(); lds_barrier();
        for (int it = 0; it < nwt; ++it) {
            const unsigned char* Kt = lds + (it & 1) * 32768; const int kt = kt1 - it;
            if (it + 1 < nwt) { unsigned char* nb_ = lds + ((it + 1) & 1) * 32768; tile_dma<true>(kwin + (size_t)(kt - 1) * 64 * NPROJ, NPROJ, nb_, D, w); tile_dma<false>(vwin + (size_t)(kt - 1) * 64 * NPROJ, NPROJ, nb_ + 16384, D, w); }
            qk_tile2(Kt, L, qf, acc);
            const float tb = lb + slope2 * (float)(64 * kt); const int d0[2] = {tq[0] - 64 * kt, tq[1] - 64 * kt};
            const bool full = __all(d0[0] >= 63 && d0[0] < 512 && d0[1] >= 63 && d0[1] < 512);
#pragma unroll
            for (int j = 0; j < 2; ++j) {
                if (full) {
#pragma unroll
                    for (int rb = 0; rb < 4; ++rb)
#pragma unroll
                        for (int r = 0; r < 4; ++r) acc[j][rb][r] = fmaf(acc[j][rb][r], sc2, tb + slope2 * (float)(16 * rb + r));
                } else {
#pragma unroll
                    for (int rb = 0; rb < 4; ++rb)
#pragma unroll
                        for (int r = 0; r < 4; ++r) { const int dist = d0[j] - (16 * rb + 4 * L.gq + r); acc[j][rb][r] = (dist >= 0 && dist < 512) ? fmaf(acc[j][rb][r], sc2, tb + slope2 * (float)(16 * rb + r)) : -INFINITY; }
                }
            }
            osm_fast2(acc, mw_, lw, o);
            pv_tile2(Kt + 16384, L, acc, o);
            DMA_WAIT(); lds_barrier();
        }
        if (rep_w == NREP_WIN - 1) {
#pragma unroll
        for (int j = 0; j < 2; ++j) { const float lt = red_gq_sum(lw[j]); const float il = lt > 0.f ? gatel[(j * 3 + 2) * 16] / lt : 0.f;
#pragma unroll
            for (int c = 0; c < 8; ++c) { const u32x2 fp = finl[(j * 8 + c) * 64]; const float f0 = bflo(fp.x) + o[j][c][0] * il, f1 = bfhi(fp.x) + o[j][c][1] * il, f2 = bflo(fp.y) + o[j][c][2] * il, f3 = bfhi(fp.y) + o[j][c][3] * il;
                u32x2 fv; fv.x = cvtpk(f0, f1); fv.y = cvtpk(f2, f3); finl[(j * 8 + c) * 64] = fv; } } }
    }
    for (int rep_s = 0; rep_s < NREP_SEL; ++rep_s) {
        float ms[2] = {-1e30f, -1e30f}, ls[2] = {0.f, 0.f};
        lds_barrier();
#pragma unroll
        for (int j = 0; j < 2; ++j)
#pragma unroll
            for (int c = 0; c < 8; ++c) o[j][c] = (f32x4){0.f, 0.f, 0.f, 0.f};
        const bf16_t* ksel = proj + (size_t)b * SEQ * NPROJ + C_KSEL + g * 128; const bf16_t* vsel = proj + (size_t)b * SEQ * NPROJ + C_VSEL + g * 128;
        { const int s0_ = slist[nsel - 1]; tile_dma<true>(ksel + (size_t)s0_ * 64 * NPROJ, NPROJ, lds + NSA_KV0, D, w); tile_dma<false>(vsel + (size_t)s0_ * 64 * NPROJ, NPROJ, lds + NSA_KV0 + 16384, D, w); }
        DMA_WAIT(); lds_barrier();
        for (int it = 0; it < nsel; ++it) {
            const unsigned char* Kt = lds + (it & 1) * 32768; const int sblk = slist[nsel - 1 - it];
            if (it + 1 < nsel) { const int sn = slist[nsel - 2 - it]; unsigned char* nb_ = lds + ((it + 1) & 1) * 32768; tile_dma<true>(ksel + (size_t)sn * 64 * NPROJ, NPROJ, nb_, D, w); tile_dma<false>(vsel + (size_t)sn * 64 * NPROJ, NPROJ, nb_ + 16384, D, w); }
            bool mine[2];
#pragma unroll
            for (int j = 0; j < 2; ++j) mine[j] = (selm[(8 * w + 4 * j + qi) * 8 + (sblk >> 5)] >> (sblk & 31)) & 1u;
            if (__any(mine[0] || mine[1])) {
                qk_tile2(Kt, L, qf, acc);
                const float tb = lb + slope2 * (float)(64 * sblk); const int d0[2] = {tq[0] - 64 * sblk, tq[1] - 64 * sblk};
                const bool full = __all(mine[0] && mine[1] && d0[0] >= 63 && d0[1] >= 63);
#pragma unroll
                for (int j = 0; j < 2; ++j) {
                    if (full) {
#pragma unroll
                        for (int rb = 0; rb < 4; ++rb)
#pragma unroll
                            for (int r = 0; r < 4; ++r) acc[j][rb][r] = fmaf(acc[j][rb][r], sc2, tb + slope2 * (float)(16 * rb + r));
                    } else {
#pragma unroll
                        for (int rb = 0; rb < 4; ++rb)
#pragma unroll
                            for (int r = 0; r < 4; ++r) { const int dist = d0[j] - (16 * rb + 4 * L.gq + r); acc[j][rb][r] = (mine[j] && dist >= 0) ? fmaf(acc[j][rb][r], sc2, tb + slope2 * (float)(16 * rb + r)) : -INFINITY; }
                    }
                }
                osm_fast2(acc, ms, ls, o);
                pv_tile2(Kt + 16384, L, acc, o);
            }
            DMA_WAIT(); lds_barrier();
        }
        if (rep_s == NREP_SEL - 1) {
#pragma unroll
        for (int j = 0; j < 2; ++j) { const float lt = red_gq_sum(ls[j]); const float il = lt > 0.f ? gatel[(j * 3 + 1) * 16] / lt : 0.f;
            f32x4 fin[8]; float ss = 0.f;
#pragma unroll
            for (int c = 0; c < 8; ++c) { const u32x2 fp = finl[(j * 8 + c) * 64]; fin[c][0] = bflo(fp.x) + o[j][c][0] * il; fin[c][1] = bfhi(fp.x) + o[j][c][1] * il; fin[c][2] = bflo(fp.y) + o[j][c][2] * il; fin[c][3] = bfhi(fp.y) + o[j][c][3] * il;
                ss += (fin[c][0] * fin[c][0] + fin[c][1] * fin[c][1]) + (fin[c][2] * fin[c][2] + fin[c][3] * fin[c][3]); }
            ss = red_gq_sum(ss);
            const float rn = rsqrtf(ss * (1.0f / 128.f) + EPS);
            bf16_t* yo = ymix + ((size_t)b * SEQ + (t0 + 8 * w + 4 * j + qi)) * DM + 1024 + head * 128;
#pragma unroll
            for (int c = 0; c < 8; ++c) { const int d = 16 * c + 4 * L.gq; const f32x4 gg = *(const f32x4*)(P.nsa_norm_g + d);
                u32x2 wv; wv.x = cvtpk(fin[c][0] * rn * gg[0], fin[c][1] * rn * gg[1]); wv.y = cvtpk(fin[c][2] * rn * gg[2], fin[c][3] * rn * gg[3]); *(u32x2*)(yo + d) = wv; } } }
    }
}
__device__ __forceinline__ bf16x8 afrag8(const unsigned char* img, const NsaLane& L, int mb, int ks) {
    const u32x2 lo = *(const u32x2*)(img + L.a8[ks][0] + mb * 4096), hi = *(const u32x2*)(img + L.a8[ks][1] + mb * 4096);
    const u32x4 v = {lo.x, lo.y, hi.x, hi.y}; return __builtin_bit_cast(bf16x8, v);
}
__device__ __forceinline__ int perm32k(int c) { return (c & ~31) | (((c >> 2) & 3) << 3) | (((c >> 4) & 1) << 2) | (c & 3); }
__device__ __forceinline__ bf16x8 afrag16(const unsigned char* img, const NsaLane& L, int mb, int ks) { return *(const bf16x8*)(img + L.kaddr[ks] + mb * 4096); }
__device__ __forceinline__ void dn_lane_init(NsaLane& L, int lane, int w) {
    L.r16 = lane & 15; L.gq = lane >> 4;
    const unsigned Xk = ((L.r16 & 3u) << 2) | ((unsigned)L.r16 >> 2);
#pragma unroll
    for (int ks = 0; ks < 4; ++ks) { L.kaddr[ks] = 256 * L.r16 + 16 * (int)(((unsigned)(4 * ks + L.gq)) ^ Xk);
#pragma unroll
        for (int hf = 0; hf < 2; ++hf) L.a8[ks][hf] = 256 * L.r16 + 16 * (int)(((unsigned)(4 * ks + 2 * hf + (L.gq >> 1))) ^ Xk) + 8 * (L.gq & 1); }
    const unsigned q4 = (unsigned)L.r16 >> 2, p = L.r16 & 3u, Xv = (q4 << 2) | (unsigned)L.gq;
#pragma unroll
    for (int c = 0; c < 8; ++c) L.vaddr[c] = 256 * (4 * L.gq + (int)q4) + 16 * (int)(((unsigned)(2 * c) + (p >> 1)) ^ Xv) + 8 * (int)(p & 1u);
    L.ubase = 256 * (4 * L.gq + (int)q4) + 16 * (int)(((unsigned)(2 * w) + (p >> 1)) ^ Xv) + 8 * (int)(p & 1u);
}
__device__ __forceinline__ f32x4 tr_c4(const unsigned char* img, const NsaLane& L, int mb) {
    const s16x4 t = __builtin_amdgcn_ds_read_tr16_b64_v4i16((LAS s16x4*)(img + L.ubase + mb * 4096));
    return (f32x4){bf2f((unsigned short)t[0]), bf2f((unsigned short)t[1]), bf2f((unsigned short)t[2]), bf2f((unsigned short)t[3])};
}
__device__ __forceinline__ void pack_tiles(const f32x4* X, int ntile2, bf16x8* out) {
    for (int k = 0; k < ntile2; ++k) { u32x4 v; v.x = cvtpk(X[2 * k][0], X[2 * k][1]); v.y = cvtpk(X[2 * k][2], X[2 * k][3]); v.z = cvtpk(X[2 * k + 1][0], X[2 * k + 1][1]); v.w = cvtpk(X[2 * k + 1][2], X[2 * k + 1][3]); out[k] = __builtin_bit_cast(bf16x8, v); }
}
template <bool HAS_U, bool HAS_OUT>
__device__ __forceinline__ void dn_step(const unsigned char* Wimg, const unsigned char* Kimg, const unsigned char* Uimg, const unsigned char* Qimg, const unsigned char* QKimg,
                                        const float* gct, const NsaLane& L, f32x4 (&S)[8], f32x4 (&o)[4]) {
    bf16x8 sf[4];
#pragma unroll
    for (int k = 0; k < 4; ++k) { u32x4 v; v.x = cvtpk(S[2 * k][0], S[2 * k][1]); v.y = cvtpk(S[2 * k][2], S[2 * k][3]); v.z = cvtpk(S[2 * k + 1][0], S[2 * k + 1][1]); v.w = cvtpk(S[2 * k + 1][2], S[2 * k + 1][3]); sf[k] = __builtin_bit_cast(bf16x8, v); }
    f32x4 wsv[4], o1[4];
#pragma unroll
    for (int mb = 0; mb < 4; ++mb) { wsv[mb] = (f32x4){0.f, 0.f, 0.f, 0.f}; o1[mb] = (f32x4){0.f, 0.f, 0.f, 0.f};
#pragma unroll
        for (int ks = 0; ks < 4; ++ks) { wsv[mb] = __builtin_amdgcn_mfma_f32_16x16x32_bf16(afrag16(Wimg, L, mb, ks), sf[ks], wsv[mb], 0, 0, 0);
            if (HAS_OUT) o1[mb] = __builtin_amdgcn_mfma_f32_16x16x32_bf16(afrag16(Qimg, L, mb, ks), sf[ks], o1[mb], 0, 0, 0); }
        if (mb & 1) asm volatile("" ::: "memory"); }
    f32x4 vn[4], vs[4];
#pragma unroll
    for (int mb = 0; mb < 4; ++mb) { f32x4 uu = (f32x4){0.f, 0.f, 0.f, 0.f}; if (HAS_U) uu = tr_c4(Uimg, L, mb); vn[mb] = uu - wsv[mb];
        vs[mb] = vn[mb] * *(const f32x4*)(gct + 64 + 16 * mb + 4 * L.gq); }
    const float dl = gct[191];
#pragma unroll
    for (int c = 0; c < 8; ++c) S[c] *= dl;
    pv_tile(Kimg, L, vs, S);
    if (HAS_OUT) {
        bf16x8 vf[2];
#pragma unroll
        for (int k = 0; k < 2; ++k) { u32x4 v; v.x = cvtpk(vn[2 * k][0], vn[2 * k][1]); v.y = cvtpk(vn[2 * k][2], vn[2 * k][3]); v.z = cvtpk(vn[2 * k + 1][0], vn[2 * k + 1][1]); v.w = cvtpk(vn[2 * k + 1][2], vn[2 * k + 1][3]); vf[k] = __builtin_bit_cast(bf16x8, v); }
#pragma unroll
        for (int mb = 0; mb < 4; ++mb) { f32x4 o2 = (f32x4){0.f, 0.f, 0.f, 0.f};
#pragma unroll
            for (int k2 = 0; k2 < 2; ++k2) o2 = __builtin_amdgcn_mfma_f32_16x16x32_bf16(afrag16(QKimg, L, mb, k2), vf[k2], o2, 0, 0, 0);
            o[mb] = *(const f32x4*)(gct + 128 + 16 * mb + 4 * L.gq) * o1[mb] + o2; }
    }
}
constexpr int DP_K = 0, DP_Q = 16384, DP_V = 32768, DP_LOFF = 49152, DP_LD = 65536, DP_T = 69632, DP_TAB = 71680, DP_RAW = 73728;
__device__ __forceinline__ void dn_prep_unit(const Params& P, Frame& F_, int unit) { Frame F = reframe(F_);
    unsigned char* ws = P.ws; const bf16_t* proj = (const bf16_t*)(ws + WS_R1); const float* small = (const float*)(ws + WS_SMALL);
    bf16_t* qn = (bf16_t*)(ws + WS_QN); bf16_t* kn = (bf16_t*)(ws + WS_KN); bf16_t* ub = (bf16_t*)(ws + WS_VN); bf16_t* wb = (bf16_t*)(ws + WS_WN); bf16_t* qkb = (bf16_t*)(ws + WS_QK); float* gcb = (float*)(ws + WS_GDEC);
    unsigned char* lds = F.lds; unsigned char* Kimg = lds + DP_K; unsigned char* Qimg = lds + DP_Q; unsigned char* Vimg = lds + DP_V; unsigned char* Loff = lds + DP_LOFF; float* Ld = (float*)(lds + DP_LD); unsigned char* Timg = lds + DP_T;
    float* gt = (float*)(lds + DP_TAB); float* bt = gt + 64; float* gct = gt + 128; unsigned char* raw = lds + DP_RAW;
    const int tid = F.tid, lane = F.lane, w = F.wave;
    const int chain = unit >> 8, cch = unit & 255, b = chain >> 3, h = chain & 7, t0 = cch * 64; const size_t row0 = (size_t)b * SEQ + t0;
    { u32x4 rv[7];
#pragma unroll
      for (int k = 0; k < 7; ++k) { const int i = tid + 512 * k, ic = i < 67 * 48 ? i : 67 * 48 - 1; const int rr = ic / 48, cc = ic % 48, s = cc >> 4, c16 = cc & 15; const int tr = (t0 + rr - 3) >= 0 ? rr - 3 : -t0;
          rv[k] = *(const u32x4*)(proj + (row0 + tr) * NPROJ + s * 1024 + h * 128 + c16 * 8); }
#pragma unroll
      for (int k = 0; k < 7; ++k) { const int i = tid + 512 * k; if (i < 67 * 48) { const int rr = i / 48, cc = i % 48; const bool ok = (t0 + rr - 3) >= 0;
          *(u32x4*)(raw + rr * 768 + cc * 16) = ok ? rv[k] : (u32x4){0u, 0u, 0u, 0u}; } } }
    float cw[3][4][2];
#pragma unroll
    for (int s = 0; s < 3; ++s)
#pragma unroll
        for (int i = 0; i < 4; ++i) { cw[s][i][0] = P.conv_w[i * 3072 + s * 1024 + h * 128 + 2 * lane]; cw[s][i][1] = P.conv_w[i * 3072 + s * 1024 + h * 128 + 2 * lane + 1]; }
    const float Ah = -__expf(P.a_log[h]), dtb = P.dt_bias[h];
    const size_t grow = row0 + 8 * w + (lane & 7); const float sb1 = small[grow * 64 + h], sa1 = small[grow * 64 + 8 + h];
    lds_barrier();
#pragma unroll
    for (int ii = 0; ii < 8; ++ii) {
        const int i = 8 * w + ii; const size_t row = row0 + i;
        float o[3][2];
#pragma unroll
        for (int s = 0; s < 3; ++s) { float a0 = 0.f, a1 = 0.f;
#pragma unroll
            for (int j = 0; j < 4; ++j) { const unsigned wv = *(const unsigned*)(raw + (i + j) * 768 + s * 256 + 4 * lane); a0 += cw[s][j][0] * bflo(wv); a1 += cw[s][j][1] * bfhi(wv); }
            o[s][0] = silu_f(a0); o[s][1] = silu_f(a1); }
        const float sq = wave_sum(o[0][0] * o[0][0] + o[0][1] * o[0][1]), sk = wave_sum(o[1][0] * o[1][0] + o[1][1] * o[1][1]);
        const float rq = rsqrtf(sq + EPS) * 0.08838834764831845f, rk = rsqrtf(sk + EPS);
        const unsigned qw = cvtpk(o[0][0] * rq, o[0][1] * rq), kw = cvtpk(o[1][0] * rk, o[1][1] * rk), vw = cvtpk(o[2][0], o[2][1]);
        const size_t oo = row * 1024 + h * 128 + 2 * lane;
        *(unsigned*)(qn + row * 1024 + h * 128 + perm32k(2 * lane)) = qw; *(unsigned*)(kn + oo) = kw;
        const unsigned io = off_b(i, lane >> 2) + (lane & 3) * 4;
        *(unsigned*)(Kimg + io) = kw; *(unsigned*)(Qimg + io) = qw; *(unsigned*)(Vimg + io) = vw;
    }
    { const float bb = sigmoid_f(sb1); const float aa = sa1 + dtb; const float gi = Ah * (aa > 20.f ? aa : log1pf(__expf(aa)));
      if (lane < 8) { gt[8 * w + lane] = gi; bt[8 * w + lane] = bb; } }
    lds_barrier();
    { const float g = wave_scan(gt[lane]);
      gct[lane] = g;
      if (w == 0) { const float g63 = __builtin_bit_cast(float, __builtin_amdgcn_readlane(__builtin_bit_cast(int, g), 63)); gcb[(row0 + lane) * 8 + h] = __expf(g); ((float*)(ws + WS_BETA))[(row0 + lane) * 8 + h] = __expf(g63 - g); } }
    NsaLane L; dn_lane_init(L, lane, w);
#define DN_GTILE(which, tI_) do { const int mb = ((tI_) >> 2) & 3, nb = (tI_) & 3; f32x4 acc = (f32x4){0.f, 0.f, 0.f, 0.f}; \
        if (mb >= nb) { const unsigned char* Aimg = (which) ? Qimg : Kimg; \
            _Pragma("unroll") for (int ks = 0; ks < 4; ++ks) { const bf16x8 a = *(const bf16x8*)(Aimg + L.kaddr[ks] + mb * 4096), bq = *(const bf16x8*)(Kimg + L.kaddr[ks] + nb * 4096); acc = __builtin_amdgcn_mfma_f32_16x16x32_bf16(a, bq, acc, 0, 0, 0); } } \
        const int j = 16 * nb + L.r16; const float gj = gct[j]; \
        _Pragma("unroll") for (int r = 0; r < 4; ++r) { const int i = 16 * mb + 4 * L.gq + r; const float dec = __expf(gct[i] - gj); \
            if ((which) == 0) { const float lv = (i > j) ? bt[i] * dec * acc[r] : 0.f; \
                *(bf16_t*)(Loff + off_b(i, j >> 3) + (j & 7) * 2) = (bf16_t)f2bf(mb > nb ? lv : 0.f); \
                if (mb == nb) Ld[mb * 256 + (4 * L.gq + r) * 16 + L.r16] = lv; } \
            else qkb[(size_t)unit * 4096 + i * 64 + perm32k(j)] = (bf16_t)f2bf((i >= j) ? dec * acc[r] : 0.f); } } while (0)
    DN_GTILE(0, 2 * w); DN_GTILE(0, 2 * w + 1);
    lds_barrier();
    if (w > 0) { for (int tI = w - 1; tI < 16; tI += 7) DN_GTILE(1, tI); }
    if (w == 0) { const int blk = lane >> 4, c = lane & 15; const float* Lb = Ld + blk * 256; asm volatile("" : "+v"(Lb));
        float Tc[16];
#pragma unroll
        for (int i = 0; i < 16; ++i) { float a = (i == c) ? 1.0f : 0.f;
#pragma unroll
            for (int j4 = 0; j4 < (i + 3) / 4; ++j4) { const f32x4 l4 = *(const f32x4*)(Lb + i * 16 + 4 * j4);
#pragma unroll
                for (int jj = 0; jj < 4; ++jj) if (4 * j4 + jj < i) a -= l4[jj] * Tc[4 * j4 + jj]; }
            Tc[i] = a; *(bf16_t*)(Timg + blk * 512 + i * 32 + c * 2) = (bf16_t)f2bf(a); }
    }
#undef DN_GTILE
    lds_barrier();
    {
        const bool isw = w >= 4; const unsigned char* Simg = isw ? Kimg : Vimg; bf16_t* dstb = (isw ? wb : ub) + row0 * 1024 + h * 128;
        const unsigned q4 = (unsigned)L.r16 >> 2, p = L.r16 & 3u, Xv = (q4 << 2) | (unsigned)L.gq;
        int ub_[2];
#pragma unroll
        for (int cbi = 0; cbi < 2; ++cbi) { const int cb = 2 * (w & 3) + cbi; ub_[cbi] = 256 * (4 * L.gq + (int)q4) + 16 * (int)(((unsigned)(2 * cb) + (p >> 1)) ^ Xv) + 8 * (int)(p & 1u); }
        f32x4 X[2][4];
#pragma unroll
        for (int cbi = 0; cbi < 2; ++cbi)
#pragma unroll
            for (int bb = 0; bb < 4; ++bb) X[cbi][bb] = (f32x4){0.f, 0.f, 0.f, 0.f};
#pragma unroll
        for (int bb = 0; bb < 4; ++bb) {
            const f32x4 bt4 = *(const f32x4*)(bt + 16 * bb + 4 * L.gq), gc4 = *(const f32x4*)(gct + 16 * bb + 4 * L.gq);
            const u32x2 tl = *(const u32x2*)(Timg + bb * 512 + L.r16 * 32 + L.gq * 8);
            const u32x4 ta = {tl.x, tl.y, 0u, 0u};
            f32x4 Y[2];
#pragma unroll
            for (int cbi = 0; cbi < 2; ++cbi) {
                const s16x4 tv = __builtin_amdgcn_ds_read_tr16_b64_v4i16((LAS s16x4*)(Simg + ub_[cbi] + bb * 4096));
#pragma unroll
                for (int r = 0; r < 4; ++r) Y[cbi][r] = bf2f((unsigned short)tv[r]) * bt4[r] * (isw ? __expf(gc4[r]) : 1.0f);
            }
            if (bb > 0) {
#pragma unroll
                for (int cbi = 0; cbi < 2; ++cbi) { f32x4 upd = (f32x4){0.f, 0.f, 0.f, 0.f};
#pragma unroll
                    for (int ks = 0; ks < 2; ++ks) if (2 * ks < bb) { u32x4 xv; xv.x = cvtpk(X[cbi][2 * ks][0], X[cbi][2 * ks][1]); xv.y = cvtpk(X[cbi][2 * ks][2], X[cbi][2 * ks][3]); xv.z = cvtpk(X[cbi][2 * ks + 1][0], X[cbi][2 * ks + 1][1]); xv.w = cvtpk(X[cbi][2 * ks + 1][2], X[cbi][2 * ks + 1][3]);
                        upd = __builtin_amdgcn_mfma_f32_16x16x32_bf16(afrag8(Loff, L, bb, ks), __builtin_bit_cast(bf16x8, xv), upd, 0, 0, 0); }
                    Y[cbi] = Y[cbi] - upd; }
            }
#pragma unroll
            for (int cbi = 0; cbi < 2; ++cbi) { const int cb = 2 * (w & 3) + cbi;
                const u32x4 yb = {cvtpk(Y[cbi][0], Y[cbi][1]), cvtpk(Y[cbi][2], Y[cbi][3]), 0u, 0u};
                X[cbi][bb] = __builtin_amdgcn_mfma_f32_16x16x32_bf16(__builtin_bit_cast(bf16x8, ta), __builtin_bit_cast(bf16x8, yb), (f32x4){0.f, 0.f, 0.f, 0.f}, 0, 0, 0);
#pragma unroll
                for (int r = 0; r < 4; ++r) dstb[(size_t)(16 * bb + 4 * L.gq + r) * 1024 + (isw ? perm32k(16 * cb + L.r16) : 16 * cb + L.r16)] = (bf16_t)f2bf(X[cbi][bb][r]); }
        }
    }
    lds_barrier();
}
constexpr int DQ_K = 0, DQ_Q = 16384, DQ_V = 32768, DQ_R = 49152, DQ_LD = DQ_R + 16384, DQ_T = DQ_R + 20480, DQ_TAB = DQ_R + 22528, DQ_HALF = 73728;
__device__ __forceinline__ void dn_prep_pair(const Params& P, Frame& F_, int c, int k) { Frame F = reframe(F_);
    unsigned char* ws = P.ws; const bf16_t* proj = (const bf16_t*)(ws + WS_R1); const float* small = (const float*)(ws + WS_SMALL);
    bf16_t* qn = (bf16_t*)(ws + WS_QN); bf16_t* kn = (bf16_t*)(ws + WS_KN); bf16_t* ub = (bf16_t*)(ws + WS_VN); bf16_t* wb = (bf16_t*)(ws + WS_WN); bf16_t* qkb = (bf16_t*)(ws + WS_QK); float* gcb = (float*)(ws + WS_GDEC);
    const int tid = F.tid, lane = F.lane, w = F.wave, hf = w >> 2, hw = w & 3, htid = tid & 255;
    unsigned char* lds = F.lds + hf * DQ_HALF; unsigned char* Kimg = lds + DQ_K; unsigned char* Qimg = lds + DQ_Q; unsigned char* Vimg = lds + DQ_V; unsigned char* Loff = lds + DQ_R; float* Ld = (float*)(lds + DQ_LD); unsigned char* Timg = lds + DQ_T;
    float* gt = (float*)(lds + DQ_TAB); float* bt = gt + 64; float* gct = gt + 128; unsigned char* raw = lds + DQ_R;
    const int chain = hf * 8 + k, b = hf, h = k, unit = chain * 256 + c, t0 = c * 64; const size_t row0 = (size_t)b * SEQ + t0;
    u32x4 rv[3][5];
#pragma unroll
    for (int s = 0; s < 3; ++s)
#pragma unroll
        for (int kk = 0; kk < 5; ++kk) { const int i = htid + 256 * kk, ic = i < 67 * 16 ? i : 67 * 16 - 1; const int rr = ic >> 4, c16 = ic & 15; const int tr = (t0 + rr - 3) >= 0 ? rr - 3 : -t0;
            rv[s][kk] = *(const u32x4*)(proj + (row0 + tr) * NPROJ + s * 1024 + h * 128 + c16 * 8); }
    float cw[3][4][2];
#pragma unroll
    for (int s = 0; s < 3; ++s)
#pragma unroll
        for (int i = 0; i < 4; ++i) { const float2 c2 = *(const float2*)(P.conv_w + i * 3072 + s * 1024 + h * 128 + 2 * lane); cw[s][i][0] = c2.x; cw[s][i][1] = c2.y; }
    const float Ah = -__expf(P.a_log[h]), dtb = P.dt_bias[h];
    const size_t grow = row0 + 16 * hw + (lane & 15); const float sb1 = small[grow * 64 + h], sa1 = small[grow * 64 + 8 + h];
#pragma unroll
    for (int s = 0; s < 3; ++s) {
#pragma unroll
        for (int kk = 0; kk < 5; ++kk) { const int i = htid + 256 * kk; if (i < 67 * 16) { const bool ok = (t0 + (i >> 4) - 3) >= 0; *(u32x4*)(raw + 16 * i) = ok ? rv[s][kk] : (u32x4){0u, 0u, 0u, 0u}; } }
        lds_barrier();
        unsigned char* img = s == 0 ? Qimg : (s == 1 ? Kimg : Vimg);
        float o0[16], o1[16], sm[16];
#pragma unroll
        for (int ii = 0; ii < 16; ++ii) { const int i = 16 * hw + ii;
            float a0 = 0.f, a1 = 0.f;
#pragma unroll
            for (int j = 0; j < 4; ++j) { const unsigned wv = *(const unsigned*)(raw + (i + j) * 256 + 4 * lane); a0 += cw[s][j][0] * bflo(wv); a1 += cw[s][j][1] * bfhi(wv); }
            o0[ii] = silu_f(a0); o1[ii] = silu_f(a1); sm[ii] = o0[ii] * o0[ii] + o1[ii] * o1[ii]; }
        if (s < 2) {
#pragma unroll
            for (int ii = 0; ii < 16; ++ii) sm[ii] = wave_sum(sm[ii]); }
#pragma unroll
        for (int ii = 0; ii < 16; ++ii) { const int i = 16 * hw + ii; const size_t row = row0 + i;
            unsigned pk;
            if (s < 2) { const float r = __builtin_amdgcn_rsqf(sm[ii] + EPS) * (s == 0 ? 0.08838834764831845f : 1.0f); pk = cvtpk(o0[ii] * r, o1[ii] * r);
                if (s == 0) *(unsigned*)(qn + row * 1024 + h * 128 + perm32k(2 * lane)) = pk; else *(unsigned*)(kn + row * 1024 + h * 128 + 2 * lane) = pk; }
            else pk = cvtpk(o0[ii], o1[ii]);
            *(unsigned*)(img + off_b(i, lane >> 2) + (lane & 3) * 4) = pk;
        }
        if (s == 2) { const float bb = sigmoid_f(sb1); const float aa = sa1 + dtb; const float gi = Ah * (aa > 20.f ? aa : log1pf(__expf(aa)));
            if (lane < 16) { gt[16 * hw + lane] = gi; bt[16 * hw + lane] = bb; } }
        lds_barrier();
    }
    { const float g = wave_scan(gt[lane]);
      gct[lane] = g;
      if (hw == 0) { const float g63 = __builtin_bit_cast(float, __builtin_amdgcn_readlane(__builtin_bit_cast(int, g), 63)); gcb[(row0 + lane) * 8 + h] = __expf(g); ((float*)(ws + WS_BETA))[(row0 + lane) * 8 + h] = __expf(g63 - g); } }
    NsaLane L; dn_lane_init(L, lane, hw);
#define DN_GTILE(which, tI_) do { const int mb = ((tI_) >> 2) & 3, nb = (tI_) & 3; f32x4 acc = (f32x4){0.f, 0.f, 0.f, 0.f}; \
        if (mb >= nb) { const unsigned char* Aimg = (which) ? Qimg : Kimg; \
            _Pragma("unroll") for (int ks = 0; ks < 4; ++ks) { const bf16x8 a = *(const bf16x8*)(Aimg + L.kaddr[ks] + mb * 4096), bq = *(const bf16x8*)(Kimg + L.kaddr[ks] + nb * 4096); acc = __builtin_amdgcn_mfma_f32_16x16x32_bf16(a, bq, acc, 0, 0, 0); } } \
        const int j = 16 * nb + L.r16; const float gj = gct[j]; \
        _Pragma("unroll") for (int r = 0; r < 4; ++r) { const int i = 16 * mb + 4 * L.gq + r; const float dec = __expf(gct[i] - gj); \
            if ((which) == 0) { const float lv = (i > j) ? bt[i] * dec * acc[r] : 0.f; \
                *(bf16_t*)(Loff + off_b(i, j >> 3) + (j & 7) * 2) = (bf16_t)f2bf(mb > nb ? lv : 0.f); \
                if (mb == nb) Ld[mb * 256 + (4 * L.gq + r) * 16 + L.r16] = lv; } \
            else qkb[(size_t)unit * 4096 + i * 64 + perm32k(j)] = (bf16_t)f2bf((i >= j) ? dec * acc[r] : 0.f); } } while (0)
    for (int q = 0; q < 4; ++q) DN_GTILE(0, 4 * hw + q);
    lds_barrier();
    if (hw > 0) { for (int tI = hw - 1; tI < 16; tI += 3) DN_GTILE(1, tI); }
    if (hw == 0) { int blk = lane >> 4; const int cc = lane & 15; asm volatile("" : "+v"(blk));
        const LAS float* Lb = (const LAS float*)(LAS unsigned char*)Ld + blk * 256;
        float Tc[16];
#pragma unroll
        for (int i = 0; i < 16; ++i) { float a = (i == cc) ? 1.0f : 0.f;
#pragma unroll
            for (int j4 = 0; j4 < (i + 3) / 4; ++j4) { const f32x4 l4 = *(const LAS f32x4*)(Lb + i * 16 + 4 * j4);
#pragma unroll
                for (int jj = 0; jj < 4; ++jj) if (4 * j4 + jj < i) a -= l4[jj] * Tc[4 * j4 + jj]; }
            Tc[i] = a; *(bf16_t*)(Timg + blk * 512 + i * 32 + cc * 2) = (bf16_t)f2bf(a); }
    }
#undef DN_GTILE
    lds_barrier();
    {
        const bool isw = hw >= 2; const unsigned char* Simg = isw ? Kimg : Vimg; bf16_t* dstb = (isw ? wb : ub) + row0 * 1024 + h * 128;
        const unsigned q4 = (unsigned)L.r16 >> 2, p = L.r16 & 3u, Xv = (q4 << 2) | (unsigned)L.gq;
        int ub_[4];
#pragma unroll
        for (int cbi = 0; cbi < 4; ++cbi) { const int cb = 4 * (hw & 1) + cbi; ub_[cbi] = 256 * (4 * L.gq + (int)q4) + 16 * (int)(((unsigned)(2 * cb) + (p >> 1)) ^ Xv) + 8 * (int)(p & 1u); }
        f32x4 X[4][4];
#pragma unroll
        for (int cbi = 0; cbi < 4; ++cbi)
#pragma unroll
            for (int bb = 0; bb < 4; ++bb) X[cbi][bb] = (f32x4){0.f, 0.f, 0.f, 0.f};
#pragma unroll
        for (int bb = 0; bb < 4; ++bb) {
            const f32x4 bt4 = *(const f32x4*)(bt + 16 * bb + 4 * L.gq), gc4 = *(const f32x4*)(gct + 16 * bb + 4 * L.gq);
            const u32x2 tl = *(const u32x2*)(Timg + bb * 512 + L.r16 * 32 + L.gq * 8);
            const u32x4 ta = {tl.x, tl.y, 0u, 0u};
            f32x4 Y[4];
#pragma unroll
            for (int cbi = 0; cbi < 4; ++cbi) {
                const s16x4 tv = __builtin_amdgcn_ds_read_tr16_b64_v4i16((LAS s16x4*)(Simg + ub_[cbi] + bb * 4096));
#pragma unroll
                for (int r = 0; r < 4; ++r) Y[cbi][r] = bf2f((unsigned short)tv[r]) * bt4[r] * (isw ? __expf(gc4[r]) : 1.0f);
            }
            if (bb > 0) {
#pragma unroll
                for (int cbi = 0; cbi < 4; ++cbi) { f32x4 upd = (f32x4){0.f, 0.f, 0.f, 0.f};
#pragma unroll
                    for (int ks = 0; ks < 2; ++ks) if (2 * ks < bb) { u32x4 xv; xv.x = cvtpk(X[cbi][2 * ks][0], X[cbi][2 * ks][1]); xv.y = cvtpk(X[cbi][2 * ks][2], X[cbi][2 * ks][3]); xv.z = cvtpk(X[cbi][2 * ks + 1][0], X[cbi][2 * ks + 1][1]); xv.w = cvtpk(X[cbi][2 * ks + 1][2], X[cbi][2 * ks + 1][3]);
                        upd = __builtin_amdgcn_mfma_f32_16x16x32_bf16(afrag8(Loff, L, bb, ks), __builtin_bit_cast(bf16x8, xv), upd, 0, 0, 0); }
                    Y[cbi] = Y[cbi] - upd; }
            }
#pragma unroll
            for (int cbi = 0; cbi < 4; ++cbi) { const int cb = 4 * (hw & 1) + cbi;
                const u32x4 yb = {cvtpk(Y[cbi][0], Y[cbi][1]), cvtpk(Y[cbi][2], Y[cbi][3]), 0u, 0u};
                X[cbi][bb] = __builtin_amdgcn_mfma_f32_16x16x32_bf16(__builtin_bit_cast(bf16x8, ta), __builtin_bit_cast(bf16x8, yb), (f32x4){0.f, 0.f, 0.f, 0.f}, 0, 0, 0);
                { const unsigned p01 = cvtpk(X[cbi][bb][0], X[cbi][bb][1]), p23 = cvtpk(X[cbi][bb][2], X[cbi][bb][3]);
                  bf16_t* d0 = dstb + (size_t)(16 * bb + 4 * L.gq) * 1024 + (isw ? perm32k(16 * cb + L.r16) : 16 * cb + L.r16);
                  d0[0] = (bf16_t)p01; d0[1024] = (bf16_t)(p01 >> 16); d0[2048] = (bf16_t)p23; d0[3072] = (bf16_t)(p23 >> 16); } }
        }
    }
    lds_barrier();
}
__device__ __forceinline__ void small_gemm_chunk(const Params& P, Frame& F_, int c) { Frame F = reframe(F_);
    unsigned char* ws = P.ws; const bf16_t* xb = (const bf16_t*)(ws + WS_R0); const bf16_t* bt = (const bf16_t*)(ws + WS_BTIN) + (size_t)6656 * DM; float* small = (float*)(ws + WS_SMALL);
    unsigned char* lds = F.lds;
    const int tid = F.tid, lane = F.lane, w = F.wave, r16 = lane & 15, gq = lane >> 4; const size_t row0 = (size_t)(w >> 2) * SEQ + 64 * c + 16 * (w & 3);
    const bf16_t* xr = xb + (row0 + r16) * DM + 8 * gq;
    f32x4 acc[3];
#pragma unroll
    for (int nb = 0; nb < 3; ++nb) acc[nb] = (f32x4){0.f, 0.f, 0.f, 0.f};
    for (int kq = 0; kq < 4; ++kq) {
        u32x4 wv[6]; bf16x8 a[16];
#pragma unroll
        for (int i = 0; i < 6; ++i) { const int ci = tid + 512 * i, rr = ci >> 6, cc = ci & 63; wv[i] = *(const u32x4*)(bt + (size_t)rr * DM + kq * 512 + cc * 8); }
#pragma unroll
        for (int k = 0; k < 16; ++k) a[k] = *(const bf16x8*)(xr + 32 * (kq * 16 + k));
        __syncthreads();
#pragma unroll
        for (int i = 0; i < 6; ++i) { const int ci = tid + 512 * i, rr = ci >> 6, cc = ci & 63; *(u32x4*)(lds + rr * 1040 + cc * 16) = wv[i]; }
        __syncthreads();
#pragma unroll
        for (int k = 0; k < 16; ++k)
#pragma unroll
            for (int nb = 0; nb < 3; ++nb) { const bf16x8 bq = *(const bf16x8*)(lds + (16 * nb + r16) * 1040 + (4 * k + gq) * 16); acc[nb] = __builtin_amdgcn_mfma_f32_16x16x32_bf16(a[k], bq, acc[nb], 0, 0, 0); }
    }
#pragma unroll
    for (int nb = 0; nb < 3; ++nb)
#pragma unroll
        for (int r = 0; r < 4; ++r) small[(row0 + 4 * gq + r) * 64 + 16 * nb + r16] = acc[nb][r];
}
constexpr int DS_W = 0, DS_K = 16384, DS_U = 32768, DS_Q = 49152, DS_QK = 65536, DS_Z = 81920, DS_TAB = 98304;
constexpr int NSEG = 16, CPS = 16;
__device__ __forceinline__ void dn_passA_unit(const Params& P, Frame& F_, int unit) { Frame F = reframe(F_);
    unsigned char* ws = P.ws; const bf16_t* kn = (const bf16_t*)(ws + WS_KN); const bf16_t* ub = (const bf16_t*)(ws + WS_VN); const bf16_t* wb = (const bf16_t*)(ws + WS_WN); const float* gcb = (const float*)(ws + WS_GDEC); float* mn = (float*)(ws + WS_MN);
    unsigned char* lds = F.lds; float* gct = (float*)(lds + DS_TAB);
    const int tid = F.tid, lane = F.lane, w = F.wave; const int part = unit & 1, cs = unit >> 1, chain = cs / 15, seg = cs % 15, b = chain >> 3, h = chain & 7;
    NsaLane L; dn_lane_init(L, lane, w);
    f32x4 S[8], dummy[4];
#pragma unroll
    for (int c = 0; c < 8; ++c)
#pragma unroll
        for (int r = 0; r < 4; ++r) S[c][r] = (part && c == w && 4 * L.gq + r == L.r16) ? 1.0f : 0.f;
    T2 rW, rK, rU; float rg = 0.f; const float* ekb = (const float*)(ws + WS_BETA);
    { const size_t row0 = (size_t)b * SEQ + (size_t)(seg * CPS) * 64; const size_t go = row0 * 1024 + h * 128;
      t2_load(rW, wb + go, 1024, tid); t2_load(rK, kn + go, 1024, tid); if (!part) t2_load(rU, ub + go, 1024, tid); if (tid < 128) rg = (tid < 64 ? ekb : gcb)[(row0 + (tid & 63)) * 8 + h]; }
    for (int cc = 0; cc < CPS; ++cc) {
        lds_barrier();
        t2_store(rW, lds + DS_W, tid); t2_store(rK, lds + DS_K, tid); if (!part) t2_store(rU, lds + DS_U, tid); if (tid < 128) gct[64 + tid] = rg;
        if (cc + 1 < CPS) { const size_t row0 = (size_t)b * SEQ + (size_t)(seg * CPS + cc + 1) * 64; const size_t go = row0 * 1024 + h * 128;
            t2_load(rW, wb + go, 1024, tid); t2_load(rK, kn + go, 1024, tid); if (!part) t2_load(rU, ub + go, 1024, tid); if (tid < 128) rg = (tid < 64 ? ekb : gcb)[(row0 + (tid & 63)) * 8 + h]; }
        lds_barrier();
        if (!part) dn_step<true, false>(lds + DS_W, lds + DS_K, lds + DS_U, lds + DS_Q, lds + DS_QK, gct, L, S, dummy);
        else dn_step<false, false>(lds + DS_W, lds + DS_K, lds + DS_U, lds + DS_Q, lds + DS_QK, gct, L, S, dummy);
    }
    float* no = mn + ((size_t)(chain * NSEG + seg) * 2 + part) * 16384;
#pragma unroll
    for (int c = 0; c < 8; ++c)
#pragma unroll
        for (int r = 0; r < 4; ++r) no[(16 * c + 4 * L.gq + r) * 128 + 16 * w + L.r16] = S[c][r];
}
__device__ __forceinline__ void dn_passB_unit(const Params& P, Frame& F_, int chain) { Frame F = reframe(F_);
    unsigned char* ws = P.ws; const float* mn = (const float*)(ws + WS_MN); float* sst = (float*)(ws + WS_SST);
    unsigned char* lds = F.lds; const int tid = F.tid, lane = F.lane, w = F.wave;
    NsaLane L; dn_lane_init(L, lane, w);
    f32x4 S[8];
#pragma unroll
    for (int c = 0; c < 8; ++c) S[c] = (f32x4){0.f, 0.f, 0.f, 0.f};
    for (int seg = 0; seg < NSEG - 1; ++seg) {
        const float* nB = mn + ((size_t)(chain * NSEG + seg) * 2 + 0) * 16384; const float* nA = nB + 16384;
        lds_barrier();
#pragma unroll
        for (int k = 0; k < 4; ++k) { const int idx = tid + 512 * k, row = idx >> 4, ch = idx & 15; const f32x4 a = *(const f32x4*)(nA + row * 128 + ch * 8), bq = *(const f32x4*)(nA + row * 128 + ch * 8 + 4);
            u32x4 v; v.x = cvtpk(a[0], a[1]); v.y = cvtpk(a[2], a[3]); v.z = cvtpk(bq[0], bq[1]); v.w = cvtpk(bq[2], bq[3]); *(u32x4*)(lds + off_b(row, ch)) = v; }
        lds_barrier();
        bf16x8 sf[4];
#pragma unroll
        for (int k = 0; k < 4; ++k) { u32x4 v; v.x = cvtpk(S[2 * k][0], S[2 * k][1]); v.y = cvtpk(S[2 * k][2], S[2 * k][3]); v.z = cvtpk(S[2 * k + 1][0], S[2 * k + 1][1]); v.w = cvtpk(S[2 * k + 1][2], S[2 * k + 1][3]); sf[k] = __builtin_bit_cast(bf16x8, v); }
        float* so = sst + ((size_t)chain * NSEG + seg + 1) * 16384;
        f32x4 nv[8];
#pragma unroll
        for (int mb = 0; mb < 8; ++mb)
#pragma unroll
            for (int r = 0; r < 4; ++r) nv[mb][r] = nB[(16 * mb + 4 * L.gq + r) * 128 + 16 * w + L.r16];
#pragma unroll
        for (int mb = 0; mb < 8; ++mb) { f32x4 acc = nv[mb];
#pragma unroll
            for (int ks = 0; ks < 4; ++ks) acc = __builtin_amdgcn_mfma_f32_16x16x32_bf16(afrag8(lds, L, mb, ks), sf[ks], acc, 0, 0, 0);
            S[mb] = acc;
#pragma unroll
            for (int r = 0; r < 4; ++r) so[(16 * mb + 4 * L.gq + r) * 128 + 16 * w + L.r16] = acc[r]; }
    }
}
__device__ __forceinline__ void dn_passC_unit(const Params& P, Frame& F_, int unit) { Frame F = reframe(F_);
    unsigned char* ws = P.ws; const bf16_t* proj = (const bf16_t*)(ws + WS_R1); const bf16_t* qn = (const bf16_t*)(ws + WS_QN); const bf16_t* kn = (const bf16_t*)(ws + WS_KN); const bf16_t* ub = (const bf16_t*)(ws + WS_VN); const bf16_t* wb = (const bf16_t*)(ws + WS_WN);
    const bf16_t* qkb = (const bf16_t*)(ws + WS_QK); const float* gcb = (const float*)(ws + WS_GDEC); const float* sst = (const float*)(ws + WS_SST); bf16_t* ymix = (bf16_t*)(ws + WS_R0);
    unsigned char* lds = F.lds; float* gct = (float*)(lds + DS_TAB); float* part = gct + 256; float* rnt = part + 512;
    const int tid = F.tid, lane = F.lane, w = F.wave; const int chain = unit >> 4, seg = unit & 15, b = chain >> 3, h = chain & 7;
    NsaLane L; dn_lane_init(L, lane, w);
    f32x4 S[8], o[4];
    { const float* si = sst + ((size_t)chain * NSEG + seg) * 16384;
#pragma unroll
      for (int c = 0; c < 8; ++c)
#pragma unroll
          for (int r = 0; r < 4; ++r) { const float sv = si[(16 * c + 4 * L.gq + r) * 128 + 16 * w + L.r16]; S[c][r] = seg ? sv : 0.f; } }
    const float gnorm = P.dn_norm_g[16 * w + L.r16];
    T2 rW, rK, rU, rQ, rZ; u32x4 rQK; float rg = 0.f; const float* ekb = (const float*)(ws + WS_BETA);
#define DN_C_LOAD(chunk_) do { const size_t row0_ = (size_t)b * SEQ + (size_t)(chunk_) * 64; const size_t go_ = row0_ * 1024 + h * 128; \
        t2_load(rW, wb + go_, 1024, tid); t2_load(rK, kn + go_, 1024, tid); t2_load(rU, ub + go_, 1024, tid); t2_load(rQ, qn + go_, 1024, tid); \
        t2_load(rZ, proj + row0_ * NPROJ + C_Z + h * 128, NPROJ, tid); \
        rQK = *(const u32x4*)(qkb + (size_t)(chain * 256 + (chunk_)) * 4096 + (tid >> 3) * 64 + (tid & 7) * 8); \
        if (tid < 128) rg = (tid < 64 ? ekb : gcb)[(row0_ + (tid & 63)) * 8 + h]; } while (0)
    DN_C_LOAD(seg * CPS);
    for (int cc = 0; cc < CPS; ++cc) {
        const int chunk = seg * CPS + cc; const size_t row0 = (size_t)b * SEQ + (size_t)chunk * 64;
        lds_barrier();
        t2_store(rW, lds + DS_W, tid); t2_store(rK, lds + DS_K, tid); t2_store(rU, lds + DS_U, tid); t2_store(rQ, lds + DS_Q, tid); t2_store(rZ, lds + DS_Z, tid);
        *(u32x4*)(lds + DS_QK + off_b(tid >> 3, tid & 7)) = rQK; if (tid < 128) gct[64 + tid] = rg;
        if (cc + 1 < CPS) DN_C_LOAD(chunk + 1);
        lds_barrier();
        dn_step<true, true>(lds + DS_W, lds + DS_K, lds + DS_U, lds + DS_Q, lds + DS_QK, gct, L, S, o);
        float rs_[4][4];
#pragma unroll
        for (int mb = 0; mb < 4; ++mb)
#pragma unroll
            for (int r = 0; r < 4; ++r) rs_[mb][r] = row16_sum(o[mb][r] * o[mb][r]);
#pragma unroll
        for (int mb = 0; mb < 4; ++mb)
#pragma unroll
            for (int r = 0; r < 4; ++r) { if (L.r16 == 0) part[(16 * mb + 4 * L.gq + r) * 8 + w] = rs_[mb][r]; }
        lds_barrier();
        if (tid < 64) { float s = 0.f;
#pragma unroll
            for (int k = 0; k < 8; ++k) s += part[tid * 8 + k];
            rnt[tid] = rsqrtf(s * (1.0f / 128.f) + EPS); }
        lds_barrier();
#pragma unroll
        for (int mb = 0; mb < 4; ++mb) { const f32x4 rn4 = *(const f32x4*)(rnt + 16 * mb + 4 * L.gq); const f32x4 z4 = tr_c4(lds + DS_Z, L, mb);
#pragma unroll
            for (int r = 0; r < 4; ++r) ymix[(row0 + 16 * mb + 4 * L.gq + r) * DM + h * 128 + 16 * w + L.r16] = (bf16_t)f2bf(o[mb][r] * rn4[r] * gnorm * silu_f(z4[r])); }
    }
}

__device__ __forceinline__ void router_phase(const Params& P, Frame& F_) { Frame F = reframe(F_);
    unsigned char* ws = P.ws; const bf16_t* x1b = (const bf16_t*)(ws + WS_X1B); const bf16_t* whi = (const bf16_t*)(ws + WS_WR); const bf16_t* wlo = (const bf16_t*)(ws + WS_WR + 512 * 1024);
    float* rstd2 = (float*)(ws + WS_RSTD2); int* lists = (int*)(ws + WS_LISTS); float* gatew = (float*)(ws + WS_GATEW); unsigned* cnt = (unsigned*)(ws + WS_CTL) + CW_CNT;
    float* lg = (float*)(F.lds + 86016 + F.wave * (16 * 80 * 4));
    unsigned char* lds = F.lds; const int tid = F.tid;
    const int lane = F.lane, r16 = lane & 15, gq = lane >> 4;
    for (int tb = F.bid; tb < T / 128; tb += F.G) {
        const int task = tb * 8 + F.wave;
        const int row = task * 16 + r16; const bf16_t* xr = x1b + (size_t)row * DM + 8 * gq;
        f32x4 acc[5];
#pragma unroll
        for (int nb = 0; nb < 5; ++nb) acc[nb] = (f32x4){0.f, 0.f, 0.f, 0.f};
        float ssq = 0.f;
        for (int e8 = 0; e8 < 8; ++e8) {
            u32x4 wv[10], xa[8];
#pragma unroll
            for (int i = 0; i < 10; ++i) { const int ci = tid + 512 * i, rr = ci >> 5, cc = ci & 31; wv[i] = *(const u32x4*)((rr < 80 ? whi + (size_t)rr * DM : wlo + (size_t)(rr - 80) * DM) + e8 * 256 + cc * 8); }
#pragma unroll
            for (int k = 0; k < 8; ++k) xa[k] = *(const u32x4*)(xr + 32 * (e8 * 8 + k));
            __syncthreads();
#pragma unroll
            for (int i = 0; i < 10; ++i) { const int ci = tid + 512 * i, rr = ci >> 5, cc = ci & 31; *(u32x4*)(lds + rr * 528 + cc * 16) = wv[i]; }
            __syncthreads();
#pragma unroll
            for (int k = 0; k < 8; ++k) { const u32x4 xw = xa[k];
                { const float a0 = bflo(xw.x), a1 = bfhi(xw.x), a2 = bflo(xw.y), a3 = bfhi(xw.y), a4 = bflo(xw.z), a5 = bfhi(xw.z), a6 = bflo(xw.w), a7 = bfhi(xw.w);
                  ssq += (a0 * a0 + a1 * a1) + (a2 * a2 + a3 * a3) + (a4 * a4 + a5 * a5) + (a6 * a6 + a7 * a7); }
                const bf16x8 xh = __builtin_bit_cast(bf16x8, xw);
#pragma unroll
                for (int nb = 0; nb < 5; ++nb) { const bf16x8 bh = *(const bf16x8*)(lds + (16 * nb + r16) * 528 + (4 * k + gq) * 16), bl = *(const bf16x8*)(lds + (80 + 16 * nb + r16) * 528 + (4 * k + gq) * 16);
                    acc[nb] = __builtin_amdgcn_mfma_f32_16x16x32_bf16(bh, xh, acc[nb], 0, 0, 0);
                    acc[nb] = __builtin_amdgcn_mfma_f32_16x16x32_bf16(bl, xh, acc[nb], 0, 0, 0); } }
        }
        ssq = red_gq_sum(ssq); const float rs = rsqrtf(ssq * (1.0f / DM) + EPS);
#pragma unroll
        for (int nb = 0; nb < 5; ++nb)
#pragma unroll
            for (int r = 0; r < 4; ++r) lg[r16 * 80 + 16 * nb + 4 * gq + r] = acc[nb][r] * rs;
        __builtin_amdgcn_s_waitcnt(0xc07f); asm volatile("" ::: "memory");
        if (lane < 16) {
            const float* L = lg + lane * 80; const int tok = task * 16 + lane;
            float mx = L[0]; for (int j = 1; j < 8; ++j) mx = fmaxf(mx, L[j]);
            float se = 0.f; for (int j = 0; j < 8; ++j) se += __expf(L[j] - mx);
            int gs = 0; float bv = L[0] + P.b_group[0]; for (int j = 1; j < 8; ++j) { const float v = L[j] + P.b_group[j]; if (v > bv) { bv = v; gs = j; } }
            const float pg = __expf(L[gs] - mx) / se;
            const float* el = L + 8 + 8 * gs; const float* br = P.b_router + 8 * gs;
            int i1 = 0; float s1 = el[0] + br[0]; for (int j = 1; j < 8; ++j) { const float v = el[j] + br[j]; if (v > s1) { s1 = v; i1 = j; } }
            int i2 = -1; float s2 = -INFINITY; for (int j = 0; j < 8; ++j) { if (j == i1) continue; const float v = el[j] + br[j]; if (v > s2) { s2 = v; i2 = j; } }
            const float e1 = el[i1], e2 = el[i2], em = fmaxf(e1, e2), x1e = __expf(e1 - em), x2e = __expf(e2 - em), inv = 1.0f / (x1e + x2e);
            const int ex1 = gs * 8 + i1, ex2 = gs * 8 + i2;
            const unsigned p1 = atomicAdd(cnt + ex1, 1u), p2 = atomicAdd(cnt + ex2, 1u);
            lists[(size_t)ex1 * T + p1] = tok * 2; lists[(size_t)ex2 * T + p2] = tok * 2 + 1;
            gatew[tok * 2] = pg * x1e * inv; gatew[tok * 2 + 1] = pg * x2e * inv; rstd2[tok] = rs;
        }
        __builtin_amdgcn_s_waitcnt(0xc07f); asm volatile("" ::: "memory");
    }
}
__device__ __forceinline__ void convert_phase(const Params& P, Frame& F_) { Frame F = reframe(F_);
    unsigned char* ws = P.ws;
    float* scr = (float*)(F.lds + F.wave * 8448);
    bf16_t* btgu = (bf16_t*)(ws + WS_BTGU); bf16_t* btd = (bf16_t*)(ws + WS_BTD); const float* gf = P.norm_ffn_g;
    constexpr int I_GU = 64 * 2 * 32 * 16, I_D = 64 * 8 * 64, NI = I_GU + I_D, NB_ = 2;
#define CONV_LOAD(vq, dq, lq, it_) do { const int it = (it_); dq = nullptr; lq = 0; \
        if (it < I_GU) { const int nb = it & 15, kb = (it >> 4) & 31, which = (it >> 9) & 1, e = it >> 10; const int k0 = kb * 64, f0 = nb * 32; \
            const float* w = (which ? P.w_up : P.w_gate) + (size_t)e * DM * DEXP; \
            tr_load([&](int kk, int nn) { return *(const f32x4*)(w + (size_t)(k0 + kk) * DEXP + f0 + nn) * gf[k0 + kk]; }, vq, F.lane); \
            dq = btgu + ((size_t)e * 1024 + 256 * (f0 >> 7) + which * 128 + (f0 & 127)) * DM + k0; lq = DM; \
        } else if (it < NI) { const int r = it - I_GU, nb = r & 63, kb = (r >> 6) & 7, e = r >> 9; const int k0 = kb * 64, n0 = nb * 32; const float* w = P.w_down + (size_t)e * DEXP * DM; \
            tr_load([&](int kk, int nn) { return *(const f32x4*)(w + (size_t)(k0 + kk) * DM + n0 + nn); }, vq, F.lane); \
            dq = btd + ((size_t)e * DM + n0) * DEXP + k0; lq = DEXP; } } while (0)
    f32x4 va[NB_][8], vb[NB_][8]; bf16_t* da[NB_]; bf16_t* db[NB_]; size_t la[NB_], lb[NB_];
#pragma unroll
    for (int q = 0; q < NB_; ++q) CONV_LOAD(va[q], da[q], la[q], F.gw + q * F.NGW);
    for (int it0 = F.gw; it0 < NI; it0 += 2 * NB_ * F.NGW) {
#pragma unroll
        for (int q = 0; q < NB_; ++q) CONV_LOAD(vb[q], db[q], lb[q], it0 + (NB_ + q) * F.NGW);
#pragma unroll
        for (int q = 0; q < NB_; ++q) if (da[q]) tr_store(va[q], da[q], la[q], scr, F.lane);
#pragma unroll
        for (int q = 0; q < NB_; ++q) CONV_LOAD(va[q], da[q], la[q], it0 + (2 * NB_ + q) * F.NGW);
#pragma unroll
        for (int q = 0; q < NB_; ++q) if (db[q]) tr_store(vb[q], db[q], lb[q], scr, F.lane);
    }
#undef CONV_LOAD
}
__device__ __forceinline__ void moe_tables(const Params& P, Frame& F_) { Frame F = reframe(F_);
    LAS int* tab = (LAS int*)((LAS unsigned char*)F.lds + LDS_TAB); const unsigned* cnt = (const unsigned*)(P.ws + WS_CTL) + CW_CNT;
    if (F.tid < 64) { const int c = (int)cnt[F.tid]; const int ntl = (c + 255) >> 8; int incl = ntl;
#pragma unroll
        for (int o = 1; o < 64; o <<= 1) { const int t = __shfl_up(incl, o); if (F.lane >= o) incl += t; }
        tab[F.tid] = incl - ntl; tab[65 + F.tid] = c; if (F.tid == 63) tab[64] = incl; }
    __syncthreads();
}
__device__ __forceinline__ void final_phase(const Params& P, Frame& F_) { Frame F = reframe(F_);
    const bf16_t* ymoe = (const bf16_t*)(P.ws + WS_YMOE); float* out = P.out; const int lane = F.lane;
    const bf16_t* x1b = (const bf16_t*)(P.ws + WS_X1B);
    for (int m = F.gw; m < T; m += F.NGW) { f32x4* xr = (f32x4*)(out + (size_t)m * DM) + lane; const u32x2* x0 = (const u32x2*)(x1b + (size_t)m * DM) + lane; const u32x2* y0 = (const u32x2*)(ymoe + (size_t)(2 * m) * DM) + lane; const u32x2* y1 = (const u32x2*)(ymoe + (size_t)(2 * m + 1) * DM) + lane;
        f32x4 v[8]; float s = 0.f;
#pragma unroll
        for (int j = 0; j < 8; ++j) { const u32x2 xx = x0[64 * j], a = y0[64 * j], b = y1[64 * j];
            v[j][0] = bflo(xx.x) + (bflo(a.x) + bflo(b.x)); v[j][1] = bfhi(xx.x) + (bfhi(a.x) + bfhi(b.x)); v[j][2] = bflo(xx.y) + (bflo(a.y) + bflo(b.y)); v[j][3] = bfhi(xx.y) + (bfhi(a.y) + bfhi(b.y));
            s += (v[j][0] * v[j][0] + v[j][1] * v[j][1]) + (v[j][2] * v[j][2] + v[j][3] * v[j][3]); }
        s = wave_sum(s); const float rn = rsqrtf(s * (1.0f / DM) + EPS);
#pragma unroll
        for (int j = 0; j < 8; ++j) { const f32x4 gg = ((const f32x4*)P.norm_final_g)[lane + 64 * j]; xr[64 * j] = v[j] * rn * gg; } }
}

constexpr int LDS_MISC = LDS_TAB + 1024;
constexpr int LDS_BYTES = LDS_TAB + 2048;
constexpr int NPHASE = 11;
__global__ void __launch_bounds__(512, 2) fwd(Params P) {
    extern __shared__ __attribute__((aligned(16))) unsigned char lds[];
    Frame F; F.lds = lds; F.tid = threadIdx.x; F.lane = F.tid & 63; F.wave = __builtin_amdgcn_readfirstlane(F.tid >> 6); F.G = gridDim.x; F.bid = blockIdx.x; F.gw = F.bid * 8 + F.wave; F.NGW = F.G * 8;
    LAS unsigned char* ldsl = (LAS unsigned char*)lds;
    unsigned char* ws = P.ws;
    if (F.tid < 4) ((LAS unsigned*)(ldsl + LDS_MISC))[F.tid] = 0u;
    __syncthreads();
    const int lo = P.ph_lo, hi = P.ph_hi;
    const bool multi = (hi - lo) > 1;
    XcdBarrier bar; bar.bar = (unsigned*)(ws + WS_CTL) + CW_BAR; bar.x = 0; bar.st = nullptr;
    if (multi) bar = xcd_barrier_post((unsigned*)(ws + WS_CTL) + CW_BAR, (volatile LAS unsigned*)(ldsl + LDS_MISC));
#ifndef REPEAT_MASK
#define REPEAT_MASK 0
#endif
#define REP(k) for (int rep_ = 0; rep_ < (((REPEAT_MASK) >> (k)) & 1) + 1; ++rep_)
#define IN(k) (lo <= (k) && (k) < hi)
#define SEAM(k) do { if (IN(k) && IN((k) + 1)) xcd_barrier(bar); } while (0)
    if (IN(0)) REP(0) { p0_prologue(P, F); }
    SEAM(0);
    if (IN(1)) REP(1) {
        pg8::DenseOrder S; S.init(ws + WS_R0, ws + WS_BTIN, T, NPROJ, DM, DM, F.G, F.bid);
        EpiProj E{(bf16_t*)(ws + WS_R1), (bf16_t*)(ws + WS_CMPBUF), (float*)(ws + WS_SMALL), (const float*)(ws + WS_RSTD1)};
        pg8::gemm_phase<EpiProj, pg8::DenseOrder>(ldsl, DM, DM, DM, S, E);
    }
    SEAM(1);
    if (IN(2)) REP(2) {
        for (int c = F.bid; c < 256; c += F.G) {
            small_gemm_chunk(P, F, c);
            asm volatile("s_waitcnt vmcnt(0)" ::: "memory"); __syncthreads();
            { const int dly = (int)(F.bid & 3u);
              for (int q = 0; q < dly; ++q) __builtin_amdgcn_s_sleep(127); }
            for (int k = 0; k < 8; ++k) dn_prep_pair(P, F, c, k);
        }
        __syncthreads();
        CmpOrder S{(const char*)(ws + WS_CMPBUF), (const char*)(ws + WS_W1T), F.G, F.bid};
        EpiCmp1 E{(float*)(ws + WS_HIDS)};
        pg8::gemm_phase<EpiCmp1, CmpOrder>(ldsl, 1024, 2048, 4096, S, E);
    }
    SEAM(2);
    if (IN(3)) REP(3) { cmp2_phase(P, F); for (int u = F.bid; u < 480; u += F.G) dn_passA_unit(P, F, u); }
    SEAM(3);
    if (IN(4)) REP(4) {
        if (F.bid < 16) { dn_passB_unit(P, F, F.bid);
            asm volatile("s_waitcnt vmcnt(0)" ::: "memory"); __syncthreads();
            if (F.tid == 0) { __builtin_amdgcn_fence(__ATOMIC_RELEASE, "agent"); asm volatile("s_waitcnt vmcnt(0)" ::: "memory"); (void)xb_add((unsigned*)(ws + WS_CTL) + CW_PBDONE, 1u); } }
        __syncthreads();
        { unsigned* qctr = (unsigned*)(ws + WS_CTL) + CW_NSAQ + 64 * rep_; LAS unsigned* qs = (LAS unsigned*)(ldsl + LDS_MISC + 16);
          for (;;) {
              __syncthreads();
              if (F.tid == 0) *qs = atomicAdd(qctr, 1u);
              __syncthreads();
              const unsigned q = *qs; if (q >= 1024u) break;
              nsa_unit(P, F, (int)(((q & 3u) << 8) | (255u - (q >> 2))));
          } }
        if (IN(5)) {
            if (F.tid == 0) { unsigned* pb = (unsigned*)(ws + WS_CTL) + CW_PBDONE; XB_SPIN(xb_ld(pb) < 16u, bar.bar); __builtin_amdgcn_fence(__ATOMIC_ACQUIRE, "agent"); asm volatile("s_waitcnt vmcnt(0)" ::: "memory"); }
            __syncthreads();
            for (int u = F.bid; u < 256; u += F.G) dn_passC_unit(P, F, u);
        }
    }
    if (!(IN(4) && IN(5))) SEAM(4);
    if (IN(5) && !IN(4)) REP(5) { for (int u = F.bid; u < 256; u += F.G) dn_passC_unit(P, F, u); }
    SEAM(5);
    if (IN(6)) REP(6) {
        const int NG = (F.G == 256) ? 171 : F.G;
        if (F.bid >= NG || NG == F.G) { Frame Fc = F; if (NG < F.G) { Fc.bid = F.bid - NG; Fc.G = F.G - NG; Fc.NGW = Fc.G * 8; } convert_phase(P, Fc); }
        if (F.bid < NG) {
        pg8::DenseOrder S; S.init(ws + WS_R0, ws + WS_BTOUT, T, DM, DM, DM, NG, F.bid);
        EpiOut E{P.x, P.out, (bf16_t*)(ws + WS_X1B)};
        pg8::gemm_phase<EpiOut, pg8::DenseOrder>(ldsl, DM, DM, DM, S, E);
        }
    }
    SEAM(6);
    if (IN(7)) { router_phase(P, F); }
    SEAM(7);
    if (IN(8)) REP(8) {
        moe_tables(P, F);
        MoeOrderT<true> S{(const LAS int*)(ldsl + LDS_TAB), (const LAS int*)(ldsl + LDS_TAB + 65 * 4), (const int*)(ws + WS_LISTS), (const char*)(ws + WS_X1B), (const char*)(ws + WS_BTGU), (size_t)1024 * DM * 2, (size_t)256 * DM * 2, 4, F.G, F.bid, (unsigned)(DM * 2)};
        EpiGU E{(bf16_t*)(ws + WS_R0), (const int*)(ws + WS_LISTS), (const float*)(ws + WS_RSTD2)};
        pg8::gemm_phase<EpiGU, MoeOrderT<true>>(ldsl, DM, DM, DM, S, E);
    }
    SEAM(8);
    if (IN(9)) REP(9) {
        moe_tables(P, F);
        MoeOrderT<false> S{(const LAS int*)(ldsl + LDS_TAB), (const LAS int*)(ldsl + LDS_TAB + 65 * 4), (const int*)(ws + WS_LISTS), (const char*)(ws + WS_R0), (const char*)(ws + WS_BTD), (size_t)DM * DEXP * 2, (size_t)256 * DEXP * 2, 8, F.G, F.bid, (unsigned)(DEXP * 2)};
        EpiDown E{(bf16_t*)(ws + WS_YMOE), (const int*)(ws + WS_LISTS), (const float*)(ws + WS_GATEW)};
        pg8::gemm_phase<EpiDown, MoeOrderT<false>>(ldsl, DEXP, DEXP, DEXP, S, E);
    }
    SEAM(9);
    if (IN(10)) REP(10) { final_phase(P, F); }
#undef IN
#undef SEAM
}

extern "C" void kernel_launch(void* const* d_in, const int* in_sizes, int n_in, void* d_out, int out_size, void* d_ws, size_t ws_size, hipStream_t stream) {
    static int grid = 0;
    if (grid == 0) {
        if (n_in != 24 || in_sizes[0] != T * DM || out_size != T * DM || ws_size < WS_END) { fprintf(stderr, "kernel_launch: unexpected shapes (n_in %d, ws %zu)\n", n_in, ws_size); grid = -1; return; }
        int dev = 0, cus = 0;
        if (hipGetDevice(&dev) != hipSuccess || hipDeviceGetAttribute(&cus, hipDeviceAttributeMultiprocessorCount, dev) != hipSuccess) { grid = -1; return; }
        if (hipFuncSetAttribute((const void*)fwd, hipFuncAttributeMaxDynamicSharedMemorySize, LDS_BYTES) != hipSuccess) { fprintf(stderr, "kernel_launch: hipFuncSetAttribute failed\n"); grid = -1; return; }
        int per_cu = 0;
        if (hipOccupancyMaxActiveBlocksPerMultiprocessor(&per_cu, (const void*)fwd, 512, LDS_BYTES) != hipSuccess || per_cu < 1) fprintf(stderr, "kernel_launch: occupancy query says %d\n", per_cu);
        (void)hipGetLastError();
        grid = cus;
    }
    if (grid < 0) return;
    (void)hipMemsetAsync((char*)d_ws + WS_CTL, 0, CTL_BYTES, stream);
    Params p{};
    const float** pp = (const float**)&p;
    for (int i = 0; i < 24; ++i) pp[i] = (const float*)d_in[i];
    p.out = (float*)d_out; p.ws = (unsigned char*)d_ws;
#define ONE_LAUNCH 1
#ifndef ONE_LAUNCH
    for (int ph = 0; ph < NPHASE; ++ph) { p.ph_lo = ph; p.ph_hi = ph + 1; hipLaunchKernelGGL(fwd, dim3(grid), dim3(512), LDS_BYTES, stream, p); }
#else
    p.ph_lo = 0; p.ph_hi = NPHASE; hipLaunchKernelGGL(fwd, dim3(grid), dim3(512), LDS_BYTES, stream, p);
#endif
}
```
